# Optimizing an MI355X kernel written in HIP

```python
import math
import jax, jax.numpy as jnp
from jax import lax
import numpy as np

D_MODEL = 1024
BATCH = 8
SEQ = 2048
DEPTH = 1

N_HEADS = 8
HEAD_DIM = 64
ATTN_WIDTH = N_HEADS * HEAD_DIM
DILATED_PATTERNS = ((128, 1), (512, 4), (2048, 16))
BAND_BLOCK = 128
ROPE_THETA = 10000.0
GMLP_WIDTH = 1024
GMLP_GROUPS = 8
GMLP_GROUP_DIM = GMLP_WIDTH // GMLP_GROUPS
GMLP_CHUNK = 128
IN_WIDTH = 3 * ATTN_WIDTH + 2 * GMLP_WIDTH + 2 * D_MODEL
N_EXPERTS = 256
TOP_K = 8
EXPERT_DIM = 256
SHARED_DIM = 256
N_GROUPS = 8
TOPK_GROUPS = 4
ROUTED_SCALE = 2.5
MOE_BLOCK = 128
DEEPNORM_ALPHA = (2.0 * DEPTH) ** 0.25
DEEPNORM_BETA = (8.0 * DEPTH) ** -0.25
LN_EPS = 1e-5

kernel_name = 'hybrid_dilated_gmlp_moe_block'


def layer_norm(x, g, b):
    xf = x.astype(jnp.float32)
    mu = xf.mean(-1, keepdims=True)
    var = jnp.square(xf - mu).mean(-1, keepdims=True)
    y = (xf - mu) * lax.rsqrt(var + LN_EPS)
    return (y * g.astype(jnp.float32) + b.astype(jnp.float32)).astype(x.dtype)


def rotary(t, pos):
    half = HEAD_DIM // 2
    inv_freq = ROPE_THETA ** (-jnp.arange(half, dtype=jnp.float32) / half)
    ang = pos.astype(jnp.float32)[:, None] * inv_freq[None, :]
    cos = jnp.cos(ang)[None, :, None, :]
    sin = jnp.sin(ang)[None, :, None, :]
    t1 = t[..., :half].astype(jnp.float32)
    t2 = t[..., half:].astype(jnp.float32)
    out = jnp.concatenate([t1 * cos - t2 * sin, t2 * cos + t1 * sin], axis=-1)
    return out.astype(t.dtype)


def dilated_band_attention(q, k, v, window, dilation):
    B, S, H, E = q.shape
    n = S // dilation
    span = window // dilation
    nb = -(-n // BAND_BLOCK)
    n_pad = nb * BAND_BLOCK

    def to_blocks(t):
        t = t.reshape(B, n, dilation, H, E).transpose(0, 2, 3, 1, 4)
        t = jnp.pad(t, ((0, 0), (0, 0), (0, 0), (0, n_pad - n), (0, 0)))
        return t.reshape(B, dilation, H, nb, BAND_BLOCK, E)

    def with_prev(t):
        prev = jnp.pad(t, ((0, 0), (0, 0), (0, 0), (1, 0), (0, 0), (0, 0)))[:, :, :, :-1]
        return jnp.concatenate([prev, t], axis=4)

    qb = to_blocks(q)
    kc = with_prev(to_blocks(k))
    vc = with_prev(to_blocks(v))
    s = jnp.einsum('brhnqe,brhnke->brhnqk', qb, kc).astype(jnp.float32) * (HEAD_DIM ** -0.5)
    qi = jnp.arange(BAND_BLOCK)[:, None]
    kj = jnp.arange(2 * BAND_BLOCK)[None, :]
    dist = qi + BAND_BLOCK - kj
    key_idx = jnp.arange(nb)[:, None, None] * BAND_BLOCK - BAND_BLOCK + kj[None]
    valid = (dist >= 0) & (dist <= span) & (key_idx >= 0)
    s = jnp.where(valid, s, -jnp.inf)
    m = s.max(-1, keepdims=True)
    p = jnp.exp(s - m)
    l = p.sum(-1, keepdims=True)
    o = jnp.einsum('brhnqk,brhnke->brhnqe', (p / l).astype(v.dtype), vc)
    lse = (m + jnp.log(l))[..., 0]
    o = o.reshape(B, dilation, H, n_pad, E)[:, :, :, :n].transpose(0, 3, 1, 2, 4).reshape(B, S, H, E)
    lse = lse.reshape(B, dilation, H, n_pad)[..., :n].transpose(0, 3, 1, 2).reshape(B, S, H)
    return o, lse


def spatial_gating(uv, ln_g, ln_b, w_s, b_s):
    B, S, _ = uv.shape
    z = jax.nn.gelu(uv, approximate=False)
    u, vv = z[..., :GMLP_WIDTH], z[..., GMLP_WIDTH:]
    vv = layer_norm(vv, ln_g, ln_b)
    nc = S // GMLP_CHUNK
    vv = vv.reshape(B, nc, GMLP_CHUNK, GMLP_GROUPS, GMLP_GROUP_DIM)
    causal = jnp.tril(jnp.ones((GMLP_CHUNK, GMLP_CHUNK), dtype=bool))
    ws = jnp.where(causal[None], w_s, jnp.zeros_like(w_s))
    sv = jnp.einsum('gts,bcsgk->bctgk', ws, vv) + b_s.T[None, None, :, :, None]
    return u * sv.reshape(B, S, GMLP_WIDTH)


def token_mixer(h, pos, w_in, ln_v_g, ln_v_b, w_spatial, b_spatial, w_proj_a, w_proj_b, w_out):
    B, S, _ = h.shape
    proj = h @ w_in
    q, k, v, uv, gate_pre = jnp.split(
        proj, [ATTN_WIDTH, 2 * ATTN_WIDTH, 3 * ATTN_WIDTH, 3 * ATTN_WIDTH + 2 * GMLP_WIDTH], axis=-1)
    q = rotary(q.reshape(B, S, N_HEADS, HEAD_DIM), pos)
    k = rotary(k.reshape(B, S, N_HEADS, HEAD_DIM), pos)
    v = v.reshape(B, S, N_HEADS, HEAD_DIM)
    outs = []
    lses = []
    for window, dilation in DILATED_PATTERNS:
        o_p, lse_p = dilated_band_attention(q, k, v, window, dilation)
        outs.append(o_p)
        lses.append(lse_p)
    wts = jax.nn.softmax(jnp.stack(lses, axis=0), axis=0)
    o_a = jnp.einsum('pbsh,pbshe->bshe', wts.astype(v.dtype), jnp.stack(outs, axis=0))
    y_a = o_a.reshape(B, S, ATTN_WIDTH) @ w_proj_a
    y_b = spatial_gating(uv, ln_v_g, ln_v_b, w_spatial, b_spatial) @ w_proj_b
    gates = jax.nn.sigmoid(gate_pre)
    g_a, g_b = gates[..., :D_MODEL], gates[..., D_MODEL:]
    return (g_a * y_a + g_b * y_b) @ w_out


def moe_ffn(h, w_router, router_bias, w_gate_e, w_up_e, w_down_e, w_gate_sh, w_up_sh, w_down_sh):
    B, S, D = h.shape
    T = B * S
    hf = h.reshape(T, D)
    scores = jax.nn.sigmoid((hf @ w_router).astype(jnp.float32))
    biased = scores + router_bias.astype(jnp.float32)
    per_group = N_EXPERTS // N_GROUPS
    grp_score = lax.top_k(biased.reshape(T, N_GROUPS, per_group), 2)[0].sum(-1)
    _, top_groups = lax.top_k(grp_score, TOPK_GROUPS)
    gmask = jax.nn.one_hot(top_groups, N_GROUPS, dtype=jnp.float32).sum(1) > 0
    emask = jnp.repeat(gmask, per_group, axis=1)
    _, idx = lax.top_k(jnp.where(emask, biased, -jnp.inf), TOP_K)
    w = jnp.take_along_axis(scores, idx, axis=1)
    w = ROUTED_SCALE * w / w.sum(-1, keepdims=True)
    TK = T * TOP_K
    flat_e = idx.reshape(TK)
    flat_tok = jnp.repeat(jnp.arange(T, dtype=jnp.int32), TOP_K)
    flat_w = w.reshape(TK)
    order = jnp.argsort(flat_e)
    sorted_e = flat_e[order]
    counts = jnp.bincount(flat_e, length=N_EXPERTS)
    start = jnp.cumsum(counts) - counts
    padded = ((counts + MOE_BLOCK - 1) // MOE_BLOCK) * MOE_BLOCK
    padded_end = jnp.cumsum(padded)
    padded_start = padded_end - padded
    dest = padded_start[sorted_e] + jnp.arange(TK) - start[sorted_e]
    n_blocks = -(-TK // MOE_BLOCK) + N_EXPERTS
    P = n_blocks * MOE_BLOCK
    row_tok = jnp.zeros((P,), jnp.int32).at[dest].set(flat_tok[order])
    row_w = jnp.zeros((P,), h.dtype).at[dest].set(flat_w[order].astype(h.dtype))
    block_e = jnp.minimum(
        jnp.searchsorted(padded_end, jnp.arange(n_blocks) * MOE_BLOCK, side='right'), N_EXPERTS - 1)

    def expert_block(args):
        tok, wt, e = args
        xb = hf[tok]
        a = xb @ w_gate_e[e]
        b = xb @ w_up_e[e]
        return ((jax.nn.silu(a) * b) @ w_down_e[e]) * wt[:, None]

    y = lax.map(expert_block, (row_tok.reshape(n_blocks, MOE_BLOCK),
                               row_w.reshape(n_blocks, MOE_BLOCK), block_e))
    routed = jax.ops.segment_sum(y.reshape(P, D), row_tok, num_segments=T)
    shared = (jax.nn.silu(hf @ w_gate_sh) * (hf @ w_up_sh)) @ w_down_sh
    return (routed + shared).reshape(B, S, D)


def setup_inputs(seed: int = 0) -> dict:
    key = jax.random.key(seed)
    ks = jax.random.split(key, 24)
    L = DEPTH
    D = D_MODEL

    def nrm(k, shape, scale):
        return jax.random.normal(k, shape, jnp.float32) * scale

    return {
        'x': nrm(ks[0], (BATCH, SEQ, D), 1.0),
        'c': nrm(ks[1], (BATCH, D), 1.0),
        'w_ada': nrm(ks[2], (L, D, 6 * D), 0.5 * D ** -0.5),
        'b_ada': nrm(ks[3], (L, 6 * D), 0.02),
        'w_in': nrm(ks[4], (L, D, IN_WIDTH), D ** -0.5),
        'ln_v_g': 1.0 + nrm(ks[5], (L, GMLP_WIDTH), 0.1),
        'ln_v_b': nrm(ks[6], (L, GMLP_WIDTH), 0.02),
        'w_spatial': nrm(ks[7], (L, GMLP_GROUPS, GMLP_CHUNK, GMLP_CHUNK), GMLP_CHUNK ** -0.5),
        'b_spatial': 1.0 + nrm(ks[8], (L, GMLP_GROUPS, GMLP_CHUNK), 0.1),
        'w_proj_a': nrm(ks[9], (L, ATTN_WIDTH, D), ATTN_WIDTH ** -0.5),
        'w_proj_b': nrm(ks[10], (L, GMLP_WIDTH, D), GMLP_WIDTH ** -0.5),
        'w_out': nrm(ks[11], (L, D, D), DEEPNORM_BETA * D ** -0.5),
        'ln1_g': 1.0 + nrm(ks[12], (L, D), 0.1),
        'ln1_b': nrm(ks[13], (L, D), 0.02),
        'w_router': nrm(ks[14], (L, D, N_EXPERTS), D ** -0.5),
        'router_bias': nrm(ks[15], (L, N_EXPERTS), 0.01),
        'w_gate_e': nrm(ks[16], (L, N_EXPERTS, D, EXPERT_DIM), D ** -0.5),
        'w_up_e': nrm(ks[17], (L, N_EXPERTS, D, EXPERT_DIM), D ** -0.5),
        'w_down_e': nrm(ks[18], (L, N_EXPERTS, EXPERT_DIM, D), DEEPNORM_BETA * EXPERT_DIM ** -0.5),
        'w_gate_sh': nrm(ks[19], (L, D, SHARED_DIM), D ** -0.5),
        'w_up_sh': nrm(ks[20], (L, D, SHARED_DIM), D ** -0.5),
        'w_down_sh': nrm(ks[21], (L, SHARED_DIM, D), DEEPNORM_BETA * SHARED_DIM ** -0.5),
        'ln2_g': 1.0 + nrm(ks[22], (L, D), 0.1),
        'ln2_b': nrm(ks[23], (L, D), 0.02),
    }


def reference(x, c, w_ada, b_ada, w_in, ln_v_g, ln_v_b, w_spatial, b_spatial, w_proj_a, w_proj_b,
              w_out, ln1_g, ln1_b, w_router, router_bias, w_gate_e, w_up_e, w_down_e,
              w_gate_sh, w_up_sh, w_down_sh, ln2_g, ln2_b):
    S = x.shape[1]
    pos = jnp.arange(S, dtype=jnp.int32)
    for l in range(DEPTH):
        mod = jax.nn.silu(c) @ w_ada[l] + b_ada[l]
        sh_a, sc_a, g_a, sh_f, sc_f, g_f = jnp.split(mod[:, None, :], 6, axis=-1)
        h = x * (1.0 + sc_a) + sh_a
        mix = token_mixer(h, pos, w_in[l], ln_v_g[l], ln_v_b[l], w_spatial[l], b_spatial[l],
                          w_proj_a[l], w_proj_b[l], w_out[l])
        x = layer_norm(DEEPNORM_ALPHA * x + g_a * mix, ln1_g[l], ln1_b[l])
        h = x * (1.0 + sc_f) + sh_f
        ffn = moe_ffn(h, w_router[l], router_bias[l], w_gate_e[l], w_up_e[l], w_down_e[l],
                      w_gate_sh[l], w_up_sh[l], w_down_sh[l])
        x = layer_norm(DEEPNORM_ALPHA * x + g_f * ffn, ln2_g[l], ln2_b[l])
    return x
```

```cpp
#include <hip/hip_runtime.h>
#include <math.h>
#include <stdint.h>

namespace nv {
constexpr int NB = 8, S = 2048, D = 1024, T = NB * S;
constexpr int NH = 8, HD = 64, AW = 512, GW = 1024, INW = 5632;
constexpr int NE = 256, TOPK = 8, ED = 256, SD = 256;
constexpr float ALPHA = 1.189207115002721f;
constexpr float LN_EPS = 1e-5f;

__device__ __forceinline__ float sigmoidf_(float x) { return 1.f / (1.f + expf(-x)); }
__device__ __forceinline__ float siluf_(float x) { return x / (1.f + expf(-x)); }
__device__ __forceinline__ float wave_sum(float v) {
#pragma unroll
    for (int o = 1; o < 64; o <<= 1) v += __shfl_xor(v, o);
    return v;
}

__global__ void k_mod(const float* c, const float* w_ada, const float* b_ada, float* mod) {
    int j = blockIdx.x * blockDim.x + threadIdx.x;
    int b = blockIdx.y;
    float acc = 0.f;
    for (int k = 0; k < D; ++k) acc += siluf_(c[b * D + k]) * w_ada[(size_t)k * (6 * D) + j];
    mod[b * 6 * D + j] = acc + b_ada[j];
}
__global__ void k_modulate(const float* x, const float* mod, int off_shift, int off_scale, float* h) {
    size_t i = (size_t)blockIdx.x * blockDim.x + threadIdx.x;
    int k = (int)(i % D); int t = (int)(i / D); int b = t / S;
    h[i] = x[i] * (1.f + mod[b * 6 * D + off_scale + k]) + mod[b * 6 * D + off_shift + k];
}
__global__ void __launch_bounds__(256) k_gemm(const float* A, int lda, const float* Bm, int ldb, float* C, int ldc, int K) {
    __shared__ float As[16][65];
    __shared__ float Bs[16][64];
    const int tx = threadIdx.x & 15, ty = threadIdx.x >> 4;
    const int m0 = blockIdx.y * 64, n0 = blockIdx.x * 64;
    float acc[4][4] = {};
    for (int k0 = 0; k0 < K; k0 += 16) {
        for (int i = threadIdx.x; i < 64 * 16; i += 256) { int r = i / 16, kk = i % 16; As[kk][r] = A[(size_t)(m0 + r) * lda + k0 + kk]; }
        for (int i = threadIdx.x; i < 16 * 64; i += 256) { int kk = i / 64, cc = i % 64; Bs[kk][cc] = Bm[(size_t)(k0 + kk) * ldb + n0 + cc]; }
        __syncthreads();
#pragma unroll
        for (int kk = 0; kk < 16; ++kk) {
            float a[4], b[4];
#pragma unroll
            for (int i = 0; i < 4; ++i) { a[i] = As[kk][ty * 4 + i]; b[i] = Bs[kk][tx * 4 + i]; }
#pragma unroll
            for (int i = 0; i < 4; ++i)
#pragma unroll
                for (int j = 0; j < 4; ++j) acc[i][j] += a[i] * b[j];
        }
        __syncthreads();
    }
#pragma unroll
    for (int i = 0; i < 4; ++i)
#pragma unroll
        for (int j = 0; j < 4; ++j) C[(size_t)(m0 + ty * 4 + i) * ldc + n0 + tx * 4 + j] = acc[i][j];
}
__global__ void k_rope(float* proj) {
    int i = blockIdx.x * blockDim.x + threadIdx.x;
    int f = i & 31; int hp = (i >> 5) & 15; int t = i >> 9;
    int pos = t % S;
    float inv = powf(10000.f, -(float)f / 32.f);
    float ang = (float)pos * inv;
    float sn, cs; sincosf(ang, &sn, &cs);
    float* p = proj + (size_t)t * INW + hp * 64;
    float t1 = p[f], t2 = p[f + 32];
    p[f] = t1 * cs - t2 * sn; p[f + 32] = t2 * cs + t1 * sn;
}
__global__ void __launch_bounds__(256) k_attn(const float* proj, float* oa) {
    int item = blockIdx.x * 4 + (threadIdx.x >> 6); int lane = threadIdx.x & 63;
    int h = item % NH; int t = item / NH; int b = t / S, pos = t % S;
    const float q = proj[(size_t)t * INW + h * 64 + lane];
    float m = -INFINITY, l = 0.f, o = 0.f;
    for (int p = 0; p < 3; ++p) {
        int d = (p == 0) ? 1 : (p == 1 ? 4 : 16);
        for (int mm = 0; mm <= 128; ++mm) {
            int kp = pos - mm * d; if (kp < 0) break;
            size_t row = (size_t)(b * S + kp) * INW;
            float s = wave_sum(q * proj[row + AW + h * 64 + lane]) * 0.125f;
            float v = proj[row + 2 * AW + h * 64 + lane];
            float mn = fmaxf(m, s);
            float corr = expf(m - mn);
            float pe = expf(s - mn);
            l = l * corr + pe; o = o * corr + pe * v; m = mn;
        }
    }
    oa[(size_t)t * AW + h * 64 + lane] = o / l;
}
__global__ void __launch_bounds__(256) k_gelu_ln(float* proj, const float* g, const float* bb) {
    __shared__ float red[8];
    int t = blockIdx.x; float* p = proj + (size_t)t * INW + 3 * AW;
    float vals[4]; float s = 0.f;
    for (int i = 0; i < 8; ++i) { int c = threadIdx.x + 256 * i; float x = p[c]; float z = 0.5f * x * (1.f + erff(x * 0.70710678118654752f)); p[c] = z; if (i >= 4) { vals[i - 4] = z; s += z; } }
    s = wave_sum(s); if ((threadIdx.x & 63) == 0) red[threadIdx.x >> 6] = s; __syncthreads();
    float mean = (red[0] + red[1] + red[2] + red[3]) / 1024.f; __syncthreads();
    float q = 0.f; for (int i = 0; i < 4; ++i) { float d = vals[i] - mean; q += d * d; }
    q = wave_sum(q); if ((threadIdx.x & 63) == 0) red[threadIdx.x >> 6] = q; __syncthreads();
    float var = (red[0] + red[1] + red[2] + red[3]) / 1024.f; float rstd = 1.f / sqrtf(var + LN_EPS);
    for (int i = 0; i < 4; ++i) { int c = threadIdx.x + 256 * i; p[GW + c] = (vals[i] - mean) * rstd * g[c] + bb[c]; }
}
__global__ void __launch_bounds__(256) k_sgu(const float* proj, const float* ws, const float* bs, float* sg) {
    int t = blockIdx.x; int tt = t % 128; int t0 = t - tt;
    for (int i = 0; i < 4; ++i) {
        int c = threadIdx.x + 256 * i; int g = c / 128;
        float acc = 0.f;
        for (int s = 0; s <= tt; ++s) acc += ws[(size_t)(g * 128 + tt) * 128 + s] * proj[(size_t)(t0 + s) * INW + 3 * AW + GW + c];
        acc += bs[g * 128 + tt];
        sg[(size_t)t * GW + c] = proj[(size_t)t * INW + 3 * AW + c] * acc;
    }
}
__global__ void k_merge(const float* proj, const float* ya, const float* yb, float* merged) {
    size_t i = (size_t)blockIdx.x * blockDim.x + threadIdx.x; int c = (int)(i % D); size_t t = i / D;
    float ga = sigmoidf_(proj[t * INW + 3 * AW + 2 * GW + c]), gb = sigmoidf_(proj[t * INW + 3 * AW + 2 * GW + D + c]);
    merged[i] = ga * ya[i] + gb * yb[i];
}
__global__ void __launch_bounds__(256) k_ln_res(const float* xin, const float* y, const float* mod, int off_gate, const float* g, const float* bb,
                                                float* out, float* h2, int off_shift, int off_scale) {
    __shared__ float red[8];
    int t = blockIdx.x; int b = t / S; const float* md = mod + b * 6 * D;
    float v[4]; float s = 0.f;
    for (int i = 0; i < 4; ++i) { int c = threadIdx.x + 256 * i; v[i] = ALPHA * xin[(size_t)t * D + c] + md[off_gate + c] * y[(size_t)t * D + c]; s += v[i]; }
    s = wave_sum(s); if ((threadIdx.x & 63) == 0) red[threadIdx.x >> 6] = s; __syncthreads();
    float mean = (red[0] + red[1] + red[2] + red[3]) / 1024.f; __syncthreads();
    float q = 0.f; for (int i = 0; i < 4; ++i) { float d = v[i] - mean; q += d * d; }
    q = wave_sum(q); if ((threadIdx.x & 63) == 0) red[threadIdx.x >> 6] = q; __syncthreads();
    float rstd = 1.f / sqrtf((red[0] + red[1] + red[2] + red[3]) / 1024.f + LN_EPS);
    for (int i = 0; i < 4; ++i) { int c = threadIdx.x + 256 * i; float o = (v[i] - mean) * rstd * g[c] + bb[c]; out[(size_t)t * D + c] = o;
        if (h2) h2[(size_t)t * D + c] = o * (1.f + md[off_scale + c]) + md[off_shift + c]; }
}
__global__ void __launch_bounds__(64) k_route(const float* logits, const float* rbias, int* idx, float* wgt) {
    __shared__ float sc[NE], bi[NE]; __shared__ float gs[8]; __shared__ int gsel[8]; __shared__ int sel[8]; __shared__ int used[NE];
    int t = blockIdx.x; int lane = threadIdx.x;
    for (int i = 0; i < 4; ++i) { int e = lane + 64 * i; float s = sigmoidf_(logits[(size_t)t * NE + e]); sc[e] = s; bi[e] = s + rbias[e]; used[e] = 0; }
    __syncthreads();
    if (lane < 8) { float m1 = -INFINITY, m2 = -INFINITY; for (int i = 0; i < 32; ++i) { float v = bi[lane * 32 + i]; if (v > m1) { m2 = m1; m1 = v; } else if (v > m2) m2 = v; } gs[lane] = m1 + m2; gsel[lane] = 0; }
    __syncthreads();
    if (lane == 0) {
        for (int r = 0; r < 4; ++r) { int best = -1; float bv = -INFINITY; for (int g = 0; g < 8; ++g) if (!gsel[g] && (best < 0 || gs[g] > bv)) { best = g; bv = gs[g]; } gsel[best] = 1; }
        float ws = 0.f;
        for (int r = 0; r < 8; ++r) { int best = -1; float bv = -INFINITY;
            for (int e = 0; e < NE; ++e) { if (!gsel[e >> 5]) continue; if (used[e]) continue; if (best < 0 || bi[e] > bv) { best = e; bv = bi[e]; } }
            used[best] = 1; sel[r] = best; ws += sc[best]; }
        for (int r = 0; r < 8; ++r) { idx[t * 8 + r] = sel[r]; wgt[t * 8 + r] = 2.5f * sc[sel[r]] / ws; }
    }
}
__global__ void __launch_bounds__(256) k_moe(const float* h2, const int* idx, const float* wgt, const float* wge, const float* wue, const float* wde,
                                             const float* wgs, const float* wus, const float* wds, float* ffn) {
    __shared__ float hrow[D]; __shared__ float hid[ED];
    int t = blockIdx.x; int tid = threadIdx.x;
    for (int i = 0; i < 4; ++i) hrow[tid + 256 * i] = h2[(size_t)t * D + tid + 256 * i];
    __syncthreads();
    float acc[4] = {0.f, 0.f, 0.f, 0.f};
    for (int j = 0; j < 9; ++j) {
        const float *Wg, *Wu, *Wd; float w;
        if (j < 8) { int e = idx[t * 8 + j]; w = wgt[t * 8 + j]; Wg = wge + (size_t)e * D * ED; Wu = wue + (size_t)e * D * ED; Wd = wde + (size_t)e * ED * D; }
        else { w = 1.f; Wg = wgs; Wu = wus; Wd = wds; }
        float a = 0.f, b = 0.f;
        for (int k = 0; k < D; ++k) { float hv = hrow[k]; a += hv * Wg[(size_t)k * ED + tid]; b += hv * Wu[(size_t)k * ED + tid]; }
        hid[tid] = siluf_(a) * b;
        __syncthreads();
        for (int i = 0; i < 4; ++i) { float s = 0.f; for (int k = 0; k < ED; ++k) s += hid[k] * Wd[(size_t)k * D + tid + 256 * i]; acc[i] += w * s; }
        __syncthreads();
    }
    for (int i = 0; i < 4; ++i) ffn[(size_t)t * D + tid + 256 * i] = acc[i];
}
}

extern "C" void kernel_launch(void* const* d_in, const int* in_sizes, int n_in, void* d_out, int out_size, void* d_ws, size_t ws_size, hipStream_t stream) {
    using namespace nv;
    const float* x = (const float*)d_in[0]; const float* c = (const float*)d_in[1]; const float* w_ada = (const float*)d_in[2]; const float* b_ada = (const float*)d_in[3];
    const float* w_in = (const float*)d_in[4]; const float* ln_v_g = (const float*)d_in[5]; const float* ln_v_b = (const float*)d_in[6]; const float* w_sp = (const float*)d_in[7];
    const float* b_sp = (const float*)d_in[8]; const float* w_pa = (const float*)d_in[9]; const float* w_pb = (const float*)d_in[10]; const float* w_out = (const float*)d_in[11];
    const float* ln1_g = (const float*)d_in[12]; const float* ln1_b = (const float*)d_in[13]; const float* w_router = (const float*)d_in[14]; const float* rbias = (const float*)d_in[15];
    const float* wge = (const float*)d_in[16]; const float* wue = (const float*)d_in[17]; const float* wde = (const float*)d_in[18];
    const float* wgs = (const float*)d_in[19]; const float* wus = (const float*)d_in[20]; const float* wds = (const float*)d_in[21];
    const float* ln2_g = (const float*)d_in[22]; const float* ln2_b = (const float*)d_in[23];
    float* out = (float*)d_out;
    char* ws = (char*)d_ws; size_t off = 0;
    auto carve = [&](size_t bytes) { char* p = ws + off; off += (bytes + 255) & ~(size_t)255; return p; };
    float* mod = (float*)carve((size_t)NB * 6 * D * 4);
    float* h = (float*)carve((size_t)T * D * 4);
    float* proj = (float*)carve((size_t)T * INW * 4);
    float* oa = (float*)carve((size_t)T * AW * 4);
    float* sg = (float*)carve((size_t)T * GW * 4);
    float* ya = (float*)carve((size_t)T * D * 4);
    float* yb = (float*)carve((size_t)T * D * 4);
    float* x1 = (float*)carve((size_t)T * D * 4);
    float* logits = (float*)carve((size_t)T * NE * 4);
    int* idx = (int*)carve((size_t)T * 8 * 4);
    float* wgt = (float*)carve((size_t)T * 8 * 4);
    float* merged = ya;
    float* mix = yb;
    float* ffn = sg;
    (void)ws_size; (void)in_sizes; (void)n_in; (void)out_size;

    k_mod<<<dim3(6 * D / 256, NB), 256, 0, stream>>>(c, w_ada, b_ada, mod);
    k_modulate<<<(T * D) / 256, 256, 0, stream>>>(x, mod, 0, D, h);
    k_gemm<<<dim3(INW / 64, T / 64), 256, 0, stream>>>(h, D, w_in, INW, proj, INW, D);
    k_rope<<<(T * 16 * 32) / 256, 256, 0, stream>>>(proj);
    k_attn<<<(T * NH) / 4, 256, 0, stream>>>(proj, oa);
    k_gelu_ln<<<T, 256, 0, stream>>>(proj, ln_v_g, ln_v_b);
    k_sgu<<<T, 256, 0, stream>>>(proj, w_sp, b_sp, sg);
    k_gemm<<<dim3(D / 64, T / 64), 256, 0, stream>>>(oa, AW, w_pa, D, ya, D, AW);
    k_gemm<<<dim3(D / 64, T / 64), 256, 0, stream>>>(sg, GW, w_pb, D, yb, D, GW);
    k_merge<<<(T * D) / 256, 256, 0, stream>>>(proj, ya, yb, h);
    (void)merged; (void)mix;
    k_gemm<<<dim3(D / 64, T / 64), 256, 0, stream>>>(h, D, w_out, D, ya, D, D);
    k_ln_res<<<T, 256, 0, stream>>>(x, ya, mod, 2 * D, ln1_g, ln1_b, x1, h, 3 * D, 4 * D);
    k_gemm<<<dim3(NE / 64, T / 64), 256, 0, stream>>>(h, D, w_router, NE, logits, NE, D);
    k_route<<<T, 64, 0, stream>>>(logits, rbias, idx, wgt);
    k_moe<<<T, 256, 0, stream>>>(h, idx, wgt, wge, wue, wde, wgs, wus, wds, ffn);
    k_ln_res<<<T, 256, 0, stream>>>(x1, ffn, mod, 5 * D, ln2_g, ln2_b, out, nullptr, 0, 0);
}
```

```cpp
#define PROBE 0
#define PROBE_STAGE -1
#define MK_SPLIT 0
#include <hip/hip_runtime.h>
#include <math.h>
#include <stdint.h>
#include <cstdio>

#define LAS __attribute__((address_space(3)))
#define GAS __attribute__((address_space(1)))
typedef unsigned short bf16_t;
typedef short bf16x8 __attribute__((ext_vector_type(8)));
typedef short s16x4 __attribute__((ext_vector_type(4)));
typedef float f32x4 __attribute__((ext_vector_type(4)));
typedef float f32x2 __attribute__((ext_vector_type(2)));
typedef unsigned u32x4 __attribute__((ext_vector_type(4)));
typedef unsigned u32x2 __attribute__((ext_vector_type(2)));
typedef GAS unsigned gu32;

constexpr int NB = 8, SEQ = 2048, DM = 1024, T = NB * SEQ;
constexpr int NH = 8, HD = 64, AW = 512, GW = 1024, INW = 5632;
constexpr int NE = 256, TOPK = 8, ED = 256, SD = 256;
constexpr float ALPHA = 1.189207115002721f;
constexpr float LN_EPS = 1e-5f;
constexpr int NWAVES = 8, NTHR = 512;
constexpr int BUCKET = 16384;
constexpr int MAXTILES = 768;

constexpr size_t MiB = 1u << 20;
constexpr size_t WS_CTL = 0, CTL_ZERO_BYTES = 64 * 1024;
constexpr size_t WS_MOD = 1 * MiB;
constexpr size_t WS_ROPE = 1 * MiB + 256 * 1024;
constexpr size_t WS_WPA = 2 * MiB, WS_WPB = 3 * MiB, WS_WOUT = 5 * MiB, WS_WRS = 7 * MiB, WS_WSD = 8 * MiB + 512 * 1024;
constexpr size_t WS_WD = 10 * MiB;
constexpr size_t WS_X1 = 138 * MiB;
constexpr size_t WS_HID = 202 * MiB;
constexpr size_t WS_SHID = 298 * MiB;
constexpr size_t WS_YSH = 306 * MiB;
constexpr size_t WS_TOKE = 338 * MiB, WS_TOKR = WS_TOKE + 512 * 1024, WS_TOKW = WS_TOKR + 512 * 1024;
constexpr size_t WS_BTOK = 340 * MiB, WS_BW = 356 * MiB;
constexpr size_t WS_D = 372 * MiB;
constexpr size_t WS_YROW = WS_D;
constexpr size_t WS_WGU = 372 * MiB;
constexpr size_t WS_WIN = 628 * MiB;
constexpr size_t WS_H = 640 * MiB;
constexpr size_t WS_OP = 628 * MiB, WS_LSE = 676 * MiB;
constexpr size_t WS_Q = 678 * MiB, WS_K = 694 * MiB, WS_V = 710 * MiB;
constexpr size_t WS_MERGED = 678 * MiB;
constexpr size_t WS_U = 726 * MiB, WS_VG = 758 * MiB;
constexpr size_t WS_MIX = 726 * MiB;
constexpr size_t WS_LOGITS = 758 * MiB;
constexpr size_t WS_GA = 790 * MiB, WS_GB = 822 * MiB;
constexpr size_t WS_OA = 854 * MiB, WS_SG = 870 * MiB;
constexpr size_t WS_END = 902 * MiB;
constexpr size_t WS_GOLD = 960 * MiB;
constexpr int CW_BAR = 1024;
constexpr int CW_CNT = 8192;

#define RLX_AGENT __ATOMIC_RELAXED, __HIP_MEMORY_SCOPE_AGENT
#define LDS_WAIT() asm volatile("s_waitcnt lgkmcnt(0)" ::: "memory")
#define VM_WAIT() asm volatile("s_waitcnt vmcnt(0)" ::: "memory")
__device__ __forceinline__ unsigned cvt_pk_bf16(float lo, float hi) { unsigned r; asm volatile("v_cvt_pk_bf16_f32 %0, %1, %2" : "=v"(r) : "v"(lo), "v"(hi)); return r; }
__device__ __forceinline__ float bf_lo(unsigned u) { return __uint_as_float(u << 16); }
__device__ __forceinline__ float bf_hi(unsigned u) { return __uint_as_float(u & 0xffff0000u); }
__device__ __forceinline__ float wave_sum(float v) {
#pragma unroll
    for (int o = 1; o < 64; o <<= 1) v += __shfl_xor(v, o);
    return v;
}
__device__ __forceinline__ float fast_sigmoid(float x) { return __builtin_amdgcn_rcpf(1.f + __builtin_amdgcn_exp2f(-1.4426950408889634f * x)); }
__device__ __forceinline__ f32x2 gelu_pk(f32x2 v) {
    const f32x2 av = __builtin_elementwise_abs(v), d = av * 0.2316418882f + 1.0f;
    f32x2 t; t.x = __builtin_amdgcn_rcpf(d.x); t.y = __builtin_amdgcn_rcpf(d.y);
    f32x2 q = t * 0.5307027145f + (-0.7265760135f); q = q * t + 0.7107068705f; q = q * t + (-0.142248368f); q = q * t + 0.127414796f; q = q * t;
    const f32x2 s = (v * v) * (-0.72134752044f);
    f32x2 e; e.x = __builtin_amdgcn_exp2f(s.x); e.y = __builtin_amdgcn_exp2f(s.y);
    const f32x2 m = v * (q * e), r = v - m;
    f32x2 o; o.x = v.x < 0.f ? m.x : r.x; o.y = v.y < 0.f ? m.y : r.y; return o;
}

#define XB_TMO      128
#define XB_XCNT(j)  (256  + 64 * (j))
#define XB_XSUB(j)  (1280 + 64 * (j))
#define XB_XGEN(j)  (2304 + 64 * (j))
#define XB_TOP      3328
#define XB_TOPGEN   3392
#define XCD_BAR_WORDS 3456
#define XB_SPIN_CAP (1u << 18)
__device__ __forceinline__ unsigned xb_ld(unsigned* p)              { return __hip_atomic_load(p, __ATOMIC_RELAXED, __HIP_MEMORY_SCOPE_AGENT); }
__device__ __forceinline__ unsigned xb_add(unsigned* p, unsigned v) { return __hip_atomic_fetch_add(p, v, __ATOMIC_RELAXED, __HIP_MEMORY_SCOPE_AGENT); }
__device__ __forceinline__ unsigned xb_xcc_id() { return (unsigned)__builtin_amdgcn_s_getreg((3 << 11) | 20) & 0xFu; }
#define XB_SPIN(cond, bar) do { unsigned _sp = 0; while (cond) { __builtin_amdgcn_s_sleep(1); \
    if ((++_sp & 255u) == 0u) { if (xb_ld(&(bar)[XB_TMO])) break; if (_sp > XB_SPIN_CAP) { atomicAdd(&(bar)[XB_TMO], 1u); break; } } } } while (0)
struct XcdBarrier { unsigned* bar; unsigned x; volatile LAS unsigned* st; };
__device__ __forceinline__ XcdBarrier xcd_barrier_post(unsigned* bar, volatile LAS unsigned* st) {
    XcdBarrier b; b.bar = bar; b.x = xb_xcc_id(); b.st = st;
    if (threadIdx.x == 0) (void)xb_add(&bar[XB_XCNT(b.x)], 1u);
    return b;
}
__device__ __forceinline__ void xcd_barrier_complete(unsigned* bar, unsigned x, unsigned& nloc, unsigned& nx) {
    const unsigned G = gridDim.x * gridDim.y * gridDim.z;
    unsigned sum, cnt, mine, sp = 0u;
    for (;;) {
        sum = 0u; cnt = 0u; mine = 0u;
#pragma unroll
        for (unsigned j = 0; j < 16; ++j) { const unsigned c = xb_ld(&bar[XB_XCNT(j)]); sum += c; cnt += (c > 0u) ? 1u : 0u; mine = (j == x) ? c : mine; }
        if (sum == G) break;
        __builtin_amdgcn_s_sleep(1);
        if ((++sp & 255u) == 0u) { if (xb_ld(&bar[XB_TMO])) break; if (sp > XB_SPIN_CAP) { atomicAdd(&bar[XB_TMO], 1u); break; } }
    }
    nloc = mine > 0u ? mine : 1u; nx = cnt > 0u ? cnt : 1u;
}
__device__ __forceinline__ void xcd_barrier(const XcdBarrier& b) {
    asm volatile("s_waitcnt vmcnt(0)" ::: "memory");
    __syncthreads();
    if (threadIdx.x == 0) {
        unsigned* bar = b.bar;
        __builtin_amdgcn_s_waitcnt(0);
        unsigned nloc = b.st[0], nx = b.st[1];
        if (nloc == 0u) { xcd_barrier_complete(bar, b.x, nloc, nx); b.st[0] = nloc; b.st[1] = nx; }
        const unsigned old = xb_add(&bar[XB_XSUB(b.x)], 1u);
        const unsigned gen = old / nloc;
        if (old + 1u == (gen + 1u) * nloc) {
            __builtin_amdgcn_fence(__ATOMIC_RELEASE, "agent");
            asm volatile("s_waitcnt vmcnt(0)" ::: "memory");
            const unsigned og = xb_add(&bar[XB_TOP], 1u);
            const unsigned tg = og / nx;
            if (og + 1u == (tg + 1u) * nx) xb_add(&bar[XB_TOPGEN], 1u);
            else XB_SPIN(xb_ld(&bar[XB_TOPGEN]) == tg, bar);
            __builtin_amdgcn_fence(__ATOMIC_ACQUIRE, "agent");
            xb_add(&bar[XB_XGEN(b.x)], 1u);
            asm volatile("s_waitcnt vmcnt(0)" ::: "memory");
        } else {
            XB_SPIN(xb_ld(&bar[XB_XGEN(b.x)]) == gen, bar);
            __builtin_amdgcn_fence(__ATOMIC_ACQUIRE, "agent");
            asm volatile("s_waitcnt vmcnt(0)" ::: "memory");
        }
    }
    __syncthreads();
}

namespace pg8 {
constexpr int BM = 256, BK = 64, HALF = 128, HTB = HALF * BK * 2, STAGE_BYTES = 8 * HTB, NXCD = 8, WGM = 8;
__host__ __device__ __forceinline__ int lds_byte(int r, int c) { const int st = (r >> 4) * 2 + (c >> 5), rr = r & 15, cc = c & 31, ob = rr * 64 + cc * 2; return st * 1024 + (ob ^ (((ob >> 9) & 1) << 5)); }
__host__ __device__ __forceinline__ void stage_rc(int b, int& R, int& C) { const int st = b / 1024, sb = b % 1024, swz = sb ^ (((sb >> 9) & 1) << 5); R = (st >> 1) * 16 + swz / 64; C = (st & 1) * 32 + (swz % 64) / 2; }
__host__ __device__ __forceinline__ int perm32(int rho) { const int n = rho >> 4, i = rho & 15; return 8 * (i >> 2) + 4 * n + (i & 3); }

struct GU { const char* A; const char* B; const int* gidx; int gcnt; int pm, pn, e; };

struct StaticOrder {
    int nM, nN, nwg, G, c; const char* A; const char* B; size_t tstepA, tstepB;
    __device__ void init(const void* A_, const void* B_, int M, int N, unsigned lda, unsigned ldb, int G_, int c_) { nM = M / BM; nN = N / BM; nwg = nM * nN; G = G_; c = c_; A = (const char*)A_; B = (const char*)B_; tstepA = (size_t)BM * lda; tstepB = (size_t)BM * ldb; }
    __device__ bool next(int i, GU& u) const {
        const long L = (long)i * G + c; if (L >= nwg) return false;
        int wgid = (int)L; { const int q = nwg / NXCD, r = nwg % NXCD, xcd = wgid % NXCD, off = wgid / NXCD; wgid = (xcd < r ? xcd * (q + 1) : r * (q + 1) + (xcd - r) * q) + off; }
        const int nig = WGM * nN, gid = wgid / nig, fm = gid * WGM, gsz = (nM - fm) < WGM ? (nM - fm) : WGM;
        u.pm = fm + ((wgid % nig) % gsz); u.pn = (wgid % nig) / gsz; u.e = 0; u.gidx = nullptr; u.gcnt = 0;
        u.A = A + (size_t)u.pm * tstepA; u.B = B + (size_t)u.pn * tstepB; return true;
    }
};

template <class Epi, class Sched, bool GATHER, bool ALIGN_EPI>
__device__ __forceinline__ void gemm_phase(LAS unsigned char* lds, const int K, const unsigned lda, const unsigned ldb, const Sched& S, const Epi& E) {
    const int tid = threadIdx.x, wid = __builtin_amdgcn_readfirstlane(tid >> 6), lane = tid & 63, wr = wid >> 2, wc = wid & 3, fr = lane & 15, fq = lane >> 4;
    const int nt = K / BK;
    int R0, C0, R1, C1; stage_rc(tid * 16, R0, C0); stage_rc(tid * 16 + 8192, R1, C1);
    const int Rb0 = (R0 & ~31) + perm32(R0 & 31), Rb1 = (R1 & ~31) + perm32(R1 & 31);
    const unsigned vB0 = (unsigned)Rb0 * ldb + (unsigned)C0 * 2u, vB1 = (unsigned)Rb1 * ldb + (unsigned)C1 * 2u;
    const size_t kstep = (size_t)(BK * 2);
    const size_t hstepB = (size_t)HALF * ldb;
    const unsigned ldsw = (unsigned)wid * 1024u;
    const int aoff = lds_byte(wr * 64 + fr, fq * 8), boff = lds_byte(wc * 32 + fr, fq * 8);
#define PG8_SA(b, h) (((b) * 2 + (h)) * HTB)
#define PG8_SB(b, h) ((4 + (b) * 2 + (h)) * HTB)
#define PG8_STAGE(bufoff, gbase, v0, v1) do { \
        __builtin_amdgcn_global_load_lds((const unsigned*)((const char*)(gbase) + (v0)), (LAS unsigned*)(lds + (bufoff) + ldsw), 16, 0, 0); \
        __builtin_amdgcn_global_load_lds((const unsigned*)((const char*)(gbase) + (v1)), (LAS unsigned*)(lds + (bufoff) + ldsw + 8192), 16, 0, 0); } while (0)
#define PG8_LDA(dst, b, h) do { _Pragma("unroll") for (int m = 0; m < 4; ++m) _Pragma("unroll") for (int k = 0; k < 2; ++k) dst[m][k] = *(const LAS bf16x8*)(lds + PG8_SA(b, h) + aoff + m * 2048 + k * 1024); } while (0)
#define PG8_LDB(dst, b, h) do { _Pragma("unroll") for (int n = 0; n < 2; ++n) _Pragma("unroll") for (int k = 0; k < 2; ++k) dst[n][k] = *(const LAS bf16x8*)(lds + PG8_SB(b, h) + boff + n * 2048 + k * 1024); } while (0)
#define PG8_MMA(ai, bj, At, Bt) do { __builtin_amdgcn_s_setprio(1); _Pragma("unroll") for (int m = 0; m < 4; ++m) _Pragma("unroll") for (int n = 0; n < 2; ++n) _Pragma("unroll") for (int k = 0; k < 2; ++k) \
        acc[ai][bj][m][n] = __builtin_amdgcn_mfma_f32_16x16x32_bf16(Bt[n][k], At[m][k], acc[ai][bj][m][n], 0, 0, 0); __builtin_amdgcn_s_setprio(0); } while (0)
#define PG8_WAIT_V(n) asm volatile("s_waitcnt vmcnt(" #n ")" ::: "memory")
#define PG8_WAIT_L(n) asm volatile("s_waitcnt lgkmcnt(" #n ")" ::: "memory")
#define PG8_BAR __builtin_amdgcn_s_barrier()
#define PG8_SCHED __builtin_amdgcn_sched_barrier(0)
#define PG8_AOFFS(u, o00, o01, o10, o11) do { \
        if constexpr (GATHER) { \
            const int i00 = R0 < (u).gcnt ? (u).gidx[R0] : 0, i01 = R1 < (u).gcnt ? (u).gidx[R1] : 0; \
            const int i10 = (HALF + R0) < (u).gcnt ? (u).gidx[HALF + R0] : 0, i11 = (HALF + R1) < (u).gcnt ? (u).gidx[HALF + R1] : 0; \
            o00 = (unsigned)i00 * lda + (unsigned)C0 * 2u; o01 = (unsigned)i01 * lda + (unsigned)C1 * 2u; \
            o10 = (unsigned)i10 * lda + (unsigned)C0 * 2u; o11 = (unsigned)i11 * lda + (unsigned)C1 * 2u; \
            asm volatile("s_waitcnt vmcnt(0)" : "+v"(o00), "+v"(o01), "+v"(o10), "+v"(o11) :: "memory"); \
        } else { \
            o00 = (unsigned)R0 * lda + (unsigned)C0 * 2u; o01 = (unsigned)R1 * lda + (unsigned)C1 * 2u; \
            o10 = (unsigned)(HALF + R0) * lda + (unsigned)C0 * 2u; o11 = (unsigned)(HALF + R1) * lda + (unsigned)C1 * 2u; \
        } } while (0)
    GU cur, nxt; int ui = 0;
    if (!S.next(0, cur)) return;
    f32x4 acc[2][2][4][2];
#pragma unroll
    for (int a = 0; a < 2; ++a)
#pragma unroll
        for (int b = 0; b < 2; ++b)
#pragma unroll
            for (int m = 0; m < 4; ++m)
#pragma unroll
                for (int n = 0; n < 2; ++n) acc[a][b][m][n] = (f32x4){0.f, 0.f, 0.f, 0.f};
    bf16x8 At[4][2], B0[2][2], B1[2][2];
    const char* cA = cur.A; const char* cB = cur.B;
    unsigned c00, c01, c10, c11, n00, n01, n10, n11;
    PG8_AOFFS(cur, c00, c01, c10, c11);
    PG8_STAGE(PG8_SB(0, 0), cB, vB0, vB1); PG8_STAGE(PG8_SB(0, 1), cB + hstepB, vB0, vB1); PG8_STAGE(PG8_SA(0, 0), cA, c00, c01); PG8_STAGE(PG8_SA(0, 1), cA, c10, c11);
    if (wr == 1) PG8_BAR;
    PG8_WAIT_V(2); PG8_BAR;
    PG8_STAGE(PG8_SB(1, 0), cB + kstep, vB0, vB1); PG8_STAGE(PG8_SA(1, 0), cA + kstep, c00, c01); PG8_STAGE(PG8_SB(1, 1), cB + hstepB + kstep, vB0, vB1);
    PG8_WAIT_V(6); PG8_BAR;
    for (;;) {
        const bool has_next = S.next(ui + 1, nxt);
        const char* nA = has_next ? nxt.A : cA; const char* nB = has_next ? nxt.B : cB;
        if (has_next) { PG8_AOFFS(nxt, n00, n01, n10, n11); } else { n00 = c00; n01 = c01; n10 = c10; n11 = c11; }
#pragma nounroll
        for (int t = 0; t < nt; t += 2) {
            const bool last = (t == nt - 2);
            const char* a1 = cA + (size_t)(t + 1) * kstep;
            const char* a2 = last ? nA : cA + (size_t)(t + 2) * kstep; const char* b2 = last ? nB : cB + (size_t)(t + 2) * kstep;
            const char* a3 = a2 + kstep; const char* b3 = b2 + kstep;
            const unsigned x00 = last ? n00 : c00, x01 = last ? n01 : c01, x10 = last ? n10 : c10, x11 = last ? n11 : c11;
            PG8_LDB(B0, 0, 0); PG8_LDB(B1, 0, 1); PG8_SCHED; PG8_LDA(At, 0, 0); PG8_STAGE(PG8_SA(1, 1), a1, c10, c11);
            PG8_WAIT_V(8); PG8_WAIT_L(0); PG8_BAR; PG8_MMA(0, 0, At, B0); PG8_MMA(0, 1, At, B1); PG8_BAR; PG8_SCHED;
            PG8_LDA(At, 0, 1); PG8_STAGE(PG8_SB(0, 0), b2, vB0, vB1); PG8_STAGE(PG8_SB(0, 1), b2 + hstepB, vB0, vB1); PG8_STAGE(PG8_SA(0, 0), a2, x00, x01);
            PG8_WAIT_V(8); PG8_WAIT_L(0); PG8_BAR; PG8_MMA(1, 0, At, B0); PG8_MMA(1, 1, At, B1); PG8_BAR; PG8_SCHED;
            PG8_LDB(B0, 1, 0); PG8_LDB(B1, 1, 1); PG8_SCHED; PG8_LDA(At, 1, 0); PG8_STAGE(PG8_SA(0, 1), a2, x10, x11);
            PG8_WAIT_V(8); PG8_WAIT_L(0); PG8_BAR; PG8_MMA(0, 0, At, B0); PG8_MMA(0, 1, At, B1); PG8_BAR; PG8_SCHED;
            PG8_LDA(At, 1, 1); PG8_STAGE(PG8_SB(1, 0), b3, vB0, vB1); PG8_STAGE(PG8_SB(1, 1), b3 + hstepB, vB0, vB1); PG8_STAGE(PG8_SA(1, 0), a3, x00, x01);
            PG8_WAIT_V(8); PG8_WAIT_L(0); PG8_BAR; PG8_MMA(1, 0, At, B0); PG8_MMA(1, 1, At, B1); PG8_BAR; PG8_SCHED;
        }
        if constexpr (ALIGN_EPI) { if (wr == 0) PG8_BAR; }
        E(acc, cur, wr, wc, fr, fq);
        if (!has_next) break;
#pragma unroll
        for (int a = 0; a < 2; ++a)
#pragma unroll
            for (int b = 0; b < 2; ++b)
#pragma unroll
                for (int m = 0; m < 4; ++m)
#pragma unroll
                    for (int n = 0; n < 2; ++n) acc[a][b][m][n] = (f32x4){0.f, 0.f, 0.f, 0.f};
        cur = nxt; cA = nA; cB = nB; c00 = n00; c01 = n01; c10 = n10; c11 = n11; ++ui;
        if constexpr (ALIGN_EPI) { if (wr == 1) PG8_BAR; }
    }
    PG8_WAIT_V(0);
    if constexpr (!ALIGN_EPI) { if (wr == 0) PG8_BAR; }
    PG8_BAR;
#undef PG8_SA
#undef PG8_SB
#undef PG8_STAGE
#undef PG8_LDA
#undef PG8_LDB
#undef PG8_MMA
#undef PG8_WAIT_V
#undef PG8_WAIT_L
#undef PG8_BAR
#undef PG8_SCHED
#undef PG8_AOFFS
}
}
namespace pg8 {
typedef const f32x4 (&AccRef)[2][2][4][2];
__device__ __forceinline__ u32x4 pack8(f32x4 a, f32x4 b) { u32x4 w; w.x = cvt_pk_bf16(a[0], a[1]); w.y = cvt_pk_bf16(a[2], a[3]); w.z = cvt_pk_bf16(b[0], b[1]); w.w = cvt_pk_bf16(b[2], b[3]); return w; }
__device__ __forceinline__ void unpack8(u32x4 w, f32x4& a, f32x4& b) { a = (f32x4){bf_lo(w.x), bf_hi(w.x), bf_lo(w.y), bf_hi(w.y)}; b = (f32x4){bf_lo(w.z), bf_hi(w.z), bf_lo(w.w), bf_hi(w.w)}; }

struct EpiInProj {
    unsigned char* ws; const float* rcos;
    __device__ __forceinline__ void operator()(AccRef acc, const GU& un, int wr, int wc, int fr, int fq) const {
        const int pn = un.pn; const int row0 = un.pm * BM + wr * 64 + fr;
        if (pn < 4) {
            const float* rsin = rcos + SEQ * 32;
            bf16_t* dst = (bf16_t*)(ws + WS_Q + (size_t)(pn >> 1) * (16 * MiB)); const int dcol = (4 * (pn & 1) + wc) * 64 + 8 * fq;
#pragma unroll
            for (int ai = 0; ai < 2; ++ai)
#pragma unroll
                for (int m = 0; m < 4; ++m) {
                    const int row = row0 + ai * HALF + m * 16; const int pos = row & (SEQ - 1);
                    const f32x4 c0 = *(const f32x4*)(rcos + pos * 32 + 8 * fq), c1 = *(const f32x4*)(rcos + pos * 32 + 8 * fq + 4);
                    const f32x4 s0 = *(const f32x4*)(rsin + pos * 32 + 8 * fq), s1 = *(const f32x4*)(rsin + pos * 32 + 8 * fq + 4);
                    const f32x4 a0 = acc[ai][0][m][0], a1 = acc[ai][0][m][1], b0 = acc[ai][1][m][0], b1 = acc[ai][1][m][1];
                    const f32x4 o0 = a0 * c0 - b0 * s0, o1 = a1 * c1 - b1 * s1, p0 = b0 * c0 + a0 * s0, p1 = b1 * c1 + a1 * s1;
                    bf16_t* rp = dst + (size_t)row * AW + dcol;
                    *(u32x4*)rp = pack8(o0, o1); *(u32x4*)(rp + 32) = pack8(p0, p1);
                }
        } else {
            static_assert(WS_K == WS_Q + 16 * MiB && WS_VG == WS_U + 32 * MiB && WS_GA == WS_U + 64 * MiB && WS_GB == WS_U + 96 * MiB, "in-proj output map");
            const int grp = (pn - 6) >> 2;
            bf16_t* dst = (bf16_t*)(ws + (pn < 6 ? WS_V : WS_U + (size_t)grp * (32 * MiB)));
            const int ldc = pn < 6 ? AW : GW; const int ct = pn < 6 ? pn - 4 : (pn - 6) & 3; const int act = pn < 6 ? 0 : (pn < 14 ? 1 : 2);
            const int col0 = ct * BM + wc * 32 + 8 * fq;
#pragma unroll
            for (int ai = 0; ai < 2; ++ai)
#pragma unroll
                for (int m = 0; m < 4; ++m) {
                    bf16_t* rp = dst + (size_t)(row0 + ai * HALF + m * 16) * ldc + col0;
#pragma unroll
                    for (int bj = 0; bj < 2; ++bj) {
                        f32x4 v0 = acc[ai][bj][m][0], v1 = acc[ai][bj][m][1];
                        if (act == 1) { f32x2 a = gelu_pk((f32x2){v0[0], v0[1]}), b = gelu_pk((f32x2){v0[2], v0[3]}), c = gelu_pk((f32x2){v1[0], v1[1]}), d = gelu_pk((f32x2){v1[2], v1[3]});
                            v0 = (f32x4){a.x, a.y, b.x, b.y}; v1 = (f32x4){c.x, c.y, d.x, d.y}; }
                        else if (act == 2) {
#pragma unroll
                            for (int j = 0; j < 4; ++j) { v0[j] = fast_sigmoid(v0[j]); v1[j] = fast_sigmoid(v1[j]); } }
                        *(u32x4*)(rp + bj * HALF) = pack8(v0, v1);
                    }
                }
        }
    }
};
template <bool ROWSCALE> struct EpiBf16 {
    bf16_t* O; int ldc; const float* roww;
    __device__ __forceinline__ void operator()(AccRef acc, const GU& un, int wr, int wc, int fr, int fq) const {
        const int row0 = un.pm * BM + wr * 64 + fr; const int col0 = un.pn * BM + wc * 32 + 8 * fq;
#pragma unroll
        for (int ai = 0; ai < 2; ++ai)
#pragma unroll
            for (int m = 0; m < 4; ++m) {
                const int row = row0 + ai * HALF + m * 16; bf16_t* rp = O + (size_t)row * ldc + col0;
                float s = 1.f; if constexpr (ROWSCALE) s = roww[row];
#pragma unroll
                for (int bj = 0; bj < 2; ++bj) *(u32x4*)(rp + bj * HALF) = pack8(acc[ai][bj][m][0] * s, acc[ai][bj][m][1] * s);
            }
    }
};
struct EpiDown {
    bf16_t* O;
    __device__ __forceinline__ void operator()(AccRef acc, const GU& un, int wr, int wc, int fr, int fq) const {
        const int r0 = wr * 64 + fr; const int col0 = un.pn * BM + wc * 32 + 8 * fq; const float* wts = (const float*)un.gidx;
#pragma unroll
        for (int ai = 0; ai < 2; ++ai)
#pragma unroll
            for (int m = 0; m < 4; ++m) {
                const int r = r0 + ai * HALF + m * 16; bf16_t* rp = O + (size_t)(un.pm * BM + r) * DM + col0;
                const float s = r < un.gcnt ? wts[r] : 0.f;
#pragma unroll
                for (int bj = 0; bj < 2; ++bj) *(u32x4*)(rp + bj * HALF) = pack8(acc[ai][bj][m][0] * s, acc[ai][bj][m][1] * s);
            }
    }
};
template <bool ADD> struct EpiGate {
    bf16_t* O; const bf16_t* G;
    __device__ __forceinline__ void operator()(AccRef acc, const GU& un, int wr, int wc, int fr, int fq) const {
        const int row0 = un.pm * BM + wr * 64 + fr; const int col0 = un.pn * BM + wc * 32 + 8 * fq;
#pragma unroll
        for (int ai = 0; ai < 2; ++ai)
#pragma unroll
            for (int m = 0; m < 4; ++m) {
                const size_t off = (size_t)(row0 + ai * HALF + m * 16) * DM + col0;
#pragma unroll
                for (int bj = 0; bj < 2; ++bj) {
                    f32x4 g0, g1; unpack8(*(const u32x4*)(G + off + bj * HALF), g0, g1);
                    f32x4 v0 = acc[ai][bj][m][0] * g0, v1 = acc[ai][bj][m][1] * g1;
                    if constexpr (ADD) { f32x4 p0, p1; unpack8(*(const u32x4*)(O + off + bj * HALF), p0, p1); v0 += p0; v1 += p1; }
                    *(u32x4*)(O + off + bj * HALF) = pack8(v0, v1);
                }
            }
    }
};
struct EpiRouterShared {
    float* logits; bf16_t* shid;
    __device__ __forceinline__ void operator()(AccRef acc, const GU& un, int wr, int wc, int fr, int fq) const {
        const int row0 = un.pm * BM + wr * 64 + fr;
        if (un.pn == 0) {
#pragma unroll
            for (int ai = 0; ai < 2; ++ai)
#pragma unroll
                for (int m = 0; m < 4; ++m) { float* rp = logits + (size_t)(row0 + ai * HALF + m * 16) * NE + wc * 32 + 8 * fq;
#pragma unroll
                    for (int bj = 0; bj < 2; ++bj) { *(f32x4*)(rp + bj * HALF) = acc[ai][bj][m][0]; *(f32x4*)(rp + bj * HALF + 4) = acc[ai][bj][m][1]; } }
        } else {
            const int col0 = (un.pn - 1) * HALF + wc * 32 + 8 * fq;
#pragma unroll
            for (int ai = 0; ai < 2; ++ai)
#pragma unroll
                for (int m = 0; m < 4; ++m) {
                    f32x4 h0, h1;
#pragma unroll
                    for (int j = 0; j < 4; ++j) { const float g0 = acc[ai][0][m][0][j], g1 = acc[ai][0][m][1][j];
                        h0[j] = g0 * fast_sigmoid(g0) * acc[ai][1][m][0][j]; h1[j] = g1 * fast_sigmoid(g1) * acc[ai][1][m][1][j]; }
                    *(u32x4*)(shid + (size_t)(row0 + ai * HALF + m * 16) * SD + col0) = pack8(h0, h1);
                }
        }
    }
};
struct EpiGateUp {
    bf16_t* hid;
    __device__ __forceinline__ void operator()(AccRef acc, const GU& un, int wr, int wc, int fr, int fq) const {
        const int row0 = un.pm * BM + wr * 64 + fr; const int col0 = un.pn * HALF + wc * 32 + 8 * fq;
#pragma unroll
        for (int ai = 0; ai < 2; ++ai)
#pragma unroll
            for (int m = 0; m < 4; ++m) {
                f32x4 h0, h1;
#pragma unroll
                for (int j = 0; j < 4; ++j) { const float g0 = acc[ai][0][m][0][j], g1 = acc[ai][0][m][1][j];
                    h0[j] = g0 * fast_sigmoid(g0) * acc[ai][1][m][0][j]; h1[j] = g1 * fast_sigmoid(g1) * acc[ai][1][m][1][j]; }
                *(u32x4*)(hid + (size_t)(row0 + ai * HALF + m * 16) * ED + col0) = pack8(h0, h1);
            }
    }
};

struct GroupedOrder {
    int G, c, NPN, ntiles; const LAS unsigned short* tile_e; const LAS unsigned short* tstart; const unsigned* cnt;
    const char* Abase; size_t a_tile_stride;
    const char* Bbase; size_t b_exp_stride, b_tile_stride;
    const int* idxbase;
    bool gather;
    __device__ bool next(int i, GU& u) const {
        const long L = (long)i * G + c; const int tile = (int)(L / NPN);
        if (tile >= ntiles) return false;
        const int pn = (int)(L % NPN); const int e = tile_e[tile]; const int mt = tile - tstart[e];
        u.pm = tile; u.pn = pn; u.e = e; u.gcnt = (int)cnt[e] - mt * BM; u.gidx = idxbase + (size_t)e * BUCKET + mt * BM;
        u.A = gather ? Abase : Abase + (size_t)tile * a_tile_stride;
        u.B = Bbase + (size_t)e * b_exp_stride + (size_t)pn * b_tile_stride;
        return true;
    }
};
}
constexpr int RING_BYTES = 131072;
constexpr int L_TILE_E = RING_BYTES;
constexpr int L_TSTART = L_TILE_E + 1536;
constexpr int L_MISC = L_TSTART + 512;
constexpr int LDS_BYTES = 147456;

struct Frame {
    LAS unsigned char* lds; volatile LAS unsigned* MISC; gu32* ctl;
    int tid, lane, wave, vcu, G;
};
struct Args { const float* in[24]; float* out; unsigned char* ws; int ph_lo, ph_hi; };
#define WSP(T_, off) ((T_*)(A.ws + (off)))

__device__ __forceinline__ void cvt_item(const float* W, int ldsrc, int s0, int k0, bf16_t* WT, int Kdst, int dst_row0, LAS float* scr, int lane) {
#pragma unroll 8
    for (int i = 0; i < 32; ++i) { const int kk = 2 * i + (lane >> 5); scr[kk * 33 + (lane & 31)] = W[(size_t)(k0 + kk) * ldsrc + s0 + (lane & 31)]; }
    LDS_WAIT(); asm volatile("" ::: "memory");
    const int c = lane & 7;
#pragma unroll
    for (int j = 0; j < 4; ++j) { const int n = (lane >> 3) + 8 * j; const LAS float* s = scr + (8 * c) * 33 + n;
        u32x4 o; o.x = cvt_pk_bf16(s[0 * 33], s[1 * 33]); o.y = cvt_pk_bf16(s[2 * 33], s[3 * 33]); o.z = cvt_pk_bf16(s[4 * 33], s[5 * 33]); o.w = cvt_pk_bf16(s[6 * 33], s[7 * 33]);
        *(u32x4*)(WT + (size_t)(dst_row0 + n) * Kdst + k0 + 8 * c) = o; }
    LDS_WAIT(); asm volatile("" ::: "memory");
}
__device__ __forceinline__ void cvt_gu_item(const float* Wg, const float* Wu, bf16_t* WT, int item, LAS float* scr, int lane) {
    const int kb = item >> 4, rb = item & 15; const int p = rb >> 3, bj = (rb >> 2) & 1, q = rb & 3;
    cvt_item(bj ? Wu : Wg, 256, 128 * p + 32 * q, 64 * kb, WT, 1024, 32 * rb, scr, lane);
}

__device__ __forceinline__ void p0_phase(Frame& F, const Args& A) {
    const float* c = A.in[1]; const float* w_ada = A.in[2]; const float* b_ada = A.in[3];
    float* mod = WSP(float, WS_MOD);
    if (blockIdx.x < 192) {
        LAS float* sc = (LAS float*)F.lds;
        LAS float* part = (LAS float*)(F.lds + 32768);
        for (int i = F.tid; i < NB * DM; i += NTHR) { const float v = c[i]; sc[i] = v / (1.f + expf(-v)); }
        __syncthreads();
        const int j0 = blockIdx.x * 32, col = F.lane & 31, kpar = F.lane >> 5;
        float acc[NB];
#pragma unroll
        for (int b = 0; b < NB; ++b) acc[b] = 0.f;
        for (int i = 0; i < 64; ++i) { const int k = F.wave * 128 + 2 * i + kpar; const float w = w_ada[(size_t)k * (6 * DM) + j0 + col];
#pragma unroll
            for (int b = 0; b < NB; ++b) acc[b] += sc[b * DM + k] * w; }
#pragma unroll
        for (int b = 0; b < NB; ++b) { acc[b] += __shfl_xor(acc[b], 32); if (F.lane < 32) part[(F.wave * NB + b) * 32 + col] = acc[b]; }
        __syncthreads();
        if (F.tid < 256) { const int b = F.tid >> 5, cc = F.tid & 31; float s = b_ada[j0 + cc];
#pragma unroll
            for (int w = 0; w < 8; ++w) s += part[(w * NB + b) * 32 + cc];
            mod[b * 6 * DM + j0 + cc] = s; }
        __syncthreads();
    }
    { const int gt = blockIdx.x * NTHR + F.tid;
      if (gt < SEQ * 32) { const int pos = gt >> 5, f = gt & 31; const float inv = powf(10000.f, -(float)f / 32.f); float sn, cs; sincosf((float)pos * inv, &sn, &cs);
          WSP(float, WS_ROPE)[gt] = cs; WSP(float, WS_ROPE)[SEQ * 32 + gt] = sn; } }
    LAS float* scr = (LAS float*)(F.lds + F.wave * 16384);
    const int gw = F.vcu * NWAVES + F.wave, NGW = F.G * NWAVES;
    constexpr int I_IN = 16 * 176, I_PA = 8 * 32, I_PB = 16 * 32, I_OUT = 16 * 32, I_RS = 16 * 24, I_SD = 4 * 32;
    constexpr int NIT = I_IN + I_PA + I_PB + I_OUT + I_RS + I_SD;
    for (int it = gw; it < NIT; it += NGW) {
        int r = it;
        if (r < I_IN) { const int kb = r / 176, rb = r % 176; const int pn = rb >> 3, blk = rb & 7; int s0;
            if (pn < 4) { const int base = (pn < 2) ? 0 : AW; s0 = base + (4 * (pn & 1) + (blk & 3)) * 64 + 32 * (blk >> 2); } else s0 = 32 * rb;
            cvt_item(A.in[4], INW, s0, 64 * kb, WSP(bf16_t, WS_WIN), DM, 32 * rb, scr, F.lane); continue; } r -= I_IN;
        if (r < I_PA) { cvt_item(A.in[9], DM, 32 * (r & 31), 64 * (r >> 5), WSP(bf16_t, WS_WPA), AW, 32 * (r & 31), scr, F.lane); continue; } r -= I_PA;
        if (r < I_PB) { cvt_item(A.in[10], DM, 32 * (r & 31), 64 * (r >> 5), WSP(bf16_t, WS_WPB), GW, 32 * (r & 31), scr, F.lane); continue; } r -= I_PB;
        if (r < I_OUT) { cvt_item(A.in[11], DM, 32 * (r & 31), 64 * (r >> 5), WSP(bf16_t, WS_WOUT), DM, 32 * (r & 31), scr, F.lane); continue; } r -= I_OUT;
        if (r < I_RS) { const int kb = r / 24, rb = r % 24;
            if (rb < 8) cvt_item(A.in[14], NE, 32 * rb, 64 * kb, WSP(bf16_t, WS_WRS), DM, 32 * rb, scr, F.lane);
            else cvt_gu_item(A.in[19], A.in[20], WSP(bf16_t, WS_WRS) + (size_t)256 * DM, kb * 16 + (rb - 8), scr, F.lane);
            continue; } r -= I_RS;
        cvt_item(A.in[21], DM, 32 * (r & 31), 64 * (r >> 5), WSP(bf16_t, WS_WSD), SD, 32 * (r & 31), scr, F.lane);
    }
}
__device__ __forceinline__ void p1_phase(Frame& F, const Args& A) {
    const int gw = F.vcu * NWAVES + F.wave, NGW = F.G * NWAVES;
    const float* x = A.in[0]; const float* mod = WSP(float, WS_MOD); bf16_t* h = WSP(bf16_t, WS_H);
    for (int m = gw; m < T; m += NGW) {
        const float* md = mod + (m / SEQ) * 6 * DM; const f32x4* xr = (const f32x4*)(x + (size_t)m * DM) + F.lane; u32x2* o8 = (u32x2*)(h + (size_t)m * DM) + F.lane;
#pragma unroll
        for (int j = 0; j < 4; ++j) { const f32x4 v = xr[64 * j]; const f32x4 sh = *((const f32x4*)md + F.lane + 64 * j), sc = *((const f32x4*)(md + DM) + F.lane + 64 * j);
            const f32x4 r = v * (sc + 1.f) + sh; u32x2 w; w.x = cvt_pk_bf16(r[0], r[1]); w.y = cvt_pk_bf16(r[2], r[3]); o8[64 * j] = w; }
    }
    LAS float* scr = (LAS float*)(F.lds + F.wave * 16384);
    constexpr int I_GU = 256, I_D = 128, I_E = I_GU + I_D;
    for (int it = gw; it < NE * I_E; it += NGW) {
        const int e = it / I_E, r = it % I_E;
        if (r < I_GU) cvt_gu_item(A.in[16] + (size_t)e * DM * ED, A.in[17] + (size_t)e * DM * ED, WSP(bf16_t, WS_WGU) + (size_t)e * 512 * DM, r, scr, F.lane);
        else { const int q = r - I_GU; cvt_item(A.in[18] + (size_t)e * ED * DM, DM, 32 * (q & 31), 64 * (q >> 5), WSP(bf16_t, WS_WD) + (size_t)e * DM * ED, ED, 32 * (q & 31), scr, F.lane); }
    }
}

__device__ __forceinline__ s16x4 tr_read(const LAS unsigned char* p) { return __builtin_bit_cast(s16x4, __builtin_amdgcn_ds_read_tr16_b64_v4i16((LAS s16x4*)p)); }
__device__ __forceinline__ void attn_unit(Frame& F, const Args& A, int u) {
    LAS unsigned char* Qs = F.lds; LAS unsigned char* Ks = F.lds + 16384; LAS unsigned char* Vs = F.lds + 49152;
    const int p = u >> 10, bh = (u & 1023) >> 4, cls = u & 15; const int b = bh >> 3, h = bh & 7;
    int d, r, n; if (p == 0) { d = 1; r = 0; n = cls; } else if (p == 1) { d = 4; r = cls & 3; n = cls >> 2; } else { d = 16; r = cls; n = 0; }
    const bf16_t* Q = WSP(bf16_t, WS_Q); const bf16_t* K = WSP(bf16_t, WS_K); const bf16_t* V = WSP(bf16_t, WS_V);
    const int tid = F.tid, lane = F.lane, w = F.wave, g = lane >> 4, li = lane & 15;
    const size_t tb = (size_t)b * SEQ;
#pragma unroll
    for (int i = 0; i < 4; ++i) { const int idx = tid + NTHR * i, row = idx >> 3, c = idx & 7; const int ci = (n - 1) * 128 + row;
        u32x4 kv = (u32x4){0u, 0u, 0u, 0u}, vv = kv;
        if (ci >= 0) { const size_t off = (tb + (size_t)ci * d + r) * AW + h * HD + c * 8; kv = *(const u32x4*)(K + off); vv = *(const u32x4*)(V + off); }
        const int lo = row * 128 + ((c ^ (row & 7)) << 4); *(LAS u32x4*)(Ks + lo) = kv; *(LAS u32x4*)(Vs + lo) = vv; }
#pragma unroll
    for (int i = 0; i < 2; ++i) { const int idx = tid + NTHR * i, row = idx >> 3, c = idx & 7;
        const size_t off = (tb + (size_t)(n * 128 + row) * d + r) * AW + h * HD + c * 8;
        *(LAS u32x4*)(Qs + row * 128 + ((c ^ (row & 7)) << 4)) = *(const u32x4*)(Q + off); }
    __syncthreads();
    bf16x8 qf[2];
    { const int row = 16 * w + li;
#pragma unroll
      for (int ks = 0; ks < 2; ++ks) qf[ks] = *(const LAS bf16x8*)(Qs + row * 128 + (((4 * ks + g) ^ (row & 7)) << 4)); }
    f32x4 s[9];
#pragma unroll
    for (int kt = 0; kt < 9; ++kt) { const int krow = 16 * (w + kt) + li; f32x4 a = (f32x4){0.f, 0.f, 0.f, 0.f};
#pragma unroll
        for (int ks = 0; ks < 2; ++ks) { const bf16x8 kf = *(const LAS bf16x8*)(Ks + krow * 128 + (((4 * ks + g) ^ (krow & 7)) << 4)); a = __builtin_amdgcn_mfma_f32_16x16x32_bf16(kf, qf[ks], a, 0, 0, 0); }
        s[kt] = a; }
    float mx = -INFINITY;
#pragma unroll
    for (int kt = 0; kt < 9; ++kt)
#pragma unroll
        for (int rr = 0; rr < 4; ++rr) { const int kk = 16 * kt + 4 * g + rr; const int kj = 16 * w + kk;
            const bool ok = (kk >= li) && (kk <= li + 128) && (n > 0 || kj >= 128);
            const float v = ok ? s[kt][rr] : -INFINITY; s[kt][rr] = v; mx = fmaxf(mx, v); }
    mx = fmaxf(mx, __shfl_xor(mx, 16)); mx = fmaxf(mx, __shfl_xor(mx, 32));
    const float C = 0.125f * 1.4426950408889634f; float ls = 0.f;
#pragma unroll
    for (int kt = 0; kt < 9; ++kt)
#pragma unroll
        for (int rr = 0; rr < 4; ++rr) { const float e = __builtin_amdgcn_exp2f((s[kt][rr] - mx) * C); s[kt][rr] = e; ls += e; }
    ls += __shfl_xor(ls, 16); ls += __shfl_xor(ls, 32);
    f32x4 o[4];
#pragma unroll
    for (int nt = 0; nt < 4; ++nt) o[nt] = (f32x4){0.f, 0.f, 0.f, 0.f};
    const int q4 = li >> 2, p4 = li & 3;
#pragma unroll
    for (int k2 = 0; k2 < 5; ++k2) {
        const int t0 = 2 * k2, t1 = 2 * k2 + 1;
        u32x4 pw; pw.x = cvt_pk_bf16(s[t0][0], s[t0][1]); pw.y = cvt_pk_bf16(s[t0][2], s[t0][3]);
        if (t1 < 9) { pw.z = cvt_pk_bf16(s[t1 < 9 ? t1 : 8][0], s[t1 < 9 ? t1 : 8][1]); pw.w = cvt_pk_bf16(s[t1 < 9 ? t1 : 8][2], s[t1 < 9 ? t1 : 8][3]); } else { pw.z = 0u; pw.w = 0u; }
        const bf16x8 pa = __builtin_bit_cast(bf16x8, pw);
        int KT1 = w + t1; if (KT1 > 15) KT1 = 15;
        const int r0 = 16 * (w + t0) + 4 * g + q4, r1 = 16 * KT1 + 4 * g + q4;
#pragma unroll
        for (int nt = 0; nt < 4; ++nt) { const int ch = 2 * nt + (p4 >> 1);
            const s16x4 lo = tr_read(Vs + r0 * 128 + ((ch ^ (r0 & 7)) << 4) + (p4 & 1) * 8), hi = tr_read(Vs + r1 * 128 + ((ch ^ (r1 & 7)) << 4) + (p4 & 1) * 8);
            const bf16x8 vb = (bf16x8){lo[0], lo[1], lo[2], lo[3], hi[0], hi[1], hi[2], hi[3]};
            o[nt] = __builtin_amdgcn_mfma_f32_16x16x32_bf16(pa, vb, o[nt], 0, 0, 0); }
    }
    const float linv = 1.f / ls;
    LAS bf16_t* st = (LAS bf16_t*)(Qs + 16 * w * 128);
#pragma unroll
    for (int rr = 0; rr < 4; ++rr) { const float sc = __shfl(linv, 4 * g + rr);
#pragma unroll
        for (int nt = 0; nt < 4; ++nt) st[(4 * g + rr) * 64 + 16 * nt + li] = (bf16_t)(cvt_pk_bf16(o[nt][rr] * sc, 0.f) & 0xffffu); }
    LDS_WAIT(); asm volatile("" ::: "memory");
    bf16_t* OP = WSP(bf16_t, WS_OP) + (size_t)p * T * AW; float* LSE = WSP(float, WS_LSE) + (size_t)p * T * NH;
#pragma unroll
    for (int i = 0; i < 2; ++i) { const int cidx = lane + 64 * i, row = cidx >> 3, c = cidx & 7;
        const size_t tok = tb + (size_t)(n * 128 + 16 * w + row) * d + r;
        *(u32x4*)(OP + tok * AW + h * HD + c * 8) = *(const LAS u32x4*)((const LAS unsigned char*)st + row * 128 + c * 16); }
    if (lane < 16) { const size_t tok = tb + (size_t)(n * 128 + 16 * w + li) * d + r; LSE[tok * NH + h] = mx * 0.125f + logf(ls); }
    __syncthreads();
}
__device__ __forceinline__ void sgu_unit(Frame& F, const Args& A, int u) {
    LAS unsigned char* Ws = F.lds; LAS unsigned char* Vn = F.lds + 32768; LAS f32x2* stats = (LAS f32x2*)(F.lds + 65536);
    const int g = u & 7, bc = u >> 3; const size_t t0 = (size_t)bc * 128;
    const bf16_t* VG = WSP(bf16_t, WS_VG); const bf16_t* U = WSP(bf16_t, WS_U); bf16_t* SG = WSP(bf16_t, WS_SG);
    const float* lng = A.in[5]; const float* lnb = A.in[6]; const float* wsp = A.in[7] + (size_t)g * 128 * 128; const float* bsp = A.in[8] + g * 128;
    const int tid = F.tid, lane = F.lane, w = F.wave, g4 = lane >> 4, li = lane & 15;
    { const int row = tid >> 2, qd = tid & 3; const u32x4* pr = (const u32x4*)(VG + (t0 + row) * GW + qd * 256); float s1 = 0.f, s2 = 0.f;
#pragma unroll 8
      for (int i = 0; i < 32; ++i) { const u32x4 v = pr[i];
#pragma unroll
          for (int j = 0; j < 4; ++j) { const float a = bf_lo(v[j]), c = bf_hi(v[j]); s1 += a + c; s2 += a * a + c * c; } }
      s1 += __shfl_xor(s1, 1); s2 += __shfl_xor(s2, 1); s1 += __shfl_xor(s1, 2); s2 += __shfl_xor(s2, 2);
      const float mean = s1 * (1.f / 1024.f); const float var = fmaxf(s2 * (1.f / 1024.f) - mean * mean, 0.f);
      if (qd == 0) stats[row] = (f32x2){mean, 1.f / sqrtf(var + LN_EPS)}; }
#pragma unroll
    for (int i = 0; i < 8; ++i) { const int idx = tid + NTHR * i, trow = idx >> 5, c4 = idx & 31; f32x4 v = *(const f32x4*)(wsp + trow * 128 + c4 * 4);
#pragma unroll
        for (int j = 0; j < 4; ++j) if (4 * c4 + j > trow) v[j] = 0.f;
        u32x2 o; o.x = cvt_pk_bf16(v[0], v[1]); o.y = cvt_pk_bf16(v[2], v[3]);
        *(LAS u32x2*)(Ws + trow * 256 + (((c4 >> 1) ^ (trow & 15)) << 4) + (c4 & 1) * 8) = o; }
    __syncthreads();
#pragma unroll
    for (int i = 0; i < 4; ++i) { const int idx = tid + NTHR * i, srow = idx >> 4, c16 = idx & 15; const int ch0 = g * 128 + c16 * 8;
        const u32x4 v = *(const u32x4*)(VG + (t0 + srow) * GW + ch0); const f32x2 st = stats[srow];
        const f32x4 ga = *(const f32x4*)(lng + ch0), gb = *(const f32x4*)(lng + ch0 + 4), ba = *(const f32x4*)(lnb + ch0), bb = *(const f32x4*)(lnb + ch0 + 4);
        f32x4 x0, x1; pg8::unpack8(v, x0, x1);
        x0 = (x0 - st.x) * st.y * ga + ba; x1 = (x1 - st.x) * st.y * gb + bb;
        *(LAS u32x4*)(Vn + srow * 256 + ((c16 ^ (srow & 15)) << 4)) = pg8::pack8(x0, x1); }
    __syncthreads();
    f32x4 acc[8];
#pragma unroll
    for (int nt = 0; nt < 8; ++nt) acc[nt] = (f32x4){0.f, 0.f, 0.f, 0.f};
    const int nks = (w >> 1) + 1; const int arow = 16 * w + li; const int q4 = li >> 2, p4 = li & 3;
    for (int ks = 0; ks < nks; ++ks) {
        const bf16x8 af = *(const LAS bf16x8*)(Ws + arow * 256 + (((4 * ks + g4) ^ (arow & 15)) << 4));
        const int r0 = 32 * ks + 8 * g4 + q4, r1 = r0 + 4;
#pragma unroll
        for (int nt = 0; nt < 8; ++nt) { const int ch = 2 * nt + (p4 >> 1);
            const s16x4 lo = tr_read(Vn + r0 * 256 + ((ch ^ (r0 & 15)) << 4) + (p4 & 1) * 8), hi = tr_read(Vn + r1 * 256 + ((ch ^ (r1 & 15)) << 4) + (p4 & 1) * 8);
            const bf16x8 vb = (bf16x8){lo[0], lo[1], lo[2], lo[3], hi[0], hi[1], hi[2], hi[3]};
            acc[nt] = __builtin_amdgcn_mfma_f32_16x16x32_bf16(af, vb, acc[nt], 0, 0, 0); }
    }
    LAS bf16_t* st = (LAS bf16_t*)(Ws + 16 * w * 256);
#pragma unroll
    for (int rr = 0; rr < 4; ++rr) { const float bias = bsp[16 * w + 4 * g4 + rr];
#pragma unroll
        for (int nt = 0; nt < 8; ++nt) st[(4 * g4 + rr) * 128 + 16 * nt + li] = (bf16_t)(cvt_pk_bf16(acc[nt][rr] + bias, 0.f) & 0xffffu); }
    LDS_WAIT(); asm volatile("" ::: "memory");
#pragma unroll
    for (int i = 0; i < 4; ++i) { const int cidx = lane + 64 * i, row = cidx >> 4, c16 = cidx & 15; const size_t off = (t0 + 16 * w + row) * GW + g * 128 + c16 * 8;
        f32x4 a0, a1, u0, u1; pg8::unpack8(*(const LAS u32x4*)((const LAS unsigned char*)st + row * 256 + c16 * 16), a0, a1); pg8::unpack8(*(const u32x4*)(U + off), u0, u1);
        *(u32x4*)(SG + off) = pg8::pack8(a0 * u0, a1 * u1); }
    __syncthreads();
}
__device__ __forceinline__ void p4_phase(Frame& F, const Args& A) {
    const bf16_t* OP = WSP(bf16_t, WS_OP); const float* LSE = WSP(float, WS_LSE); bf16_t* OA = WSP(bf16_t, WS_OA);
    for (int idx = F.vcu * NTHR + F.tid; idx < T * 64; idx += F.G * NTHR) {
        const int t = idx >> 6, h = (idx >> 3) & 7, c = idx & 7;
        const float l0 = LSE[(size_t)t * NH + h], l1 = LSE[(size_t)(T + t) * NH + h], l2 = LSE[(size_t)(2 * T + t) * NH + h];
        const float m = fmaxf(l0, fmaxf(l1, l2)); float w0 = expf(l0 - m), w1 = expf(l1 - m), w2 = expf(l2 - m); const float inv = 1.f / (w0 + w1 + w2); w0 *= inv; w1 *= inv; w2 *= inv;
        const size_t off = (size_t)t * AW + h * HD + c * 8;
        f32x4 a0, a1, b0, b1, c0, c1; pg8::unpack8(*(const u32x4*)(OP + off), a0, a1); pg8::unpack8(*(const u32x4*)(OP + (size_t)T * AW + off), b0, b1); pg8::unpack8(*(const u32x4*)(OP + (size_t)2 * T * AW + off), c0, c1);
        *(u32x4*)(OA + off) = pg8::pack8(a0 * w0 + b0 * w1 + c0 * w2, a1 * w0 + b1 * w1 + c1 * w2);
    }
}
__device__ __forceinline__ void p7_phase(Frame& F, const Args& A) {
    const int gw = F.vcu * NWAVES + F.wave, NGW = F.G * NWAVES;
    const float* x = A.in[0]; const float* mod = WSP(float, WS_MOD); const bf16_t* mix = WSP(bf16_t, WS_MIX); float* x1 = WSP(float, WS_X1); bf16_t* h2 = WSP(bf16_t, WS_H);
    const float* g1 = A.in[12]; const float* b1 = A.in[13];
    for (int m = gw; m < T; m += NGW) {
        const float* md = mod + (m / SEQ) * 6 * DM; const f32x4* xr = (const f32x4*)(x + (size_t)m * DM) + F.lane; const u32x2* mr = (const u32x2*)(mix + (size_t)m * DM) + F.lane;
        f32x4 v[4]; float s = 0.f;
#pragma unroll
        for (int j = 0; j < 4; ++j) { const f32x4 xv = xr[64 * j]; const u32x2 mw = mr[64 * j]; const f32x4 gv = *((const f32x4*)(md + 2 * DM) + F.lane + 64 * j);
            const f32x4 mv = (f32x4){bf_lo(mw.x), bf_hi(mw.x), bf_lo(mw.y), bf_hi(mw.y)};
            v[j] = xv * ALPHA + gv * mv; s += (v[j][0] + v[j][1]) + (v[j][2] + v[j][3]); }
        const float mean = wave_sum(s) * (1.f / DM); float s2 = 0.f;
#pragma unroll
        for (int j = 0; j < 4; ++j) { v[j] = v[j] - mean; s2 += (v[j][0] * v[j][0] + v[j][1] * v[j][1]) + (v[j][2] * v[j][2] + v[j][3] * v[j][3]); }
        const float rstd = 1.f / sqrtf(wave_sum(s2) * (1.f / DM) + LN_EPS);
        f32x4* xo = (f32x4*)(x1 + (size_t)m * DM) + F.lane; u32x2* ho = (u32x2*)(h2 + (size_t)m * DM) + F.lane;
#pragma unroll
        for (int j = 0; j < 4; ++j) { const f32x4 gg = *((const f32x4*)g1 + F.lane + 64 * j), bb = *((const f32x4*)b1 + F.lane + 64 * j);
            const f32x4 o = v[j] * rstd * gg + bb; xo[64 * j] = o;
            const f32x4 sh = *((const f32x4*)(md + 3 * DM) + F.lane + 64 * j), sc = *((const f32x4*)(md + 4 * DM) + F.lane + 64 * j);
            const f32x4 r = o * (sc + 1.f) + sh; u32x2 wv; wv.x = cvt_pk_bf16(r[0], r[1]); wv.y = cvt_pk_bf16(r[2], r[3]); ho[64 * j] = wv; }
    }
}
__device__ __forceinline__ unsigned f2ord(float f) { const unsigned u = __float_as_uint(f); return (u & 0x80000000u) ? ~u : (u | 0x80000000u); }
__device__ __forceinline__ void p9_phase(Frame& F, const Args& A) {
    const int gw = F.vcu * NWAVES + F.wave, NGW = F.G * NWAVES, lane = F.lane;
    const float* logits = WSP(float, WS_LOGITS); const float* rbias = A.in[15];
    unsigned* cnt = (unsigned*)(F.ctl + CW_CNT); int* tok_e = WSP(int, WS_TOKE); int* tok_r = WSP(int, WS_TOKR); int* btok = WSP(int, WS_BTOK); float* bw = WSP(float, WS_BW);
    const f32x4 rb = *((const f32x4*)rbias + lane);
    for (int t = gw; t < T; t += NGW) {
        const f32x4 lg = *((const f32x4*)(logits + (size_t)t * NE) + lane);
        f32x4 sc, bi;
#pragma unroll
        for (int i = 0; i < 4; ++i) { sc[i] = 1.f / (1.f + expf(-lg[i])); bi[i] = sc[i] + rb[i]; }
        float m1 = fmaxf(bi[0], bi[1]), m2 = fminf(bi[0], bi[1]);
#pragma unroll
        for (int i = 2; i < 4; ++i) { const float v = bi[i]; m2 = fmaxf(m2, fminf(m1, v)); m1 = fmaxf(m1, v); }
#pragma unroll
        for (int o = 1; o < 8; o <<= 1) { const float o1 = __shfl_xor(m1, o), o2 = __shfl_xor(m2, o); const float n1 = fmaxf(m1, o1), n2 = fmaxf(fminf(m1, o1), fmaxf(m2, o2)); m1 = n1; m2 = n2; }
        const float gs = m1 + m2; const int grp = lane >> 3; int rank = 0;
#pragma unroll
        for (int gg = 0; gg < 8; ++gg) { const float v = __shfl(gs, 8 * gg); rank += (v > gs || (v == gs && gg < grp)) ? 1 : 0; }
        const bool sel = rank < 4;
        unsigned long long key[4];
#pragma unroll
        for (int i = 0; i < 4; ++i) key[i] = sel ? (((unsigned long long)f2ord(bi[i]) << 32) | (unsigned)(255 - (4 * lane + i))) : 0ull;
        int my_e = 0; float my_s = 0.f, wsum = 0.f;
#pragma unroll
        for (int r = 0; r < TOPK; ++r) {
            unsigned long long k = key[0] > key[1] ? key[0] : key[1]; { const unsigned long long k2 = key[2] > key[3] ? key[2] : key[3]; k = k > k2 ? k : k2; }
#pragma unroll
            for (int o = 1; o < 64; o <<= 1) { const unsigned long long ok = __shfl_xor(k, o); k = ok > k ? ok : k; }
            const int e = 255 - (int)(k & 0xffull); const int owner = e >> 2, sub = e & 3;
            const float sv = (sub == 0) ? sc[0] : (sub == 1) ? sc[1] : (sub == 2) ? sc[2] : sc[3];
            const float ssel = __shfl(sv, owner);
            if (lane == owner) {
#pragma unroll
                for (int i = 0; i < 4; ++i) if (i == sub) key[i] = 0ull; }
            wsum += ssel; if (lane == r) { my_e = e; my_s = ssel; }
        }
        if (lane < TOPK) {
            const float wv = 2.5f * my_s / wsum;
            const unsigned rk = atomicAdd(&cnt[my_e], 1u);
            tok_e[t * TOPK + lane] = my_e; tok_r[t * TOPK + lane] = (int)rk;
            if (rk < (unsigned)BUCKET) { btok[(size_t)my_e * BUCKET + rk] = t; bw[(size_t)my_e * BUCKET + rk] = wv; }
        }
    }
}
__device__ __forceinline__ void build_tile_table(Frame& F, const Args& A) {
    LAS unsigned short* tile_e = (LAS unsigned short*)(F.lds + L_TILE_E); LAS unsigned short* tstart = (LAS unsigned short*)(F.lds + L_TSTART);
    const unsigned* cnt = (const unsigned*)(F.ctl + CW_CNT);
    __syncthreads();
    int val = 0, incl = 0;
    if (F.tid < NE) { unsigned c = __hip_atomic_load(cnt + F.tid, RLX_AGENT); if (c > (unsigned)BUCKET) c = BUCKET; val = (int)((c + 255u) >> 8); incl = val;
#pragma unroll
        for (int o = 1; o < 64; o <<= 1) { const int v = __shfl_up(incl, o); if (F.lane >= o) incl += v; }
        if (F.lane == 63) F.MISC[F.wave] = (unsigned)incl; }
    __syncthreads();
    if (F.tid < NE) { int off = 0;
#pragma unroll
        for (int w = 0; w < 4; ++w) if (w < F.wave) off += (int)F.MISC[w];
        const int st = off + incl - val; tstart[F.tid] = (unsigned short)st;
        for (int k = 0; k < val; ++k) tile_e[st + k] = (unsigned short)F.tid;
        if (F.tid == NE - 1) F.MISC[4] = (unsigned)(off + incl); }
    __syncthreads();
}
__device__ __forceinline__ void p12_phase(Frame& F, const Args& A) {
    const int gw = F.vcu * NWAVES + F.wave, NGW = F.G * NWAVES;
    const LAS unsigned short* tstart = (const LAS unsigned short*)(F.lds + L_TSTART);
    const float* mod = WSP(float, WS_MOD); const float* x1 = WSP(float, WS_X1); const bf16_t* ysh = WSP(bf16_t, WS_YSH); const bf16_t* yrow = WSP(bf16_t, WS_YROW);
    const int* tok_e = WSP(int, WS_TOKE); const int* tok_r = WSP(int, WS_TOKR); const float* g2 = A.in[22]; const float* b2 = A.in[23]; float* out = A.out;
    for (int m = gw; m < T; m += NGW) {
        const float* md = mod + (m / SEQ) * 6 * DM;
        f32x4 f[4];
        { const u32x2* sr = (const u32x2*)(ysh + (size_t)m * DM) + F.lane;
#pragma unroll
          for (int j = 0; j < 4; ++j) { const u32x2 w = sr[64 * j]; f[j] = (f32x4){bf_lo(w.x), bf_hi(w.x), bf_lo(w.y), bf_hi(w.y)}; } }
#pragma unroll
        for (int k = 0; k < TOPK; ++k) { const int e = tok_e[m * TOPK + k], rk = tok_r[m * TOPK + k]; const size_t pos = (size_t)tstart[e] * 256 + rk;
            const u32x2* yr = (const u32x2*)(yrow + pos * DM) + F.lane;
#pragma unroll
            for (int j = 0; j < 4; ++j) { const u32x2 w = yr[64 * j]; f[j] += (f32x4){bf_lo(w.x), bf_hi(w.x), bf_lo(w.y), bf_hi(w.y)}; } }
        const f32x4* xr = (const f32x4*)(x1 + (size_t)m * DM) + F.lane; f32x4 v[4]; float s = 0.f;
#pragma unroll
        for (int j = 0; j < 4; ++j) { const f32x4 gv = *((const f32x4*)(md + 5 * DM) + F.lane + 64 * j); v[j] = xr[64 * j] * ALPHA + gv * f[j]; s += (v[j][0] + v[j][1]) + (v[j][2] + v[j][3]); }
        const float mean = wave_sum(s) * (1.f / DM); float s2 = 0.f;
#pragma unroll
        for (int j = 0; j < 4; ++j) { v[j] = v[j] - mean; s2 += (v[j][0] * v[j][0] + v[j][1] * v[j][1]) + (v[j][2] * v[j][2] + v[j][3] * v[j][3]); }
        const float rstd = 1.f / sqrtf(wave_sum(s2) * (1.f / DM) + LN_EPS);
        f32x4* oo = (f32x4*)(out + (size_t)m * DM) + F.lane;
#pragma unroll
        for (int j = 0; j < 4; ++j) { const f32x4 gg = *((const f32x4*)g2 + F.lane + 64 * j), bb = *((const f32x4*)b2 + F.lane + 64 * j); oo[64 * j] = v[j] * rstd * gg + bb; }
    }
}
constexpr int NPHASE = 13;

__global__ void __launch_bounds__(NTHR, 2) mk_fwd(Args args) {
    extern __shared__ __attribute__((aligned(16))) unsigned char lds_raw[];
    Frame F;
    F.lds = (LAS unsigned char*)lds_raw; F.MISC = (volatile LAS unsigned*)(F.lds + L_MISC);
    F.tid = threadIdx.x; F.lane = F.tid & 63; F.wave = __builtin_amdgcn_readfirstlane(F.tid >> 6);
    F.G = gridDim.x; { const int bx = blockIdx.x; F.vcu = (F.G % 8 == 0) ? (bx % 8) * (F.G / 8) + bx / 8 : bx; }
    const Args& A = args;
    F.ctl = (gu32*)(args.ws + WS_CTL);
    if (F.tid < 64) F.MISC[F.tid] = 0u;
    __syncthreads();
    const int lo = args.ph_lo, hi = args.ph_hi;
    XcdBarrier bar; bar.bar = (unsigned*)(F.ctl + CW_BAR); bar.x = 0; bar.st = nullptr;
    if (hi - lo > 1) bar = xcd_barrier_post((unsigned*)(F.ctl + CW_BAR), F.MISC + 8);
#define IN(k) (lo <= (k) && (k) < hi)
#define SEAM(k) do { if (IN(k) && IN((k) + 1)) xcd_barrier(bar); } while (0)
    LAS unsigned char* ring = F.lds;

    if (IN(0)) { p0_phase(F, A); } SEAM(0);
    if (IN(1)) { p1_phase(F, A); } SEAM(1);
    if (IN(2)) {
        pg8::StaticOrder S; S.init(WSP(bf16_t, WS_H), WSP(bf16_t, WS_WIN), T, INW, DM * 2, DM * 2, F.G, (int)blockIdx.x);
        pg8::EpiInProj E{A.ws, WSP(float, WS_ROPE)};
        pg8::gemm_phase<pg8::EpiInProj, pg8::StaticOrder, false, true>(ring, DM, DM * 2, DM * 2, S, E);
    } SEAM(2);
    if (IN(3)) { for (int u = F.vcu; u < 4096; u += F.G) { if (u < 3072) attn_unit(F, A, u); else sgu_unit(F, A, u - 3072); } } SEAM(3);
    if (IN(4)) { p4_phase(F, A); } SEAM(4);
    if (IN(5)) {
        { pg8::StaticOrder S; S.init(WSP(bf16_t, WS_OA), WSP(bf16_t, WS_WPA), T, DM, AW * 2, AW * 2, F.G, (int)blockIdx.x);
          pg8::EpiGate<false> E{WSP(bf16_t, WS_MERGED), WSP(bf16_t, WS_GA)};
          pg8::gemm_phase<pg8::EpiGate<false>, pg8::StaticOrder, false, false>(ring, AW, AW * 2, AW * 2, S, E); }
        { pg8::StaticOrder S; S.init(WSP(bf16_t, WS_SG), WSP(bf16_t, WS_WPB), T, DM, GW * 2, GW * 2, F.G, (int)blockIdx.x);
          pg8::EpiGate<true> E{WSP(bf16_t, WS_MERGED), WSP(bf16_t, WS_GB)};
          pg8::gemm_phase<pg8::EpiGate<true>, pg8::StaticOrder, false, false>(ring, GW, GW * 2, GW * 2, S, E); }
    } SEAM(5);
    if (IN(6)) {
        pg8::StaticOrder S; S.init(WSP(bf16_t, WS_MERGED), WSP(bf16_t, WS_WOUT), T, DM, DM * 2, DM * 2, F.G, (int)blockIdx.x);
        pg8::EpiBf16<false> E{WSP(bf16_t, WS_MIX), DM, nullptr};
        pg8::gemm_phase<pg8::EpiBf16<false>, pg8::StaticOrder, false, false>(ring, DM, DM * 2, DM * 2, S, E);
    } SEAM(6);
    if (IN(7)) { p7_phase(F, A); } SEAM(7);
    if (IN(8)) {
        pg8::StaticOrder S; S.init(WSP(bf16_t, WS_H), WSP(bf16_t, WS_WRS), T, 768, DM * 2, DM * 2, F.G, (int)blockIdx.x);
        pg8::EpiRouterShared E{WSP(float, WS_LOGITS), WSP(bf16_t, WS_SHID)};
        pg8::gemm_phase<pg8::EpiRouterShared, pg8::StaticOrder, false, true>(ring, DM, DM * 2, DM * 2, S, E);
    } SEAM(8);
    if (IN(9)) { p9_phase(F, A); } SEAM(9);
    if (IN(10)) {
        build_tile_table(F, A);
        pg8::GroupedOrder S; S.G = F.G; S.c = F.vcu; S.NPN = 2; S.ntiles = (int)F.MISC[4]; S.tile_e = (const LAS unsigned short*)(F.lds + L_TILE_E); S.tstart = (const LAS unsigned short*)(F.lds + L_TSTART);
        S.cnt = (const unsigned*)(F.ctl + CW_CNT); S.Abase = (const char*)WSP(bf16_t, WS_H); S.a_tile_stride = 0; S.Bbase = (const char*)WSP(bf16_t, WS_WGU); S.b_exp_stride = (size_t)512 * DM * 2; S.b_tile_stride = (size_t)256 * DM * 2;
        S.idxbase = WSP(int, WS_BTOK); S.gather = true;
        pg8::EpiGateUp E{WSP(bf16_t, WS_HID)};
        pg8::gemm_phase<pg8::EpiGateUp, pg8::GroupedOrder, true, true>(ring, DM, DM * 2, DM * 2, S, E);
    } SEAM(10);
    if (IN(11)) {
        build_tile_table(F, A);
        { pg8::GroupedOrder S; S.G = F.G; S.c = F.vcu; S.NPN = 4; S.ntiles = (int)F.MISC[4]; S.tile_e = (const LAS unsigned short*)(F.lds + L_TILE_E); S.tstart = (const LAS unsigned short*)(F.lds + L_TSTART);
          S.cnt = (const unsigned*)(F.ctl + CW_CNT); S.Abase = (const char*)WSP(bf16_t, WS_HID); S.a_tile_stride = (size_t)256 * ED * 2; S.Bbase = (const char*)WSP(bf16_t, WS_WD); S.b_exp_stride = (size_t)DM * ED * 2; S.b_tile_stride = (size_t)256 * ED * 2;
          S.idxbase = WSP(int, WS_BW); S.gather = false;
          pg8::EpiDown E{WSP(bf16_t, WS_YROW)};
          pg8::gemm_phase<pg8::EpiDown, pg8::GroupedOrder, false, true>(ring, ED, ED * 2, ED * 2, S, E); }
        { pg8::StaticOrder S; S.init(WSP(bf16_t, WS_SHID), WSP(bf16_t, WS_WSD), T, DM, SD * 2, SD * 2, F.G, (int)blockIdx.x);
          pg8::EpiBf16<false> E{WSP(bf16_t, WS_YSH), DM, nullptr};
          pg8::gemm_phase<pg8::EpiBf16<false>, pg8::StaticOrder, false, false>(ring, SD, SD * 2, SD * 2, S, E); }
    } SEAM(11);
    if (IN(12)) { build_tile_table(F, A); p12_phase(F, A); }
#undef IN
#undef SEAM
}

#ifndef MK_SPLIT
#define MK_SPLIT 0
#endif
static int mk_grid(size_t ws_size) {
    static int grid = 0;
    if (grid == 0) {
        int dev = 0, cus = 0, per_cu = 0;
        if (ws_size < WS_END) { fprintf(stderr, "kernel_launch: workspace too small (%zu < %zu)\n", ws_size, (size_t)WS_END); grid = -1; return -1; }
        if (hipGetDevice(&dev) != hipSuccess || hipDeviceGetAttribute(&cus, hipDeviceAttributeMultiprocessorCount, dev) != hipSuccess) { grid = -1; return -1; }
        if (hipFuncSetAttribute((const void*)mk_fwd, hipFuncAttributeMaxDynamicSharedMemorySize, LDS_BYTES) != hipSuccess) { fprintf(stderr, "kernel_launch: hipFuncSetAttribute failed\n"); grid = -1; return -1; }
        if (hipOccupancyMaxActiveBlocksPerMultiprocessor(&per_cu, (const void*)mk_fwd, NTHR, LDS_BYTES) != hipSuccess || per_cu < 1) { fprintf(stderr, "kernel_launch: occupancy query says %d blocks/CU\n", per_cu); (void)hipGetLastError(); grid = -1; return -1; }
        grid = cus;
    }
    return grid;
}
static void mk_run(void* const* d_in, float* out, void* d_ws, int grid, int lo, int hi, hipStream_t stream) {
    Args a{};
    for (int i = 0; i < 24; ++i) a.in[i] = (const float*)d_in[i];
    a.out = out; a.ws = (unsigned char*)d_ws; a.ph_lo = lo; a.ph_hi = hi;
    if (hi - lo > 1) {
        void* kargs[] = {&a};
        hipError_t e = hipLaunchCooperativeKernel((const void*)mk_fwd, dim3(grid), dim3(NTHR), kargs, LDS_BYTES, stream);
        if (e != hipSuccess) fprintf(stderr, "kernel_launch: cooperative launch failed: %s (grid %d)\n", hipGetErrorString(e), grid);
    } else {
        hipLaunchKernelGGL(mk_fwd, dim3(grid), dim3(NTHR), LDS_BYTES, stream, a);
    }
}
static int mk_launch(void* const* d_in, float* out, void* d_ws, size_t ws_size, hipStream_t stream) {
    const int grid = mk_grid(ws_size);
    if (grid < 0) return -1;
    (void)hipMemsetAsync((char*)d_ws + WS_CTL, 0, CTL_ZERO_BYTES, stream);
#if MK_SPLIT
    for (int p = 0; p < NPHASE; ++p) mk_run(d_in, out, d_ws, grid, p, p + 1, stream);
#else
    mk_run(d_in, out, d_ws, grid, 0, NPHASE, stream);
#endif
    return 0;
}
extern "C" void kernel_launch(void* const* d_in, const int* in_sizes, int n_in, void* d_out, int out_size, void* d_ws, size_t ws_size, hipStream_t stream) {
    (void)in_sizes; (void)n_in; (void)out_size;
#if PROBE
    probe::run(d_in, d_out, d_ws, ws_size, stream);
#else
    mk_launch(d_in, (float*)d_out, d_ws, ws_size, stream);
#endif
}
```

```cpp
#define PROBE 0
#define PROBE_STAGE -1
#define MK_SPLIT 0
#define REPEAT_MASK 0
#define EXTRA_PHASE -1
#define MK_COOP 1
#include <hip/hip_runtime.h>
#include <math.h>
#include <stdint.h>
#include <cstdio>

#define LAS __attribute__((address_space(3)))
#define GAS __attribute__((address_space(1)))
typedef unsigned short bf16_t;
typedef short bf16x8 __attribute__((ext_vector_type(8)));
typedef short s16x4 __attribute__((ext_vector_type(4)));
typedef float f32x4 __attribute__((ext_vector_type(4)));
typedef float f32x2 __attribute__((ext_vector_type(2)));
typedef unsigned u32x4 __attribute__((ext_vector_type(4)));
typedef unsigned u32x2 __attribute__((ext_vector_type(2)));
typedef GAS unsigned gu32;

constexpr int NB = 8, SEQ = 2048, DM = 1024, T = NB * SEQ;
constexpr int NH = 8, HD = 64, AW = 512, GW = 1024, INW = 5632;
constexpr int NE = 256, TOPK = 8, ED = 256, SD = 256;
constexpr float ALPHA = 1.189207115002721f;
constexpr float LN_EPS = 1e-5f;
constexpr int NWAVES = 8, NTHR = 512;
constexpr int BUCKET = 16384;
constexpr int MAXTILES = 768;

constexpr size_t MiB = 1u << 20;
constexpr size_t WS_CTL = 0, CTL_ZERO_BYTES = 64 * 1024;
constexpr size_t WS_MOD = 1 * MiB;
constexpr size_t WS_ROPE = 1 * MiB + 256 * 1024;
constexpr size_t WS_WPA = 2 * MiB, WS_WPB = 3 * MiB, WS_WOUT = 5 * MiB, WS_WRS = 7 * MiB, WS_WSD = 8 * MiB + 512 * 1024;
constexpr size_t WS_WD = 10 * MiB;
constexpr size_t WS_X1 = 138 * MiB;
constexpr size_t WS_HID = 202 * MiB;
constexpr size_t WS_SHID = 298 * MiB;
constexpr size_t WS_YSH = 306 * MiB;
constexpr size_t WS_TOKE = 338 * MiB, WS_TOKR = WS_TOKE + 512 * 1024, WS_TOKW = WS_TOKR + 512 * 1024;
constexpr size_t WS_BTOK = 340 * MiB, WS_BW = 356 * MiB;
constexpr size_t WS_D = 372 * MiB;
constexpr size_t WS_YROW = WS_D;
constexpr size_t WS_WGU = 372 * MiB;
constexpr size_t WS_WIN = 628 * MiB;
constexpr size_t WS_H = 640 * MiB;
constexpr size_t WS_OP = 628 * MiB, WS_LSE = 676 * MiB;
constexpr size_t WS_Q = 678 * MiB, WS_K = 694 * MiB, WS_V = 710 * MiB;
constexpr size_t WS_MERGED = 678 * MiB;
constexpr size_t WS_U = 726 * MiB, WS_VG = 758 * MiB;
constexpr size_t WS_MIX = 726 * MiB;
constexpr size_t WS_LOGITS = 758 * MiB;
constexpr size_t WS_GA = 790 * MiB, WS_GB = 822 * MiB;
constexpr size_t WS_OA = 854 * MiB, WS_SG = 870 * MiB;
constexpr size_t WS_END = 902 * MiB;
constexpr size_t WS_GOLD = 960 * MiB;
constexpr int CW_BAR = 1024;
constexpr int CW_CNT = 8192;

#define RLX_AGENT __ATOMIC_RELAXED, __HIP_MEMORY_SCOPE_AGENT
#define LDS_WAIT() asm volatile("s_waitcnt lgkmcnt(0)" ::: "memory")
#define VM_WAIT() asm volatile("s_waitcnt vmcnt(0)" ::: "memory")
__device__ __forceinline__ unsigned cvt_pk_bf16(float lo, float hi) { unsigned r; asm volatile("v_cvt_pk_bf16_f32 %0, %1, %2" : "=v"(r) : "v"(lo), "v"(hi)); return r; }
__device__ __forceinline__ float bf_lo(unsigned u) { return __uint_as_float(u << 16); }
__device__ __forceinline__ float bf_hi(unsigned u) { return __uint_as_float(u & 0xffff0000u); }
__device__ __forceinline__ float wave_sum(float v) {
#pragma unroll
    for (int o = 1; o < 64; o <<= 1) v += __shfl_xor(v, o);
    return v;
}
__device__ __forceinline__ float fast_sigmoid(float x) { return __builtin_amdgcn_rcpf(1.f + __builtin_amdgcn_exp2f(-1.4426950408889634f * x)); }
__device__ __forceinline__ f32x2 gelu_pk(f32x2 v) {
    const f32x2 av = __builtin_elementwise_abs(v), d = av * 0.2316418882f + 1.0f;
    f32x2 t; t.x = __builtin_amdgcn_rcpf(d.x); t.y = __builtin_amdgcn_rcpf(d.y);
    f32x2 q = t * 0.5307027145f + (-0.7265760135f); q = q * t + 0.7107068705f; q = q * t + (-0.142248368f); q = q * t + 0.127414796f; q = q * t;
    const f32x2 s = (v * v) * (-0.72134752044f);
    f32x2 e; e.x = __builtin_amdgcn_exp2f(s.x); e.y = __builtin_amdgcn_exp2f(s.y);
    const f32x2 m = v * (q * e), r = v - m;
    f32x2 o; o.x = v.x < 0.f ? m.x : r.x; o.y = v.y < 0.f ? m.y : r.y; return o;
}

#define XB_TMO      128
#define XB_XCNT(j)  (256  + 64 * (j))
#define XB_XSUB(j)  (1280 + 64 * (j))
#define XB_XGEN(j)  (2304 + 64 * (j))
#define XB_TOP      3328
#define XB_TOPGEN   3392
#define XCD_BAR_WORDS 3456
#define XB_SPIN_CAP (1u << 18)
__device__ __forceinline__ unsigned xb_ld(unsigned* p)              { return __hip_atomic_load(p, __ATOMIC_RELAXED, __HIP_MEMORY_SCOPE_AGENT); }
__device__ __forceinline__ unsigned xb_add(unsigned* p, unsigned v) { return __hip_atomic_fetch_add(p, v, __ATOMIC_RELAXED, __HIP_MEMORY_SCOPE_AGENT); }
__device__ __forceinline__ unsigned xb_xcc_id() { return (unsigned)__builtin_amdgcn_s_getreg((3 << 11) | 20) & 0xFu; }
#define XB_SPIN(cond, bar) do { unsigned _sp = 0; while (cond) { __builtin_amdgcn_s_sleep(1); \
    if ((++_sp & 255u) == 0u) { if (xb_ld(&(bar)[XB_TMO])) break; if (_sp > XB_SPIN_CAP) { atomicAdd(&(bar)[XB_TMO], 1u); break; } } } } while (0)
struct XcdBarrier { unsigned* bar; unsigned x; volatile LAS unsigned* st; };
__device__ __forceinline__ XcdBarrier xcd_barrier_post(unsigned* bar, volatile LAS unsigned* st) {
    XcdBarrier b; b.bar = bar; b.x = xb_xcc_id(); b.st = st;
    if (threadIdx.x == 0) (void)xb_add(&bar[XB_XCNT(b.x)], 1u);
    return b;
}
__device__ __forceinline__ void xcd_barrier_complete(unsigned* bar, unsigned x, unsigned& nloc, unsigned& nx) {
    const unsigned G = gridDim.x * gridDim.y * gridDim.z;
    unsigned sum, cnt, mine, sp = 0u;
    for (;;) {
        sum = 0u; cnt = 0u; mine = 0u;
#pragma unroll
        for (unsigned j = 0; j < 16; ++j) { const unsigned c = xb_ld(&bar[XB_XCNT(j)]); sum += c; cnt += (c > 0u) ? 1u : 0u; mine = (j == x) ? c : mine; }
        if (sum == G) break;
        __builtin_amdgcn_s_sleep(1);
        if ((++sp & 255u) == 0u) { if (xb_ld(&bar[XB_TMO])) break; if (sp > XB_SPIN_CAP) { atomicAdd(&bar[XB_TMO], 1u); break; } }
    }
    nloc = mine > 0u ? mine : 1u; nx = cnt > 0u ? cnt : 1u;
}
__device__ __forceinline__ void xcd_barrier(const XcdBarrier& b) {
    asm volatile("s_waitcnt vmcnt(0)" ::: "memory");
    __syncthreads();
    if (threadIdx.x == 0) {
        unsigned* bar = b.bar;
        __builtin_amdgcn_s_waitcnt(0);
        unsigned nloc = b.st[0], nx = b.st[1];
        if (nloc == 0u) { xcd_barrier_complete(bar, b.x, nloc, nx); b.st[0] = nloc; b.st[1] = nx; }
        const unsigned old = xb_add(&bar[XB_XSUB(b.x)], 1u);
        const unsigned gen = old / nloc;
        if (old + 1u == (gen + 1u) * nloc) {
            __builtin_amdgcn_fence(__ATOMIC_RELEASE, "agent");
            asm volatile("s_waitcnt vmcnt(0)" ::: "memory");
            const unsigned og = xb_add(&bar[XB_TOP], 1u);
            const unsigned tg = og / nx;
            if (og + 1u == (tg + 1u) * nx) xb_add(&bar[XB_TOPGEN], 1u);
            else XB_SPIN(xb_ld(&bar[XB_TOPGEN]) == tg, bar);
            __builtin_amdgcn_fence(__ATOMIC_ACQUIRE, "agent");
            xb_add(&bar[XB_XGEN(b.x)], 1u);
            asm volatile("s_waitcnt vmcnt(0)" ::: "memory");
        } else {
            XB_SPIN(xb_ld(&bar[XB_XGEN(b.x)]) == gen, bar);
            __builtin_amdgcn_fence(__ATOMIC_ACQUIRE, "agent");
            asm volatile("s_waitcnt vmcnt(0)" ::: "memory");
        }
    }
    __syncthreads();
}

namespace pg8 {
constexpr int BM = 256, BK = 64, HALF = 128, HTB = HALF * BK * 2, STAGE_BYTES = 8 * HTB, NXCD = 8, WGM = 8;
__host__ __device__ __forceinline__ int lds_byte(int r, int c) { const int st = (r >> 4) * 2 + (c >> 5), rr = r & 15, cc = c & 31, ob = rr * 64 + cc * 2; return st * 1024 + (ob ^ (((ob >> 9) & 1) << 5)); }
__host__ __device__ __forceinline__ void stage_rc(int b, int& R, int& C) { const int st = b / 1024, sb = b % 1024, swz = sb ^ (((sb >> 9) & 1) << 5); R = (st >> 1) * 16 + swz / 64; C = (st & 1) * 32 + (swz % 64) / 2; }
__host__ __device__ __forceinline__ int perm32(int rho) { const int n = rho >> 4, i = rho & 15; return 8 * (i >> 2) + 4 * n + (i & 3); }

struct GU { const char* A; const char* B; const int* gidx; int gcnt; int pm, pn, e; };

struct StaticOrder {
    int nM, nN, nwg, G, c; const char* A; const char* B; size_t tstepA, tstepB;
    __device__ void init(const void* A_, const void* B_, int M, int N, unsigned lda, unsigned ldb, int G_, int c_) { nM = M / BM; nN = N / BM; nwg = nM * nN; G = G_; c = c_; A = (const char*)A_; B = (const char*)B_; tstepA = (size_t)BM * lda; tstepB = (size_t)BM * ldb; }
    __device__ bool next(int i, GU& u) const {
        const long L = (long)i * G + c; if (L >= nwg) return false;
        int wgid = (int)L; { const int q = nwg / NXCD, r = nwg % NXCD, xcd = wgid % NXCD, off = wgid / NXCD; wgid = (xcd < r ? xcd * (q + 1) : r * (q + 1) + (xcd - r) * q) + off; }
        const int nig = WGM * nN, gid = wgid / nig, fm = gid * WGM, gsz = (nM - fm) < WGM ? (nM - fm) : WGM;
        u.pm = fm + ((wgid % nig) % gsz); u.pn = (wgid % nig) / gsz; u.e = 0; u.gidx = nullptr; u.gcnt = 0;
        u.A = A + (size_t)u.pm * tstepA; u.B = B + (size_t)u.pn * tstepB; return true;
    }
};

template <class Epi, class Sched, bool GATHER, bool ALIGN_EPI>
__device__ __forceinline__ void gemm_phase(LAS unsigned char* lds, const int K, const unsigned lda, const unsigned ldb, const Sched& S, const Epi& E) {
    const int tid = threadIdx.x, wid = __builtin_amdgcn_readfirstlane(tid >> 6), lane = tid & 63, wr = wid >> 2, wc = wid & 3, fr = lane & 15, fq = lane >> 4;
    const int nt = K / BK;
    int R0, C0, R1, C1; stage_rc(tid * 16, R0, C0); stage_rc(tid * 16 + 8192, R1, C1);
    const int Rb0 = (R0 & ~31) + perm32(R0 & 31), Rb1 = (R1 & ~31) + perm32(R1 & 31);
    const unsigned vB0 = (unsigned)Rb0 * ldb + (unsigned)C0 * 2u, vB1 = (unsigned)Rb1 * ldb + (unsigned)C1 * 2u;
    const size_t kstep = (size_t)(BK * 2);
    const size_t hstepB = (size_t)HALF * ldb;
    const unsigned ldsw = (unsigned)wid * 1024u;
    const int aoff = lds_byte(wr * 64 + fr, fq * 8), boff = lds_byte(wc * 32 + fr, fq * 8);
#define PG8_SA(b, h) (((b) * 2 + (h)) * HTB)
#define PG8_SB(b, h) ((4 + (b) * 2 + (h)) * HTB)
#define PG8_STAGE(bufoff, gbase, v0, v1) do { \
        __builtin_amdgcn_global_load_lds((const unsigned*)((const char*)(gbase) + (v0)), (LAS unsigned*)(lds + (bufoff) + ldsw), 16, 0, 0); \
        __builtin_amdgcn_global_load_lds((const unsigned*)((const char*)(gbase) + (v1)), (LAS unsigned*)(lds + (bufoff) + ldsw + 8192), 16, 0, 0); } while (0)
#define PG8_LDA(dst, b, h) do { _Pragma("unroll") for (int m = 0; m < 4; ++m) _Pragma("unroll") for (int k = 0; k < 2; ++k) dst[m][k] = *(const LAS bf16x8*)(lds + PG8_SA(b, h) + aoff + m * 2048 + k * 1024); } while (0)
#define PG8_LDB(dst, b, h) do { _Pragma("unroll") for (int n = 0; n < 2; ++n) _Pragma("unroll") for (int k = 0; k < 2; ++k) dst[n][k] = *(const LAS bf16x8*)(lds + PG8_SB(b, h) + boff + n * 2048 + k * 1024); } while (0)
#define PG8_MMA(ai, bj, At, Bt) do { __builtin_amdgcn_s_setprio(1); _Pragma("unroll") for (int m = 0; m < 4; ++m) _Pragma("unroll") for (int n = 0; n < 2; ++n) _Pragma("unroll") for (int k = 0; k < 2; ++k) \
        acc[ai][bj][m][n] = __builtin_amdgcn_mfma_f32_16x16x32_bf16(Bt[n][k], At[m][k], acc[ai][bj][m][n], 0, 0, 0); __builtin_amdgcn_s_setprio(0); } while (0)
#define PG8_WAIT_V(n) asm volatile("s_waitcnt vmcnt(" #n ")" ::: "memory")
#define PG8_WAIT_L(n) asm volatile("s_waitcnt lgkmcnt(" #n ")" ::: "memory")
#define PG8_BAR __builtin_amdgcn_s_barrier()
#define PG8_SCHED __builtin_amdgcn_sched_barrier(0)
#define PG8_AOFFS(u, o00, o01, o10, o11) do { \
        if constexpr (GATHER) { \
            const int i00 = R0 < (u).gcnt ? (u).gidx[R0] : 0, i01 = R1 < (u).gcnt ? (u).gidx[R1] : 0; \
            const int i10 = (HALF + R0) < (u).gcnt ? (u).gidx[HALF + R0] : 0, i11 = (HALF + R1) < (u).gcnt ? (u).gidx[HALF + R1] : 0; \
            o00 = (unsigned)i00 * lda + (unsigned)C0 * 2u; o01 = (unsigned)i01 * lda + (unsigned)C1 * 2u; \
            o10 = (unsigned)i10 * lda + (unsigned)C0 * 2u; o11 = (unsigned)i11 * lda + (unsigned)C1 * 2u; \
            asm volatile("s_waitcnt vmcnt(0)" : "+v"(o00), "+v"(o01), "+v"(o10), "+v"(o11) :: "memory"); \
        } else { \
            o00 = (unsigned)R0 * lda + (unsigned)C0 * 2u; o01 = (unsigned)R1 * lda + (unsigned)C1 * 2u; \
            o10 = (unsigned)(HALF + R0) * lda + (unsigned)C0 * 2u; o11 = (unsigned)(HALF + R1) * lda + (unsigned)C1 * 2u; \
        } } while (0)
    GU cur, nxt; int ui = 0;
    if (!S.next(0, cur)) return;
    f32x4 acc[2][2][4][2];
#pragma unroll
    for (int a = 0; a < 2; ++a)
#pragma unroll
        for (int b = 0; b < 2; ++b)
#pragma unroll
            for (int m = 0; m < 4; ++m)
#pragma unroll
                for (int n = 0; n < 2; ++n) acc[a][b][m][n] = (f32x4){0.f, 0.f, 0.f, 0.f};
    bf16x8 At[4][2], B0[2][2], B1[2][2];
    const char* cA = cur.A; const char* cB = cur.B;
    unsigned c00, c01, c10, c11, n00, n01, n10, n11;
    PG8_AOFFS(cur, c00, c01, c10, c11);
    PG8_STAGE(PG8_SB(0, 0), cB, vB0, vB1); PG8_STAGE(PG8_SB(0, 1), cB + hstepB, vB0, vB1); PG8_STAGE(PG8_SA(0, 0), cA, c00, c01); PG8_STAGE(PG8_SA(0, 1), cA, c10, c11);
    if (wr == 1) PG8_BAR;
    PG8_WAIT_V(2); PG8_BAR;
    PG8_STAGE(PG8_SB(1, 0), cB + kstep, vB0, vB1); PG8_STAGE(PG8_SA(1, 0), cA + kstep, c00, c01); PG8_STAGE(PG8_SB(1, 1), cB + hstepB + kstep, vB0, vB1);
    PG8_WAIT_V(6); PG8_BAR;
    for (;;) {
        const bool has_next = S.next(ui + 1, nxt);
        const char* nA = has_next ? nxt.A : cA; const char* nB = has_next ? nxt.B : cB;
        if (has_next) { PG8_AOFFS(nxt, n00, n01, n10, n11); } else { n00 = c00; n01 = c01; n10 = c10; n11 = c11; }
#pragma nounroll
        for (int t = 0; t < nt; t += 2) {
            const bool last = (t == nt - 2);
            const char* a1 = cA + (size_t)(t + 1) * kstep;
            const char* a2 = last ? nA : cA + (size_t)(t + 2) * kstep; const char* b2 = last ? nB : cB + (size_t)(t + 2) * kstep;
            const char* a3 = a2 + kstep; const char* b3 = b2 + kstep;
            const unsigned x00 = last ? n00 : c00, x01 = last ? n01 : c01, x10 = last ? n10 : c10, x11 = last ? n11 : c11;
            PG8_LDB(B0, 0, 0); PG8_LDB(B1, 0, 1); PG8_SCHED; PG8_LDA(At, 0, 0); PG8_STAGE(PG8_SA(1, 1), a1, c10, c11);
            PG8_WAIT_V(8); PG8_WAIT_L(0); PG8_BAR; PG8_MMA(0, 0, At, B0); PG8_MMA(0, 1, At, B1); PG8_BAR; PG8_SCHED;
            PG8_LDA(At, 0, 1); PG8_STAGE(PG8_SB(0, 0), b2, vB0, vB1); PG8_STAGE(PG8_SB(0, 1), b2 + hstepB, vB0, vB1); PG8_STAGE(PG8_SA(0, 0), a2, x00, x01);
            PG8_WAIT_V(8); PG8_WAIT_L(0); PG8_BAR; PG8_MMA(1, 0, At, B0); PG8_MMA(1, 1, At, B1); PG8_BAR; PG8_SCHED;
            PG8_LDB(B0, 1, 0); PG8_LDB(B1, 1, 1); PG8_SCHED; PG8_LDA(At, 1, 0); PG8_STAGE(PG8_SA(0, 1), a2, x10, x11);
            PG8_WAIT_V(8); PG8_WAIT_L(0); PG8_BAR; PG8_MMA(0, 0, At, B0); PG8_MMA(0, 1, At, B1); PG8_BAR; PG8_SCHED;
            PG8_LDA(At, 1, 1); PG8_STAGE(PG8_SB(1, 0), b3, vB0, vB1); PG8_STAGE(PG8_SB(1, 1), b3 + hstepB, vB0, vB1); PG8_STAGE(PG8_SA(1, 0), a3, x00, x01);
            PG8_WAIT_V(8); PG8_WAIT_L(0); PG8_BAR; PG8_MMA(1, 0, At, B0); PG8_MMA(1, 1, At, B1); PG8_BAR; PG8_SCHED;
        }
        if constexpr (ALIGN_EPI) { if (wr == 0) PG8_BAR; }
        E(acc, cur, wr, wc, fr, fq);
        if (!has_next) break;
#pragma unroll
        for (int a = 0; a < 2; ++a)
#pragma unroll
            for (int b = 0; b < 2; ++b)
#pragma unroll
                for (int m = 0; m < 4; ++m)
#pragma unroll
                    for (int n = 0; n < 2; ++n) acc[a][b][m][n] = (f32x4){0.f, 0.f, 0.f, 0.f};
        cur = nxt; cA = nA; cB = nB; c00 = n00; c01 = n01; c10 = n10; c11 = n11; ++ui;
        if constexpr (ALIGN_EPI) { if (wr == 1) PG8_BAR; }
    }
    PG8_WAIT_V(0);
    if constexpr (!ALIGN_EPI) { if (wr == 0) PG8_BAR; }
    PG8_BAR;
#undef PG8_SA
#undef PG8_SB
#undef PG8_STAGE
#undef PG8_LDA
#undef PG8_LDB
#undef PG8_MMA
#undef PG8_WAIT_V
#undef PG8_WAIT_L
#undef PG8_BAR
#undef PG8_SCHED
#undef PG8_AOFFS
}
}
namespace pg8 {
typedef const f32x4 (&AccRef)[2][2][4][2];
__device__ __forceinline__ u32x4 pack8(f32x4 a, f32x4 b) { u32x4 w; w.x = cvt_pk_bf16(a[0], a[1]); w.y = cvt_pk_bf16(a[2], a[3]); w.z = cvt_pk_bf16(b[0], b[1]); w.w = cvt_pk_bf16(b[2], b[3]); return w; }
__device__ __forceinline__ void unpack8(u32x4 w, f32x4& a, f32x4& b) { a = (f32x4){bf_lo(w.x), bf_hi(w.x), bf_lo(w.y), bf_hi(w.y)}; b = (f32x4){bf_lo(w.z), bf_hi(w.z), bf_lo(w.w), bf_hi(w.w)}; }

struct EpiInProj {
    unsigned char* ws; const float* rcos;
    __device__ __forceinline__ void operator()(AccRef acc, const GU& un, int wr, int wc, int fr, int fq) const {
        const int pn = un.pn; const int row0 = un.pm * BM + wr * 64 + fr;
        if (pn < 4) {
            const float* rsin = rcos + SEQ * 32;
            bf16_t* dst = (bf16_t*)(ws + WS_Q + (size_t)(pn >> 1) * (16 * MiB)); const int dcol = (4 * (pn & 1) + wc) * 64 + 8 * fq;
#pragma unroll
            for (int ai = 0; ai < 2; ++ai)
#pragma unroll
                for (int m = 0; m < 4; ++m) {
                    const int row = row0 + ai * HALF + m * 16; const int pos = row & (SEQ - 1);
                    const f32x4 c0 = *(const f32x4*)(rcos + pos * 32 + 8 * fq), c1 = *(const f32x4*)(rcos + pos * 32 + 8 * fq + 4);
                    const f32x4 s0 = *(const f32x4*)(rsin + pos * 32 + 8 * fq), s1 = *(const f32x4*)(rsin + pos * 32 + 8 * fq + 4);
                    const f32x4 a0 = acc[ai][0][m][0], a1 = acc[ai][0][m][1], b0 = acc[ai][1][m][0], b1 = acc[ai][1][m][1];
                    const f32x4 o0 = a0 * c0 - b0 * s0, o1 = a1 * c1 - b1 * s1, p0 = b0 * c0 + a0 * s0, p1 = b1 * c1 + a1 * s1;
                    bf16_t* rp = dst + (size_t)row * AW + dcol;
                    *(u32x4*)rp = pack8(o0, o1); *(u32x4*)(rp + 32) = pack8(p0, p1);
                }
        } else {
            static_assert(WS_K == WS_Q + 16 * MiB && WS_VG == WS_U + 32 * MiB && WS_GA == WS_U + 64 * MiB && WS_GB == WS_U + 96 * MiB, "in-proj output map");
            const int grp = (pn - 6) >> 2;
            bf16_t* dst = (bf16_t*)(ws + (pn < 6 ? WS_V : WS_U + (size_t)grp * (32 * MiB)));
            const int ldc = pn < 6 ? AW : GW; const int ct = pn < 6 ? pn - 4 : (pn - 6) & 3; const int act = pn < 6 ? 0 : (pn < 14 ? 1 : 2);
            const int col0 = ct * BM + wc * 32 + 8 * fq;
#pragma unroll
            for (int ai = 0; ai < 2; ++ai)
#pragma unroll
                for (int m = 0; m < 4; ++m) {
                    bf16_t* rp = dst + (size_t)(row0 + ai * HALF + m * 16) * ldc + col0;
#pragma unroll
                    for (int bj = 0; bj < 2; ++bj) {
                        f32x4 v0 = acc[ai][bj][m][0], v1 = acc[ai][bj][m][1];
                        if (act == 1) { f32x2 a = gelu_pk((f32x2){v0[0], v0[1]}), b = gelu_pk((f32x2){v0[2], v0[3]}), c = gelu_pk((f32x2){v1[0], v1[1]}), d = gelu_pk((f32x2){v1[2], v1[3]});
                            v0 = (f32x4){a.x, a.y, b.x, b.y}; v1 = (f32x4){c.x, c.y, d.x, d.y}; }
                        else if (act == 2) {
#pragma unroll
                            for (int j = 0; j < 4; ++j) { v0[j] = fast_sigmoid(v0[j]); v1[j] = fast_sigmoid(v1[j]); } }
                        *(u32x4*)(rp + bj * HALF) = pack8(v0, v1);
                    }
                }
        }
    }
};
template <bool ROWSCALE> struct EpiBf16 {
    bf16_t* O; int ldc; const float* roww;
    __device__ __forceinline__ void operator()(AccRef acc, const GU& un, int wr, int wc, int fr, int fq) const {
        const int row0 = un.pm * BM + wr * 64 + fr; const int col0 = un.pn * BM + wc * 32 + 8 * fq;
#pragma unroll
        for (int ai = 0; ai < 2; ++ai)
#pragma unroll
            for (int m = 0; m < 4; ++m) {
                const int row = row0 + ai * HALF + m * 16; bf16_t* rp = O + (size_t)row * ldc + col0;
                float s = 1.f; if constexpr (ROWSCALE) s = roww[row];
#pragma unroll
                for (int bj = 0; bj < 2; ++bj) *(u32x4*)(rp + bj * HALF) = pack8(acc[ai][bj][m][0] * s, acc[ai][bj][m][1] * s);
            }
    }
};
struct EpiDown {
    bf16_t* O;
    __device__ __forceinline__ void operator()(AccRef acc, const GU& un, int wr, int wc, int fr, int fq) const {
        const int r0 = wr * 64 + fr; const int col0 = un.pn * BM + wc * 32 + 8 * fq; const float* wts = (const float*)un.gidx;
#pragma unroll
        for (int ai = 0; ai < 2; ++ai)
#pragma unroll
            for (int m = 0; m < 4; ++m) {
                const int r = r0 + ai * HALF + m * 16; bf16_t* rp = O + (size_t)(un.pm * BM + r) * DM + col0;
                if (r < un.gcnt) { const float s = wts[r];
#pragma unroll
                for (int bj = 0; bj < 2; ++bj) *(u32x4*)(rp + bj * HALF) = pack8(acc[ai][bj][m][0] * s, acc[ai][bj][m][1] * s); }
            }
    }
};
template <bool ADD> struct EpiGate {
    bf16_t* O; const bf16_t* G;
    __device__ __forceinline__ void operator()(AccRef acc, const GU& un, int wr, int wc, int fr, int fq) const {
        const int row0 = un.pm * BM + wr * 64 + fr; const int col0 = un.pn * BM + wc * 32 + 8 * fq;
#pragma unroll
        for (int ai = 0; ai < 2; ++ai)
#pragma unroll
            for (int m = 0; m < 4; ++m) {
                const size_t off = (size_t)(row0 + ai * HALF + m * 16) * DM + col0;
#pragma unroll
                for (int bj = 0; bj < 2; ++bj) {
                    f32x4 g0, g1; unpack8(*(const u32x4*)(G + off + bj * HALF), g0, g1);
                    f32x4 v0 = acc[ai][bj][m][0] * g0, v1 = acc[ai][bj][m][1] * g1;
                    if constexpr (ADD) { f32x4 p0, p1; unpack8(*(const u32x4*)(O + off + bj * HALF), p0, p1); v0 += p0; v1 += p1; }
                    *(u32x4*)(O + off + bj * HALF) = pack8(v0, v1);
                }
            }
    }
};
struct EpiRouterShared {
    float* logits; bf16_t* shid;
    __device__ __forceinline__ void operator()(AccRef acc, const GU& un, int wr, int wc, int fr, int fq) const {
        const int row0 = un.pm * BM + wr * 64 + fr;
        if (un.pn == 0) {
#pragma unroll
            for (int ai = 0; ai < 2; ++ai)
#pragma unroll
                for (int m = 0; m < 4; ++m) { float* rp = logits + (size_t)(row0 + ai * HALF + m * 16) * NE + wc * 32 + 8 * fq;
#pragma unroll
                    for (int bj = 0; bj < 2; ++bj) { *(f32x4*)(rp + bj * HALF) = acc[ai][bj][m][0]; *(f32x4*)(rp + bj * HALF + 4) = acc[ai][bj][m][1]; } }
        } else {
            const int col0 = (un.pn - 1) * HALF + wc * 32 + 8 * fq;
#pragma unroll
            for (int ai = 0; ai < 2; ++ai)
#pragma unroll
                for (int m = 0; m < 4; ++m) {
                    f32x4 h0, h1;
#pragma unroll
                    for (int j = 0; j < 4; ++j) { const float g0 = acc[ai][0][m][0][j], g1 = acc[ai][0][m][1][j];
                        h0[j] = g0 * fast_sigmoid(g0) * acc[ai][1][m][0][j]; h1[j] = g1 * fast_sigmoid(g1) * acc[ai][1][m][1][j]; }
                    *(u32x4*)(shid + (size_t)(row0 + ai * HALF + m * 16) * SD + col0) = pack8(h0, h1);
                }
        }
    }
};
struct EpiGateUp {
    bf16_t* hid;
    __device__ __forceinline__ void operator()(AccRef acc, const GU& un, int wr, int wc, int fr, int fq) const {
        const int row0 = un.pm * BM + wr * 64 + fr; const int col0 = un.pn * HALF + wc * 32 + 8 * fq;
#pragma unroll
        for (int ai = 0; ai < 2; ++ai)
#pragma unroll
            for (int m = 0; m < 4; ++m) {
                f32x4 h0, h1;
#pragma unroll
                for (int j = 0; j < 4; ++j) { const float g0 = acc[ai][0][m][0][j], g1 = acc[ai][0][m][1][j];
                    h0[j] = g0 * fast_sigmoid(g0) * acc[ai][1][m][0][j]; h1[j] = g1 * fast_sigmoid(g1) * acc[ai][1][m][1][j]; }
                *(u32x4*)(hid + (size_t)(row0 + ai * HALF + m * 16) * ED + col0) = pack8(h0, h1);
            }
    }
};

struct GroupedOrder {
    int G, c, NPN, ntiles; const LAS unsigned short* tile_e; const LAS unsigned short* tstart; const LAS unsigned short* cnt;
    const char* Abase; size_t a_tile_stride;
    const char* Bbase; size_t b_exp_stride, b_tile_stride;
    const int* idxbase;
    bool gather;
    __device__ bool next(int i, GU& u) const {
        const long L = (long)i * G + c; const int tile = (int)(L / NPN);
        if (tile >= ntiles) return false;
        const int pn = (int)(L % NPN); const int e = tile_e[tile]; const int mt = tile - tstart[e];
        u.pm = tile; u.pn = pn; u.e = e; u.gcnt = (int)cnt[e] - mt * BM; u.gidx = idxbase + (size_t)e * BUCKET + mt * BM;
        u.A = gather ? Abase : Abase + (size_t)tile * a_tile_stride;
        u.B = Bbase + (size_t)e * b_exp_stride + (size_t)pn * b_tile_stride;
        return true;
    }
};
}
constexpr int RING_BYTES = 131072;
constexpr int L_TILE_E = RING_BYTES;
constexpr int L_TSTART = L_TILE_E + 1536;
constexpr int L_CNT = L_TSTART + 512;
constexpr int L_MISC = L_CNT + 512;
constexpr int LDS_BYTES = 147456;

struct Frame {
    LAS unsigned char* lds; volatile LAS unsigned* MISC; gu32* ctl;
    int tid, lane, wave, vcu, G;
};
struct Args { const float* in[24]; float* out; unsigned char* ws; int ph_lo, ph_hi; };
#define WSP(T_, off) ((T_*)(A.ws + (off)))

__device__ __forceinline__ void cvt_item(const float* W, int ldsrc, int s0, int k0, bf16_t* WT, int Kdst, int dst_row0, LAS float* scr, int lane) {
#pragma unroll 8
    for (int i = 0; i < 32; ++i) { const int kk = 2 * i + (lane >> 5); scr[kk * 33 + (lane & 31)] = W[(size_t)(k0 + kk) * ldsrc + s0 + (lane & 31)]; }
    LDS_WAIT(); asm volatile("" ::: "memory");
    const int c = lane & 7;
#pragma unroll
    for (int j = 0; j < 4; ++j) { const int n = (lane >> 3) + 8 * j; const LAS float* s = scr + (8 * c) * 33 + n;
        u32x4 o; o.x = cvt_pk_bf16(s[0 * 33], s[1 * 33]); o.y = cvt_pk_bf16(s[2 * 33], s[3 * 33]); o.z = cvt_pk_bf16(s[4 * 33], s[5 * 33]); o.w = cvt_pk_bf16(s[6 * 33], s[7 * 33]);
        *(u32x4*)(WT + (size_t)(dst_row0 + n) * Kdst + k0 + 8 * c) = o; }
    LDS_WAIT(); asm volatile("" ::: "memory");
}
__device__ __forceinline__ void cvt_gu_item(const float* Wg, const float* Wu, bf16_t* WT, int item, LAS float* scr, int lane) {
    const int kb = item >> 4, rb = item & 15; const int p = rb >> 3, bj = (rb >> 2) & 1, q = rb & 3;
    cvt_item(bj ? Wu : Wg, 256, 128 * p + 32 * q, 64 * kb, WT, 1024, 32 * rb, scr, lane);
}

__device__ __forceinline__ void p0_phase(Frame& F, const Args& A) {
    const float* c = A.in[1]; const float* w_ada = A.in[2]; const float* b_ada = A.in[3];
    float* mod = WSP(float, WS_MOD);
    if (blockIdx.x < 192) {
        LAS float* sc = (LAS float*)F.lds;
        LAS float* part = (LAS float*)(F.lds + 32768);
        for (int i = F.tid; i < NB * DM; i += NTHR) { const float v = c[i]; sc[i] = v / (1.f + expf(-v)); }
        __syncthreads();
        const int j0 = blockIdx.x * 32, col = F.lane & 31, kpar = F.lane >> 5;
        float acc[NB];
#pragma unroll
        for (int b = 0; b < NB; ++b) acc[b] = 0.f;
        for (int i = 0; i < 64; ++i) { const int k = F.wave * 128 + 2 * i + kpar; const float w = w_ada[(size_t)k * (6 * DM) + j0 + col];
#pragma unroll
            for (int b = 0; b < NB; ++b) acc[b] += sc[b * DM + k] * w; }
#pragma unroll
        for (int b = 0; b < NB; ++b) { acc[b] += __shfl_xor(acc[b], 32); if (F.lane < 32) part[(F.wave * NB + b) * 32 + col] = acc[b]; }
        __syncthreads();
        if (F.tid < 256) { const int b = F.tid >> 5, cc = F.tid & 31; float s = b_ada[j0 + cc];
#pragma unroll
            for (int w = 0; w < 8; ++w) s += part[(w * NB + b) * 32 + cc];
            mod[b * 6 * DM + j0 + cc] = s; }
        __syncthreads();
    }
    { const int gt = blockIdx.x * NTHR + F.tid;
      if (gt < SEQ * 32) { const int pos = gt >> 5, f = gt & 31; const float inv = powf(10000.f, -(float)f / 32.f); float sn, cs; sincosf((float)pos * inv, &sn, &cs);
          WSP(float, WS_ROPE)[gt] = cs; WSP(float, WS_ROPE)[SEQ * 32 + gt] = sn; } }
    LAS float* scr = (LAS float*)(F.lds + F.wave * 16384);
    const int gw = F.vcu * NWAVES + F.wave, NGW = F.G * NWAVES;
    constexpr int I_IN = 16 * 176, I_PA = 8 * 32, I_PB = 16 * 32, I_OUT = 16 * 32, I_RS = 16 * 24, I_SD = 4 * 32;
    constexpr int NIT = I_IN + I_PA + I_PB + I_OUT + I_RS + I_SD;
    for (int it = gw; it < NIT; it += NGW) {
        int r = it;
        if (r < I_IN) { const int kb = r / 176, rb = r % 176; const int pn = rb >> 3, blk = rb & 7; int s0;
            if (pn < 4) { const int base = (pn < 2) ? 0 : AW; s0 = base + (4 * (pn & 1) + (blk & 3)) * 64 + 32 * (blk >> 2); } else s0 = 32 * rb;
            cvt_item(A.in[4], INW, s0, 64 * kb, WSP(bf16_t, WS_WIN), DM, 32 * rb, scr, F.lane); continue; } r -= I_IN;
        if (r < I_PA) { cvt_item(A.in[9], DM, 32 * (r & 31), 64 * (r >> 5), WSP(bf16_t, WS_WPA), AW, 32 * (r & 31), scr, F.lane); continue; } r -= I_PA;
        if (r < I_PB) { cvt_item(A.in[10], DM, 32 * (r & 31), 64 * (r >> 5), WSP(bf16_t, WS_WPB), GW, 32 * (r & 31), scr, F.lane); continue; } r -= I_PB;
        if (r < I_OUT) { cvt_item(A.in[11], DM, 32 * (r & 31), 64 * (r >> 5), WSP(bf16_t, WS_WOUT), DM, 32 * (r & 31), scr, F.lane); continue; } r -= I_OUT;
        if (r < I_RS) { const int kb = r / 24, rb = r % 24;
            if (rb < 8) cvt_item(A.in[14], NE, 32 * rb, 64 * kb, WSP(bf16_t, WS_WRS), DM, 32 * rb, scr, F.lane);
            else cvt_gu_item(A.in[19], A.in[20], WSP(bf16_t, WS_WRS) + (size_t)256 * DM, kb * 16 + (rb - 8), scr, F.lane);
            continue; } r -= I_RS;
        cvt_item(A.in[21], DM, 32 * (r & 31), 64 * (r >> 5), WSP(bf16_t, WS_WSD), SD, 32 * (r & 31), scr, F.lane);
    }
}
__device__ __forceinline__ void p1_phase(Frame& F, const Args& A) {
    const int gw = F.vcu * NWAVES + F.wave, NGW = F.G * NWAVES;
    const float* x = A.in[0]; const float* mod = WSP(float, WS_MOD); bf16_t* h = WSP(bf16_t, WS_H);
    for (int m = gw; m < T; m += NGW) {
        const float* md = mod + (m / SEQ) * 6 * DM; const f32x4* xr = (const f32x4*)(x + (size_t)m * DM) + F.lane; u32x2* o8 = (u32x2*)(h + (size_t)m * DM) + F.lane;
#pragma unroll
        for (int j = 0; j < 4; ++j) { const f32x4 v = xr[64 * j]; const f32x4 sh = *((const f32x4*)md + F.lane + 64 * j), sc = *((const f32x4*)(md + DM) + F.lane + 64 * j);
            const f32x4 r = v * (sc + 1.f) + sh; u32x2 w; w.x = cvt_pk_bf16(r[0], r[1]); w.y = cvt_pk_bf16(r[2], r[3]); o8[64 * j] = w; }
    }
    LAS float* scr = (LAS float*)(F.lds + F.wave * 16384);
    constexpr int I_GU = 256, I_D = 128, I_E = I_GU + I_D;
    for (int it = gw; it < NE * I_E; it += NGW) {
        const int e = it / I_E, r = it % I_E;
        if (r < I_GU) cvt_gu_item(A.in[16] + (size_t)e * DM * ED, A.in[17] + (size_t)e * DM * ED, WSP(bf16_t, WS_WGU) + (size_t)e * 512 * DM, r, scr, F.lane);
        else { const int q = r - I_GU; cvt_item(A.in[18] + (size_t)e * ED * DM, DM, 32 * (q & 31), 64 * (q >> 5), WSP(bf16_t, WS_WD) + (size_t)e * DM * ED, ED, 32 * (q & 31), scr, F.lane); }
    }
}

__device__ __forceinline__ s16x4 tr_read(const LAS unsigned char* p) { return __builtin_bit_cast(s16x4, __builtin_amdgcn_ds_read_tr16_b64_v4i16((LAS s16x4*)p)); }
__device__ __forceinline__ void attn_unit(Frame& F, const Args& A, int u) {
    LAS unsigned char* Qs = F.lds; LAS unsigned char* Ks = F.lds + 16384; LAS unsigned char* Vs = F.lds + 49152;
    const int p = u >> 10, bh = (u & 1023) >> 4, cls = u & 15; const int b = bh >> 3, h = bh & 7;
    int d, r, n; if (p == 0) { d = 1; r = 0; n = cls; } else if (p == 1) { d = 4; r = cls & 3; n = cls >> 2; } else { d = 16; r = cls; n = 0; }
    const bf16_t* Q = WSP(bf16_t, WS_Q); const bf16_t* K = WSP(bf16_t, WS_K); const bf16_t* V = WSP(bf16_t, WS_V);
    const int tid = F.tid, lane = F.lane, w = F.wave, g = lane >> 4, li = lane & 15;
    const size_t tb = (size_t)b * SEQ;
#pragma unroll
    for (int i = 0; i < 4; ++i) { const int idx = tid + NTHR * i, row = idx >> 3, c = idx & 7; const int ci = (n - 1) * 128 + row;
        u32x4 kv = (u32x4){0u, 0u, 0u, 0u}, vv = kv;
        if (ci >= 0) { const size_t off = (tb + (size_t)ci * d + r) * AW + h * HD + c * 8; kv = *(const u32x4*)(K + off); vv = *(const u32x4*)(V + off); }
        const int lo = row * 128 + ((c ^ (row & 7)) << 4); *(LAS u32x4*)(Ks + lo) = kv; *(LAS u32x4*)(Vs + lo) = vv; }
#pragma unroll
    for (int i = 0; i < 2; ++i) { const int idx = tid + NTHR * i, row = idx >> 3, c = idx & 7;
        const size_t off = (tb + (size_t)(n * 128 + row) * d + r) * AW + h * HD + c * 8;
        *(LAS u32x4*)(Qs + row * 128 + ((c ^ (row & 7)) << 4)) = *(const u32x4*)(Q + off); }
    __syncthreads();
    bf16x8 qf[2];
    { const int row = 16 * w + li;
#pragma unroll
      for (int ks = 0; ks < 2; ++ks) qf[ks] = *(const LAS bf16x8*)(Qs + row * 128 + (((4 * ks + g) ^ (row & 7)) << 4)); }
    f32x4 s[9];
#pragma unroll
    for (int kt = 0; kt < 9; ++kt) { const int krow = 16 * (w + kt) + li; f32x4 a = (f32x4){0.f, 0.f, 0.f, 0.f};
#pragma unroll
        for (int ks = 0; ks < 2; ++ks) { const bf16x8 kf = *(const LAS bf16x8*)(Ks + krow * 128 + (((4 * ks + g) ^ (krow & 7)) << 4)); a = __builtin_amdgcn_mfma_f32_16x16x32_bf16(kf, qf[ks], a, 0, 0, 0); }
        s[kt] = a; }
    float mx = -INFINITY;
#pragma unroll
    for (int kt = 0; kt < 9; ++kt)
#pragma unroll
        for (int rr = 0; rr < 4; ++rr) { const int kk = 16 * kt + 4 * g + rr; const int kj = 16 * w + kk;
            const bool ok = (kk >= li) && (kk <= li + 128) && (n > 0 || kj >= 128);
            const float v = ok ? s[kt][rr] : -INFINITY; s[kt][rr] = v; mx = fmaxf(mx, v); }
    mx = fmaxf(mx, __shfl_xor(mx, 16)); mx = fmaxf(mx, __shfl_xor(mx, 32));
    const float C = 0.125f * 1.4426950408889634f; float ls = 0.f;
#pragma unroll
    for (int kt = 0; kt < 9; ++kt)
#pragma unroll
        for (int rr = 0; rr < 4; ++rr) { const float e = __builtin_amdgcn_exp2f((s[kt][rr] - mx) * C); s[kt][rr] = e; ls += e; }
    ls += __shfl_xor(ls, 16); ls += __shfl_xor(ls, 32);
    f32x4 o[4];
#pragma unroll
    for (int nt = 0; nt < 4; ++nt) o[nt] = (f32x4){0.f, 0.f, 0.f, 0.f};
    const int q4 = li >> 2, p4 = li & 3;
#pragma unroll
    for (int k2 = 0; k2 < 5; ++k2) {
        const int t0 = 2 * k2, t1 = 2 * k2 + 1;
        u32x4 pw; pw.x = cvt_pk_bf16(s[t0][0], s[t0][1]); pw.y = cvt_pk_bf16(s[t0][2], s[t0][3]);
        if (t1 < 9) { pw.z = cvt_pk_bf16(s[t1 < 9 ? t1 : 8][0], s[t1 < 9 ? t1 : 8][1]); pw.w = cvt_pk_bf16(s[t1 < 9 ? t1 : 8][2], s[t1 < 9 ? t1 : 8][3]); } else { pw.z = 0u; pw.w = 0u; }
        const bf16x8 pa = __builtin_bit_cast(bf16x8, pw);
        int KT1 = w + t1; if (KT1 > 15) KT1 = 15;
        const int r0 = 16 * (w + t0) + 4 * g + q4, r1 = 16 * KT1 + 4 * g + q4;
#pragma unroll
        for (int nt = 0; nt < 4; ++nt) { const int ch = 2 * nt + (p4 >> 1);
            const s16x4 lo = tr_read(Vs + r0 * 128 + ((ch ^ (r0 & 7)) << 4) + (p4 & 1) * 8), hi = tr_read(Vs + r1 * 128 + ((ch ^ (r1 & 7)) << 4) + (p4 & 1) * 8);
            const bf16x8 vb = (bf16x8){lo[0], lo[1], lo[2], lo[3], hi[0], hi[1], hi[2], hi[3]};
            o[nt] = __builtin_amdgcn_mfma_f32_16x16x32_bf16(pa, vb, o[nt], 0, 0, 0); }
    }
    const float linv = 1.f / ls;
    LAS bf16_t* st = (LAS bf16_t*)(Qs + 16 * w * 128);
#pragma unroll
    for (int rr = 0; rr < 4; ++rr) { const float sc = __shfl(linv, 4 * g + rr);
#pragma unroll
        for (int nt = 0; nt < 4; ++nt) st[(4 * g + rr) * 64 + 16 * nt + li] = (bf16_t)(cvt_pk_bf16(o[nt][rr] * sc, 0.f) & 0xffffu); }
    LDS_WAIT(); asm volatile("" ::: "memory");
    bf16_t* OP = WSP(bf16_t, WS_OP) + (size_t)p * T * AW; float* LSE = WSP(float, WS_LSE) + (size_t)p * T * NH;
#pragma unroll
    for (int i = 0; i < 2; ++i) { const int cidx = lane + 64 * i, row = cidx >> 3, c = cidx & 7;
        const size_t tok = tb + (size_t)(n * 128 + 16 * w + row) * d + r;
        *(u32x4*)(OP + tok * AW + h * HD + c * 8) = *(const LAS u32x4*)((const LAS unsigned char*)st + row * 128 + c * 16); }
    if (lane < 16) { const size_t tok = tb + (size_t)(n * 128 + 16 * w + li) * d + r; LSE[tok * NH + h] = mx * 0.125f + logf(ls); }
    __syncthreads();
}
__device__ __forceinline__ void sgu_unit(Frame& F, const Args& A, int u) {
    LAS unsigned char* Ws = F.lds; LAS unsigned char* Vn = F.lds + 32768; LAS f32x2* stats = (LAS f32x2*)(F.lds + 65536);
    const int g = u & 7, bc = u >> 3; const size_t t0 = (size_t)bc * 128;
    const bf16_t* VG = WSP(bf16_t, WS_VG); const bf16_t* U = WSP(bf16_t, WS_U); bf16_t* SG = WSP(bf16_t, WS_SG);
    const float* lng = A.in[5]; const float* lnb = A.in[6]; const float* wsp = A.in[7] + (size_t)g * 128 * 128; const float* bsp = A.in[8] + g * 128;
    const int tid = F.tid, lane = F.lane, w = F.wave, g4 = lane >> 4, li = lane & 15;
    { const int row = tid >> 2, qd = tid & 3; const u32x4* pr = (const u32x4*)(VG + (t0 + row) * GW + qd * 256); float s1 = 0.f, s2 = 0.f;
#pragma unroll 8
      for (int i = 0; i < 32; ++i) { const u32x4 v = pr[i];
#pragma unroll
          for (int j = 0; j < 4; ++j) { const float a = bf_lo(v[j]), c = bf_hi(v[j]); s1 += a + c; s2 += a * a + c * c; } }
      s1 += __shfl_xor(s1, 1); s2 += __shfl_xor(s2, 1); s1 += __shfl_xor(s1, 2); s2 += __shfl_xor(s2, 2);
      const float mean = s1 * (1.f / 1024.f); const float var = fmaxf(s2 * (1.f / 1024.f) - mean * mean, 0.f);
      if (qd == 0) stats[row] = (f32x2){mean, 1.f / sqrtf(var + LN_EPS)}; }
#pragma unroll
    for (int i = 0; i < 8; ++i) { const int idx = tid + NTHR * i, trow = idx >> 5, c4 = idx & 31; f32x4 v = *(const f32x4*)(wsp + trow * 128 + c4 * 4);
#pragma unroll
        for (int j = 0; j < 4; ++j) if (4 * c4 + j > trow) v[j] = 0.f;
        u32x2 o; o.x = cvt_pk_bf16(v[0], v[1]); o.y = cvt_pk_bf16(v[2], v[3]);
        *(LAS u32x2*)(Ws + trow * 256 + (((c4 >> 1) ^ (trow & 15)) << 4) + (c4 & 1) * 8) = o; }
    __syncthreads();
#pragma unroll
    for (int i = 0; i < 4; ++i) { const int idx = tid + NTHR * i, srow = idx >> 4, c16 = idx & 15; const int ch0 = g * 128 + c16 * 8;
        const u32x4 v = *(const u32x4*)(VG + (t0 + srow) * GW + ch0); const f32x2 st = stats[srow];
        const f32x4 ga = *(const f32x4*)(lng + ch0), gb = *(const f32x4*)(lng + ch0 + 4), ba = *(const f32x4*)(lnb + ch0), bb = *(const f32x4*)(lnb + ch0 + 4);
        f32x4 x0, x1; pg8::unpack8(v, x0, x1);
        x0 = (x0 - st.x) * st.y * ga + ba; x1 = (x1 - st.x) * st.y * gb + bb;
        *(LAS u32x4*)(Vn + srow * 256 + ((c16 ^ (srow & 15)) << 4)) = pg8::pack8(x0, x1); }
    __syncthreads();
    f32x4 acc[8];
#pragma unroll
    for (int nt = 0; nt < 8; ++nt) acc[nt] = (f32x4){0.f, 0.f, 0.f, 0.f};
    const int nks = (w >> 1) + 1; const int arow = 16 * w + li; const int q4 = li >> 2, p4 = li & 3;
    for (int ks = 0; ks < nks; ++ks) {
        const bf16x8 af = *(const LAS bf16x8*)(Ws + arow * 256 + (((4 * ks + g4) ^ (arow & 15)) << 4));
        const int r0 = 32 * ks + 8 * g4 + q4, r1 = r0 + 4;
#pragma unroll
        for (int nt = 0; nt < 8; ++nt) { const int ch = 2 * nt + (p4 >> 1);
            const s16x4 lo = tr_read(Vn + r0 * 256 + ((ch ^ (r0 & 15)) << 4) + (p4 & 1) * 8), hi = tr_read(Vn + r1 * 256 + ((ch ^ (r1 & 15)) << 4) + (p4 & 1) * 8);
            const bf16x8 vb = (bf16x8){lo[0], lo[1], lo[2], lo[3], hi[0], hi[1], hi[2], hi[3]};
            acc[nt] = __builtin_amdgcn_mfma_f32_16x16x32_bf16(af, vb, acc[nt], 0, 0, 0); }
    }
    LAS bf16_t* st = (LAS bf16_t*)(Ws + 16 * w * 256);
#pragma unroll
    for (int rr = 0; rr < 4; ++rr) { const float bias = bsp[16 * w + 4 * g4 + rr];
#pragma unroll
        for (int nt = 0; nt < 8; ++nt) st[(4 * g4 + rr) * 128 + 16 * nt + li] = (bf16_t)(cvt_pk_bf16(acc[nt][rr] + bias, 0.f) & 0xffffu); }
    LDS_WAIT(); asm volatile("" ::: "memory");
#pragma unroll
    for (int i = 0; i < 4; ++i) { const int cidx = lane + 64 * i, row = cidx >> 4, c16 = cidx & 15; const size_t off = (t0 + 16 * w + row) * GW + g * 128 + c16 * 8;
        f32x4 a0, a1, u0, u1; pg8::unpack8(*(const LAS u32x4*)((const LAS unsigned char*)st + row * 256 + c16 * 16), a0, a1); pg8::unpack8(*(const u32x4*)(U + off), u0, u1);
        *(u32x4*)(SG + off) = pg8::pack8(a0 * u0, a1 * u1); }
    __syncthreads();
}
__device__ __forceinline__ void p4_phase(Frame& F, const Args& A) {
    const bf16_t* OP = WSP(bf16_t, WS_OP); const float* LSE = WSP(float, WS_LSE); bf16_t* OA = WSP(bf16_t, WS_OA);
    for (int idx = F.vcu * NTHR + F.tid; idx < T * 64; idx += F.G * NTHR) {
        const int t = idx >> 6, h = (idx >> 3) & 7, c = idx & 7;
        const float l0 = LSE[(size_t)t * NH + h], l1 = LSE[(size_t)(T + t) * NH + h], l2 = LSE[(size_t)(2 * T + t) * NH + h];
        const float m = fmaxf(l0, fmaxf(l1, l2)); float w0 = expf(l0 - m), w1 = expf(l1 - m), w2 = expf(l2 - m); const float inv = 1.f / (w0 + w1 + w2); w0 *= inv; w1 *= inv; w2 *= inv;
        const size_t off = (size_t)t * AW + h * HD + c * 8;
        f32x4 a0, a1, b0, b1, c0, c1; pg8::unpack8(*(const u32x4*)(OP + off), a0, a1); pg8::unpack8(*(const u32x4*)(OP + (size_t)T * AW + off), b0, b1); pg8::unpack8(*(const u32x4*)(OP + (size_t)2 * T * AW + off), c0, c1);
        *(u32x4*)(OA + off) = pg8::pack8(a0 * w0 + b0 * w1 + c0 * w2, a1 * w0 + b1 * w1 + c1 * w2);
    }
}
__device__ __forceinline__ void p7_phase(Frame& F, const Args& A) {
    const int gw = F.vcu * NWAVES + F.wave, NGW = F.G * NWAVES;
    const float* x = A.in[0]; const float* mod = WSP(float, WS_MOD); const bf16_t* mix = WSP(bf16_t, WS_MIX); float* x1 = WSP(float, WS_X1); bf16_t* h2 = WSP(bf16_t, WS_H);
    const float* g1 = A.in[12]; const float* b1 = A.in[13];
    for (int m = gw; m < T; m += NGW) {
        const float* md = mod + (m / SEQ) * 6 * DM; const f32x4* xr = (const f32x4*)(x + (size_t)m * DM) + F.lane; const u32x2* mr = (const u32x2*)(mix + (size_t)m * DM) + F.lane;
        f32x4 v[4]; float s = 0.f;
#pragma unroll
        for (int j = 0; j < 4; ++j) { const f32x4 xv = xr[64 * j]; const u32x2 mw = mr[64 * j]; const f32x4 gv = *((const f32x4*)(md + 2 * DM) + F.lane + 64 * j);
            const f32x4 mv = (f32x4){bf_lo(mw.x), bf_hi(mw.x), bf_lo(mw.y), bf_hi(mw.y)};
            v[j] = xv * ALPHA + gv * mv; s += (v[j][0] + v[j][1]) + (v[j][2] + v[j][3]); }
        const float mean = wave_sum(s) * (1.f / DM); float s2 = 0.f;
#pragma unroll
        for (int j = 0; j < 4; ++j) { v[j] = v[j] - mean; s2 += (v[j][0] * v[j][0] + v[j][1] * v[j][1]) + (v[j][2] * v[j][2] + v[j][3] * v[j][3]); }
        const float rstd = 1.f / sqrtf(wave_sum(s2) * (1.f / DM) + LN_EPS);
        f32x4* xo = (f32x4*)(x1 + (size_t)m * DM) + F.lane; u32x2* ho = (u32x2*)(h2 + (size_t)m * DM) + F.lane;
#pragma unroll
        for (int j = 0; j < 4; ++j) { const f32x4 gg = *((const f32x4*)g1 + F.lane + 64 * j), bb = *((const f32x4*)b1 + F.lane + 64 * j);
            const f32x4 o = v[j] * rstd * gg + bb; xo[64 * j] = o;
            const f32x4 sh = *((const f32x4*)(md + 3 * DM) + F.lane + 64 * j), sc = *((const f32x4*)(md + 4 * DM) + F.lane + 64 * j);
            const f32x4 r = o * (sc + 1.f) + sh; u32x2 wv; wv.x = cvt_pk_bf16(r[0], r[1]); wv.y = cvt_pk_bf16(r[2], r[3]); ho[64 * j] = wv; }
    }
}
__device__ __forceinline__ unsigned f2ord(float f) { const unsigned u = __float_as_uint(f); return (u & 0x80000000u) ? ~u : (u | 0x80000000u); }
__device__ __forceinline__ void p9_phase(Frame& F, const Args& A) {
    const int gw = F.vcu * NWAVES + F.wave, NGW = F.G * NWAVES, lane = F.lane;
    const float* logits = WSP(float, WS_LOGITS); const float* rbias = A.in[15];
    unsigned* cnt = (unsigned*)(F.ctl + CW_CNT); int* tok_e = WSP(int, WS_TOKE); int* tok_r = WSP(int, WS_TOKR); int* btok = WSP(int, WS_BTOK); float* bw = WSP(float, WS_BW);
    const f32x4 rb = *((const f32x4*)rbias + lane);
    for (int t = gw; t < T; t += NGW) {
        const f32x4 lg = *((const f32x4*)(logits + (size_t)t * NE) + lane);
        f32x4 sc, bi;
#pragma unroll
        for (int i = 0; i < 4; ++i) { sc[i] = 1.f / (1.f + expf(-lg[i])); bi[i] = sc[i] + rb[i]; }
        float m1 = fmaxf(bi[0], bi[1]), m2 = fminf(bi[0], bi[1]);
#pragma unroll
        for (int i = 2; i < 4; ++i) { const float v = bi[i]; m2 = fmaxf(m2, fminf(m1, v)); m1 = fmaxf(m1, v); }
#pragma unroll
        for (int o = 1; o < 8; o <<= 1) { const float o1 = __shfl_xor(m1, o), o2 = __shfl_xor(m2, o); const float n1 = fmaxf(m1, o1), n2 = fmaxf(fminf(m1, o1), fmaxf(m2, o2)); m1 = n1; m2 = n2; }
        const float gs = m1 + m2; const int grp = lane >> 3; int rank = 0;
#pragma unroll
        for (int gg = 0; gg < 8; ++gg) { const float v = __shfl(gs, 8 * gg); rank += (v > gs || (v == gs && gg < grp)) ? 1 : 0; }
        const bool sel = rank < 4;
        unsigned long long key[4];
#pragma unroll
        for (int i = 0; i < 4; ++i) key[i] = sel ? (((unsigned long long)f2ord(bi[i]) << 32) | (unsigned)(255 - (4 * lane + i))) : 0ull;
        int my_e = 0; float my_s = 0.f, wsum = 0.f;
#pragma unroll
        for (int r = 0; r < TOPK; ++r) {
            unsigned long long k = key[0] > key[1] ? key[0] : key[1]; { const unsigned long long k2 = key[2] > key[3] ? key[2] : key[3]; k = k > k2 ? k : k2; }
#pragma unroll
            for (int o = 1; o < 64; o <<= 1) { const unsigned long long ok = __shfl_xor(k, o); k = ok > k ? ok : k; }
            const int e = 255 - (int)(k & 0xffull); const int owner = e >> 2, sub = e & 3;
            const float sv = (sub == 0) ? sc[0] : (sub == 1) ? sc[1] : (sub == 2) ? sc[2] : sc[3];
            const float ssel = __shfl(sv, owner);
            if (lane == owner) {
#pragma unroll
                for (int i = 0; i < 4; ++i) if (i == sub) key[i] = 0ull; }
            wsum += ssel; if (lane == r) { my_e = e; my_s = ssel; }
        }
        if (lane < TOPK) {
            const float wv = 2.5f * my_s / wsum;
            const unsigned rk = atomicAdd(&cnt[my_e], 1u);
            tok_e[t * TOPK + lane] = my_e; tok_r[t * TOPK + lane] = (int)rk;
            if (rk < (unsigned)BUCKET) { btok[(size_t)my_e * BUCKET + rk] = t; bw[(size_t)my_e * BUCKET + rk] = wv; }
        }
    }
}
__device__ __forceinline__ void build_tile_table(Frame& F, const Args& A) {
    LAS unsigned short* tile_e = (LAS unsigned short*)(F.lds + L_TILE_E); LAS unsigned short* tstart = (LAS unsigned short*)(F.lds + L_TSTART);
    const unsigned* cnt = (const unsigned*)(F.ctl + CW_CNT);
    __syncthreads();
    int val = 0, incl = 0;
    if (F.tid < NE) { unsigned c = __hip_atomic_load(cnt + F.tid, RLX_AGENT); if (c > (unsigned)BUCKET) c = BUCKET; ((LAS unsigned short*)(F.lds + L_CNT))[F.tid] = (unsigned short)c; val = (int)((c + 255u) >> 8); incl = val;
#pragma unroll
        for (int o = 1; o < 64; o <<= 1) { const int v = __shfl_up(incl, o); if (F.lane >= o) incl += v; }
        if (F.lane == 63) F.MISC[F.wave] = (unsigned)incl; }
    __syncthreads();
    if (F.tid < NE) { int off = 0;
#pragma unroll
        for (int w = 0; w < 4; ++w) if (w < F.wave) off += (int)F.MISC[w];
        const int st = off + incl - val; tstart[F.tid] = (unsigned short)st;
        for (int k = 0; k < val; ++k) tile_e[st + k] = (unsigned short)F.tid;
        if (F.tid == NE - 1) F.MISC[4] = (unsigned)(off + incl); }
    __syncthreads();
}
__device__ __forceinline__ void p12_phase(Frame& F, const Args& A) {
    const int gw = F.vcu * NWAVES + F.wave, NGW = F.G * NWAVES;
    const LAS unsigned short* tstart = (const LAS unsigned short*)(F.lds + L_TSTART);
    const float* mod = WSP(float, WS_MOD); const float* x1 = WSP(float, WS_X1); const bf16_t* ysh = WSP(bf16_t, WS_YSH); const bf16_t* yrow = WSP(bf16_t, WS_YROW);
    const int* tok_e = WSP(int, WS_TOKE); const int* tok_r = WSP(int, WS_TOKR); const float* g2 = A.in[22]; const float* b2 = A.in[23]; float* out = A.out;
    for (int m = gw; m < T; m += NGW) {
        const float* md = mod + (m / SEQ) * 6 * DM;
        f32x4 f[4];
        { const u32x2* sr = (const u32x2*)(ysh + (size_t)m * DM) + F.lane;
#pragma unroll
          for (int j = 0; j < 4; ++j) { const u32x2 w = sr[64 * j]; f[j] = (f32x4){bf_lo(w.x), bf_hi(w.x), bf_lo(w.y), bf_hi(w.y)}; } }
#pragma unroll
        for (int k = 0; k < TOPK; ++k) { const int e = tok_e[m * TOPK + k], rk = tok_r[m * TOPK + k]; const size_t pos = (size_t)tstart[e] * 256 + rk;
            const u32x2* yr = (const u32x2*)(yrow + pos * DM) + F.lane;
#pragma unroll
            for (int j = 0; j < 4; ++j) { const u32x2 w = yr[64 * j]; f[j] += (f32x4){bf_lo(w.x), bf_hi(w.x), bf_lo(w.y), bf_hi(w.y)}; } }
        const f32x4* xr = (const f32x4*)(x1 + (size_t)m * DM) + F.lane; f32x4 v[4]; float s = 0.f;
#pragma unroll
        for (int j = 0; j < 4; ++j) { const f32x4 gv = *((const f32x4*)(md + 5 * DM) + F.lane + 64 * j); v[j] = xr[64 * j] * ALPHA + gv * f[j]; s += (v[j][0] + v[j][1]) + (v[j][2] + v[j][3]); }
        const float mean = wave_sum(s) * (1.f / DM); float s2 = 0.f;
#pragma unroll
        for (int j = 0; j < 4; ++j) { v[j] = v[j] - mean; s2 += (v[j][0] * v[j][0] + v[j][1] * v[j][1]) + (v[j][2] * v[j][2] + v[j][3] * v[j][3]); }
        const float rstd = 1.f / sqrtf(wave_sum(s2) * (1.f / DM) + LN_EPS);
        f32x4* oo = (f32x4*)(out + (size_t)m * DM) + F.lane;
#pragma unroll
        for (int j = 0; j < 4; ++j) { const f32x4 gg = *((const f32x4*)g2 + F.lane + 64 * j), bb = *((const f32x4*)b2 + F.lane + 64 * j); oo[64 * j] = v[j] * rstd * gg + bb; }
    }
}
constexpr int NPHASE = 13;

__global__ void __launch_bounds__(NTHR, 2) mk_fwd(Args args) {
    extern __shared__ __attribute__((aligned(16))) unsigned char lds_raw[];
    Frame F;
    F.lds = (LAS unsigned char*)lds_raw; F.MISC = (volatile LAS unsigned*)(F.lds + L_MISC);
    F.tid = threadIdx.x; F.lane = F.tid & 63; F.wave = __builtin_amdgcn_readfirstlane(F.tid >> 6);
    F.G = gridDim.x; { const int bx = blockIdx.x; F.vcu = (F.G % 8 == 0) ? (bx % 8) * (F.G / 8) + bx / 8 : bx; }
    const Args& A = args;
    F.ctl = (gu32*)(args.ws + WS_CTL);
    if (F.tid < 64) F.MISC[F.tid] = 0u;
    __syncthreads();
    const int lo = args.ph_lo, hi = args.ph_hi;
    XcdBarrier bar; bar.bar = (unsigned*)(F.ctl + CW_BAR); bar.x = 0; bar.st = nullptr;
    if (hi - lo > 1) bar = xcd_barrier_post((unsigned*)(F.ctl + CW_BAR), F.MISC + 8);
#ifndef REPEAT_MASK
#define REPEAT_MASK 0
#endif
#define IN(k) (lo <= (k) && (k) < hi)
#define REP(k) _Pragma("nounroll") for (int rep_ = 0; rep_ < (((REPEAT_MASK >> (k)) & 1) ? 2 : 1); ++rep_)
#define SEAM(k) do { if (IN(k) && IN((k) + 1)) xcd_barrier(bar); } while (0)
    LAS unsigned char* ring = F.lds;

    if (IN(0)) REP(0) { p0_phase(F, A); } SEAM(0);
    if (IN(1)) REP(1) { p1_phase(F, A); } SEAM(1);
    if (IN(2)) REP(2) {
        pg8::StaticOrder S; S.init(WSP(bf16_t, WS_H), WSP(bf16_t, WS_WIN), T, INW, DM * 2, DM * 2, F.G, (int)blockIdx.x);
        pg8::EpiInProj E{A.ws, WSP(float, WS_ROPE)};
        pg8::gemm_phase<pg8::EpiInProj, pg8::StaticOrder, false, true>(ring, DM, DM * 2, DM * 2, S, E);
    } SEAM(2);
    if (IN(3)) REP(3) { for (int u = F.vcu; u < 4096; u += F.G) { if (u < 3072) attn_unit(F, A, u); else sgu_unit(F, A, u - 3072); } } SEAM(3);
    if (IN(4)) REP(4) { p4_phase(F, A); } SEAM(4);
    if (IN(5)) REP(5) {
        { pg8::StaticOrder S; S.init(WSP(bf16_t, WS_OA), WSP(bf16_t, WS_WPA), T, DM, AW * 2, AW * 2, F.G, (int)blockIdx.x);
          pg8::EpiGate<false> E{WSP(bf16_t, WS_MERGED), WSP(bf16_t, WS_GA)};
          pg8::gemm_phase<pg8::EpiGate<false>, pg8::StaticOrder, false, false>(ring, AW, AW * 2, AW * 2, S, E); }
        { pg8::StaticOrder S; S.init(WSP(bf16_t, WS_SG), WSP(bf16_t, WS_WPB), T, DM, GW * 2, GW * 2, F.G, (int)blockIdx.x);
          pg8::EpiGate<true> E{WSP(bf16_t, WS_MERGED), WSP(bf16_t, WS_GB)};
          pg8::gemm_phase<pg8::EpiGate<true>, pg8::StaticOrder, false, false>(ring, GW, GW * 2, GW * 2, S, E); }
    } SEAM(5);
    if (IN(6)) REP(6) {
        pg8::StaticOrder S; S.init(WSP(bf16_t, WS_MERGED), WSP(bf16_t, WS_WOUT), T, DM, DM * 2, DM * 2, F.G, (int)blockIdx.x);
        pg8::EpiBf16<false> E{WSP(bf16_t, WS_MIX), DM, nullptr};
        pg8::gemm_phase<pg8::EpiBf16<false>, pg8::StaticOrder, false, false>(ring, DM, DM * 2, DM * 2, S, E);
    } SEAM(6);
    if (IN(7)) REP(7) { p7_phase(F, A); } SEAM(7);
    if (IN(8)) REP(8) {
        pg8::StaticOrder S; S.init(WSP(bf16_t, WS_H), WSP(bf16_t, WS_WRS), T, 768, DM * 2, DM * 2, F.G, (int)blockIdx.x);
        pg8::EpiRouterShared E{WSP(float, WS_LOGITS), WSP(bf16_t, WS_SHID)};
        pg8::gemm_phase<pg8::EpiRouterShared, pg8::StaticOrder, false, true>(ring, DM, DM * 2, DM * 2, S, E);
    } SEAM(8);
    if (IN(9)) REP(9) { p9_phase(F, A); } SEAM(9);
    if (IN(10)) REP(10) {
        build_tile_table(F, A);
        pg8::GroupedOrder S; S.G = F.G; S.c = F.vcu; S.NPN = 2; S.ntiles = (int)F.MISC[4]; S.tile_e = (const LAS unsigned short*)(F.lds + L_TILE_E); S.tstart = (const LAS unsigned short*)(F.lds + L_TSTART);
        S.cnt = (const LAS unsigned short*)(F.lds + L_CNT); S.Abase = (const char*)WSP(bf16_t, WS_H); S.a_tile_stride = 0; S.Bbase = (const char*)WSP(bf16_t, WS_WGU); S.b_exp_stride = (size_t)512 * DM * 2; S.b_tile_stride = (size_t)256 * DM * 2;
        S.idxbase = WSP(int, WS_BTOK); S.gather = true;
        pg8::EpiGateUp E{WSP(bf16_t, WS_HID)};
        pg8::gemm_phase<pg8::EpiGateUp, pg8::GroupedOrder, true, true>(ring, DM, DM * 2, DM * 2, S, E);
    } SEAM(10);
    if (IN(11)) REP(11) {
        build_tile_table(F, A);
        { pg8::GroupedOrder S; S.G = F.G; S.c = F.vcu; S.NPN = 4; S.ntiles = (int)F.MISC[4]; S.tile_e = (const LAS unsigned short*)(F.lds + L_TILE_E); S.tstart = (const LAS unsigned short*)(F.lds + L_TSTART);
          S.cnt = (const LAS unsigned short*)(F.lds + L_CNT); S.Abase = (const char*)WSP(bf16_t, WS_HID); S.a_tile_stride = (size_t)256 * ED * 2; S.Bbase = (const char*)WSP(bf16_t, WS_WD); S.b_exp_stride = (size_t)DM * ED * 2; S.b_tile_stride = (size_t)256 * ED * 2;
          S.idxbase = WSP(int, WS_BW); S.gather = false;
          pg8::EpiDown E{WSP(bf16_t, WS_YROW)};
          pg8::gemm_phase<pg8::EpiDown, pg8::GroupedOrder, false, true>(ring, ED, ED * 2, ED * 2, S, E); }
        { pg8::StaticOrder S; S.init(WSP(bf16_t, WS_SHID), WSP(bf16_t, WS_WSD), T, DM, SD * 2, SD * 2, F.G, (int)blockIdx.x);
          pg8::EpiBf16<false> E{WSP(bf16_t, WS_YSH), DM, nullptr};
          pg8::gemm_phase<pg8::EpiBf16<false>, pg8::StaticOrder, false, false>(ring, SD, SD * 2, SD * 2, S, E); }
    } SEAM(11);
    if (IN(12)) REP(12) { build_tile_table(F, A); p12_phase(F, A); }
#undef IN
#undef REP
#undef SEAM
}

#ifndef MK_SPLIT
#define MK_SPLIT 0
#endif
static int mk_grid(size_t ws_size) {
    static int grid = 0;
    if (grid == 0) {
        int dev = 0, cus = 0, per_cu = 0;
        if (ws_size < WS_END) { fprintf(stderr, "kernel_launch: workspace too small (%zu < %zu)\n", ws_size, (size_t)WS_END); grid = -1; return -1; }
        if (hipGetDevice(&dev) != hipSuccess || hipDeviceGetAttribute(&cus, hipDeviceAttributeMultiprocessorCount, dev) != hipSuccess) { grid = -1; return -1; }
        if (hipFuncSetAttribute((const void*)mk_fwd, hipFuncAttributeMaxDynamicSharedMemorySize, LDS_BYTES) != hipSuccess) { fprintf(stderr, "kernel_launch: hipFuncSetAttribute failed\n"); grid = -1; return -1; }
        if (hipOccupancyMaxActiveBlocksPerMultiprocessor(&per_cu, (const void*)mk_fwd, NTHR, LDS_BYTES) != hipSuccess || per_cu < 1) { fprintf(stderr, "kernel_launch: occupancy query says %d blocks/CU\n", per_cu); (void)hipGetLastError(); grid = -1; return -1; }
        grid = cus;
    }
    return grid;
}
static void mk_run(void* const* d_in, float* out, void* d_ws, int grid, int lo, int hi, hipStream_t stream) {
    Args a{};
    for (int i = 0; i < 24; ++i) a.in[i] = (const float*)d_in[i];
    a.out = out; a.ws = (unsigned char*)d_ws; a.ph_lo = lo; a.ph_hi = hi;
#ifndef MK_COOP
#define MK_COOP 1
#endif
    if (MK_COOP && hi - lo > 1) {
        void* kargs[] = {&a};
        hipError_t e = hipLaunchCooperativeKernel((const void*)mk_fwd, dim3(grid), dim3(NTHR), kargs, LDS_BYTES, stream);
        if (e != hipSuccess) fprintf(stderr, "kernel_launch: cooperative launch failed: %s (grid %d)\n", hipGetErrorString(e), grid);
    } else {
        hipLaunchKernelGGL(mk_fwd, dim3(grid), dim3(NTHR), LDS_BYTES, stream, a);
    }
}
static int mk_launch(void* const* d_in, float* out, void* d_ws, size_t ws_size, hipStream_t stream) {
    const int grid = mk_grid(ws_size);
    if (grid < 0) return -1;
    (void)hipMemsetAsync((char*)d_ws + WS_CTL, 0, CTL_ZERO_BYTES, stream);
#if MK_SPLIT
#ifndef EXTRA_PHASE
#define EXTRA_PHASE -1
#endif
    for (int p = 0; p < NPHASE; ++p) { mk_run(d_in, out, d_ws, grid, p, p + 1, stream); if (p == EXTRA_PHASE) mk_run(d_in, out, d_ws, grid, p, p + 1, stream); }
#else
    mk_run(d_in, out, d_ws, grid, 0, NPHASE, stream);
#endif
    return 0;
}
extern "C" void kernel_launch(void* const* d_in, const int* in_sizes, int n_in, void* d_out, int out_size, void* d_ws, size_t ws_size, hipStream_t stream) {
    (void)in_sizes; (void)n_in; (void)out_size;
#if PROBE
    probe::run(d_in, d_out, d_ws, ws_size, stream);
#else
    mk_launch(d_in, (float*)d_out, d_ws, ws_size, stream);
#endif
}
```

```cpp
#define PROBE 0
#define PROBE_STAGE -1
#define MK_SPLIT 0
#define REPEAT_MASK 0
#define EXTRA_PHASE -1
#define MK_COOP 1
#include <hip/hip_runtime.h>
#include <math.h>
#include <stdint.h>
#include <cstdio>

#define LAS __attribute__((address_space(3)))
#define GAS __attribute__((address_space(1)))
typedef unsigned short bf16_t;
typedef short bf16x8 __attribute__((ext_vector_type(8)));
typedef short s16x4 __attribute__((ext_vector_type(4)));
typedef float f32x4 __attribute__((ext_vector_type(4)));
typedef float f32x2 __attribute__((ext_vector_type(2)));
typedef unsigned u32x4 __attribute__((ext_vector_type(4)));
typedef unsigned u32x2 __attribute__((ext_vector_type(2)));
typedef GAS unsigned gu32;

constexpr int NB = 8, SEQ = 2048, DM = 1024, T = NB * SEQ;
constexpr int NH = 8, HD = 64, AW = 512, GW = 1024, INW = 5632;
constexpr int NE = 256, TOPK = 8, ED = 256, SD = 256;
constexpr float ALPHA = 1.189207115002721f;
constexpr float LN_EPS = 1e-5f;
constexpr int NWAVES = 8, NTHR = 512;
constexpr int BUCKET = 16384;
constexpr int MAXTILES = 768;

constexpr size_t MiB = 1u << 20;
constexpr size_t WS_CTL = 0, CTL_ZERO_BYTES = 64 * 1024;
constexpr size_t WS_MOD = 1 * MiB;
constexpr size_t WS_ROPE = 1 * MiB + 256 * 1024;
constexpr size_t WS_WPA = 2 * MiB, WS_WPB = 3 * MiB, WS_WOUT = 5 * MiB, WS_WRS = 7 * MiB, WS_WSD = 8 * MiB + 512 * 1024;
constexpr size_t WS_WD = 10 * MiB;
constexpr size_t WS_X1 = 138 * MiB;
constexpr size_t WS_HID = 202 * MiB;
constexpr size_t WS_SHID = 298 * MiB;
constexpr size_t WS_YSH = 306 * MiB;
constexpr size_t WS_TOKE = 338 * MiB, WS_TOKR = WS_TOKE + 512 * 1024, WS_TOKW = WS_TOKR + 512 * 1024;
constexpr size_t WS_BTOK = 340 * MiB, WS_BW = 356 * MiB;
constexpr size_t WS_D = 372 * MiB;
constexpr size_t WS_YROW = WS_D;
constexpr size_t WS_WGU = 372 * MiB;
constexpr size_t WS_WIN = 628 * MiB;
constexpr size_t WS_H = 640 * MiB;
constexpr size_t WS_OP = 628 * MiB, WS_LSE = 676 * MiB;
constexpr size_t WS_Q = 678 * MiB, WS_K = 694 * MiB, WS_V = 710 * MiB;
constexpr size_t WS_MERGED = 678 * MiB;
constexpr size_t WS_U = 726 * MiB, WS_VG = 758 * MiB;
constexpr size_t WS_MIX = 726 * MiB;
constexpr size_t WS_LOGITS = 758 * MiB;
constexpr size_t WS_GA = 790 * MiB, WS_GB = 822 * MiB;
constexpr size_t WS_OA = 854 * MiB, WS_SG = 870 * MiB;
constexpr size_t WS_END = 902 * MiB;
constexpr size_t WS_GOLD = 960 * MiB;
constexpr int CW_BAR = 1024;
constexpr int CW_CNT = 8192;

#define RLX_AGENT __ATOMIC_RELAXED, __HIP_MEMORY_SCOPE_AGENT
#define LDS_WAIT() asm volatile("s_waitcnt lgkmcnt(0)" ::: "memory")
#define VM_WAIT() asm volatile("s_waitcnt vmcnt(0)" ::: "memory")
__device__ __forceinline__ unsigned cvt_pk_bf16(float lo, float hi) { unsigned r; asm volatile("v_cvt_pk_bf16_f32 %0, %1, %2" : "=v"(r) : "v"(lo), "v"(hi)); return r; }
__device__ __forceinline__ float bf_lo(unsigned u) { return __uint_as_float(u << 16); }
__device__ __forceinline__ float bf_hi(unsigned u) { return __uint_as_float(u & 0xffff0000u); }
__device__ __forceinline__ float wave_sum(float v) {
#pragma unroll
    for (int o = 1; o < 64; o <<= 1) v += __shfl_xor(v, o);
    return v;
}
__device__ __forceinline__ float fast_sigmoid(float x) { return __builtin_amdgcn_rcpf(1.f + __builtin_amdgcn_exp2f(-1.4426950408889634f * x)); }
__device__ __forceinline__ f32x2 gelu_pk(f32x2 v) {
    const f32x2 av = __builtin_elementwise_abs(v), d = av * 0.2316418882f + 1.0f;
    f32x2 t; t.x = __builtin_amdgcn_rcpf(d.x); t.y = __builtin_amdgcn_rcpf(d.y);
    f32x2 q = t * 0.5307027145f + (-0.7265760135f); q = q * t + 0.7107068705f; q = q * t + (-0.142248368f); q = q * t + 0.127414796f; q = q * t;
    const f32x2 s = (v * v) * (-0.72134752044f);
    f32x2 e; e.x = __builtin_amdgcn_exp2f(s.x); e.y = __builtin_amdgcn_exp2f(s.y);
    const f32x2 m = v * (q * e), r = v - m;
    f32x2 o; o.x = v.x < 0.f ? m.x : r.x; o.y = v.y < 0.f ? m.y : r.y; return o;
}

#define XB_TMO      128
#define XB_XCNT(j)  (256  + 64 * (j))
#define XB_XSUB(j)  (1280 + 64 * (j))
#define XB_XGEN(j)  (2304 + 64 * (j))
#define XB_TOP      3328
#define XB_TOPGEN   3392
#define XCD_BAR_WORDS 3456
#define XB_SPIN_CAP (1u << 18)
__device__ __forceinline__ unsigned xb_ld(unsigned* p)              { return __hip_atomic_load(p, __ATOMIC_RELAXED, __HIP_MEMORY_SCOPE_AGENT); }
__device__ __forceinline__ unsigned xb_add(unsigned* p, unsigned v) { return __hip_atomic_fetch_add(p, v, __ATOMIC_RELAXED, __HIP_MEMORY_SCOPE_AGENT); }
__device__ __forceinline__ unsigned xb_xcc_id() { return (unsigned)__builtin_amdgcn_s_getreg((3 << 11) | 20) & 0xFu; }
#define XB_SPIN(cond, bar) do { unsigned _sp = 0; while (cond) { __builtin_amdgcn_s_sleep(1); \
    if ((++_sp & 255u) == 0u) { if (xb_ld(&(bar)[XB_TMO])) break; if (_sp > XB_SPIN_CAP) { atomicAdd(&(bar)[XB_TMO], 1u); break; } } } } while (0)
struct XcdBarrier { unsigned* bar; unsigned x; volatile LAS unsigned* st; };
__device__ __forceinline__ XcdBarrier xcd_barrier_post(unsigned* bar, volatile LAS unsigned* st) {
    XcdBarrier b; b.bar = bar; b.x = xb_xcc_id(); b.st = st;
    if (threadIdx.x == 0) (void)xb_add(&bar[XB_XCNT(b.x)], 1u);
    return b;
}
__device__ __forceinline__ void xcd_barrier_complete(unsigned* bar, unsigned x, unsigned& nloc, unsigned& nx) {
    const unsigned G = gridDim.x * gridDim.y * gridDim.z;
    unsigned sum, cnt, mine, sp = 0u;
    for (;;) {
        sum = 0u; cnt = 0u; mine = 0u;
#pragma unroll
        for (unsigned j = 0; j < 16; ++j) { const unsigned c = xb_ld(&bar[XB_XCNT(j)]); sum += c; cnt += (c > 0u) ? 1u : 0u; mine = (j == x) ? c : mine; }
        if (sum == G) break;
        __builtin_amdgcn_s_sleep(1);
        if ((++sp & 255u) == 0u) { if (xb_ld(&bar[XB_TMO])) break; if (sp > XB_SPIN_CAP) { atomicAdd(&bar[XB_TMO], 1u); break; } }
    }
    nloc = mine > 0u ? mine : 1u; nx = cnt > 0u ? cnt : 1u;
}
__device__ __forceinline__ void xcd_barrier(const XcdBarrier& b) {
    asm volatile("s_waitcnt vmcnt(0)" ::: "memory");
    __syncthreads();
    if (threadIdx.x == 0) {
        unsigned* bar = b.bar;
        __builtin_amdgcn_s_waitcnt(0);
        unsigned nloc = b.st[0], nx = b.st[1];
        if (nloc == 0u) { xcd_barrier_complete(bar, b.x, nloc, nx); b.st[0] = nloc; b.st[1] = nx; }
        const unsigned old = xb_add(&bar[XB_XSUB(b.x)], 1u);
        const unsigned gen = old / nloc;
        if (old + 1u == (gen + 1u) * nloc) {
            __builtin_amdgcn_fence(__ATOMIC_RELEASE, "agent");
            asm volatile("s_waitcnt vmcnt(0)" ::: "memory");
            const unsigned og = xb_add(&bar[XB_TOP], 1u);
            const unsigned tg = og / nx;
            if (og + 1u == (tg + 1u) * nx) xb_add(&bar[XB_TOPGEN], 1u);
            else XB_SPIN(xb_ld(&bar[XB_TOPGEN]) == tg, bar);
            __builtin_amdgcn_fence(__ATOMIC_ACQUIRE, "agent");
            xb_add(&bar[XB_XGEN(b.x)], 1u);
            asm volatile("s_waitcnt vmcnt(0)" ::: "memory");
        } else {
            XB_SPIN(xb_ld(&bar[XB_XGEN(b.x)]) == gen, bar);
            __builtin_amdgcn_fence(__ATOMIC_ACQUIRE, "agent");
            asm volatile("s_waitcnt vmcnt(0)" ::: "memory");
        }
    }
    __syncthreads();
}

namespace pg8 {
constexpr int BM = 256, BK = 64, HALF = 128, HTB = HALF * BK * 2, STAGE_BYTES = 8 * HTB, NXCD = 8, WGM = 8;
__host__ __device__ __forceinline__ int lds_byte(int r, int c) { const int st = (r >> 4) * 2 + (c >> 5), rr = r & 15, cc = c & 31, ob = rr * 64 + cc * 2; return st * 1024 + (ob ^ (((ob >> 9) & 1) << 5)); }
__host__ __device__ __forceinline__ void stage_rc(int b, int& R, int& C) { const int st = b / 1024, sb = b % 1024, swz = sb ^ (((sb >> 9) & 1) << 5); R = (st >> 1) * 16 + swz / 64; C = (st & 1) * 32 + (swz % 64) / 2; }
__host__ __device__ __forceinline__ int perm32(int rho) { const int n = rho >> 4, i = rho & 15; return 8 * (i >> 2) + 4 * n + (i & 3); }

struct GU { const char* A; const char* B; const int* gidx; int gcnt; int pm, pn, e; };

struct StaticOrder {
    int nM, nN, nwg, G, c; const char* A; const char* B; size_t tstepA, tstepB;
    __device__ void init(const void* A_, const void* B_, int M, int N, unsigned lda, unsigned ldb, int G_, int c_) { nM = M / BM; nN = N / BM; nwg = nM * nN; G = G_; c = c_; A = (const char*)A_; B = (const char*)B_; tstepA = (size_t)BM * lda; tstepB = (size_t)BM * ldb; }
    __device__ bool next(int i, GU& u) const {
        const long L = (long)i * G + c; if (L >= nwg) return false;
        int wgid = (int)L; { const int q = nwg / NXCD, r = nwg % NXCD, xcd = wgid % NXCD, off = wgid / NXCD; wgid = (xcd < r ? xcd * (q + 1) : r * (q + 1) + (xcd - r) * q) + off; }
        const int nig = WGM * nN, gid = wgid / nig, fm = gid * WGM, gsz = (nM - fm) < WGM ? (nM - fm) : WGM;
        u.pm = fm + ((wgid % nig) % gsz); u.pn = (wgid % nig) / gsz; u.e = 0; u.gidx = nullptr; u.gcnt = 0;
        u.A = A + (size_t)u.pm * tstepA; u.B = B + (size_t)u.pn * tstepB; return true;
    }
};

template <class Epi, class Sched, bool GATHER, bool ALIGN_EPI>
__device__ __forceinline__ void gemm_phase(LAS unsigned char* lds, const int K, const unsigned lda, const unsigned ldb, const Sched& S, const Epi& E) {
    const int tid = threadIdx.x, wid = __builtin_amdgcn_readfirstlane(tid >> 6), lane = tid & 63, wr = wid >> 2, wc = wid & 3, fr = lane & 15, fq = lane >> 4;
    const int nt = K / BK;
    int R0, C0, R1, C1; stage_rc(tid * 16, R0, C0); stage_rc(tid * 16 + 8192, R1, C1);
    const int Rb0 = (R0 & ~31) + perm32(R0 & 31), Rb1 = (R1 & ~31) + perm32(R1 & 31);
    const unsigned vB0 = (unsigned)Rb0 * ldb + (unsigned)C0 * 2u, vB1 = (unsigned)Rb1 * ldb + (unsigned)C1 * 2u;
    const size_t kstep = (size_t)(BK * 2);
    const size_t hstepB = (size_t)HALF * ldb;
    const unsigned ldsw = (unsigned)wid * 1024u;
    const int aoff = lds_byte(wr * 64 + fr, fq * 8), boff = lds_byte(wc * 32 + fr, fq * 8);
#define PG8_SA(b, h) (((b) * 2 + (h)) * HTB)
#define PG8_SB(b, h) ((4 + (b) * 2 + (h)) * HTB)
#define PG8_STAGE(bufoff, gbase, v0, v1) do { \
        __builtin_amdgcn_global_load_lds((const unsigned*)((const char*)(gbase) + (v0)), (LAS unsigned*)(lds + (bufoff) + ldsw), 16, 0, 0); \
        __builtin_amdgcn_global_load_lds((const unsigned*)((const char*)(gbase) + (v1)), (LAS unsigned*)(lds + (bufoff) + ldsw + 8192), 16, 0, 0); } while (0)
#define PG8_LDA(dst, b, h) do { _Pragma("unroll") for (int m = 0; m < 4; ++m) _Pragma("unroll") for (int k = 0; k < 2; ++k) dst[m][k] = *(const LAS bf16x8*)(lds + PG8_SA(b, h) + aoff + m * 2048 + k * 1024); } while (0)
#define PG8_LDB(dst, b, h) do { _Pragma("unroll") for (int n = 0; n < 2; ++n) _Pragma("unroll") for (int k = 0; k < 2; ++k) dst[n][k] = *(const LAS bf16x8*)(lds + PG8_SB(b, h) + boff + n * 2048 + k * 1024); } while (0)
#define PG8_MMA(ai, bj, At, Bt) do { __builtin_amdgcn_s_setprio(1); _Pragma("unroll") for (int m = 0; m < 4; ++m) _Pragma("unroll") for (int n = 0; n < 2; ++n) _Pragma("unroll") for (int k = 0; k < 2; ++k) \
        acc[ai][bj][m][n] = __builtin_amdgcn_mfma_f32_16x16x32_bf16(Bt[n][k], At[m][k], acc[ai][bj][m][n], 0, 0, 0); __builtin_amdgcn_s_setprio(0); } while (0)
#define PG8_WAIT_V(n) asm volatile("s_waitcnt vmcnt(" #n ")" ::: "memory")
#define PG8_WAIT_L(n) asm volatile("s_waitcnt lgkmcnt(" #n ")" ::: "memory")
#define PG8_BAR __builtin_amdgcn_s_barrier()
#define PG8_SCHED __builtin_amdgcn_sched_barrier(0)
#define PG8_AOFFS(u, o00, o01, o10, o11) do { \
        if constexpr (GATHER) { \
            const int i00 = R0 < (u).gcnt ? (u).gidx[R0] : 0, i01 = R1 < (u).gcnt ? (u).gidx[R1] : 0; \
            const int i10 = (HALF + R0) < (u).gcnt ? (u).gidx[HALF + R0] : 0, i11 = (HALF + R1) < (u).gcnt ? (u).gidx[HALF + R1] : 0; \
            o00 = (unsigned)i00 * lda + (unsigned)C0 * 2u; o01 = (unsigned)i01 * lda + (unsigned)C1 * 2u; \
            o10 = (unsigned)i10 * lda + (unsigned)C0 * 2u; o11 = (unsigned)i11 * lda + (unsigned)C1 * 2u; \
            asm volatile("s_waitcnt vmcnt(0)" : "+v"(o00), "+v"(o01), "+v"(o10), "+v"(o11) :: "memory"); \
        } else { \
            o00 = (unsigned)R0 * lda + (unsigned)C0 * 2u; o01 = (unsigned)R1 * lda + (unsigned)C1 * 2u; \
            o10 = (unsigned)(HALF + R0) * lda + (unsigned)C0 * 2u; o11 = (unsigned)(HALF + R1) * lda + (unsigned)C1 * 2u; \
        } } while (0)
    GU cur, nxt; int ui = 0;
    if (!S.next(0, cur)) return;
    f32x4 acc[2][2][4][2];
#pragma unroll
    for (int a = 0; a < 2; ++a)
#pragma unroll
        for (int b = 0; b < 2; ++b)
#pragma unroll
            for (int m = 0; m < 4; ++m)
#pragma unroll
                for (int n = 0; n < 2; ++n) acc[a][b][m][n] = (f32x4){0.f, 0.f, 0.f, 0.f};
    bf16x8 At[4][2], B0[2][2], B1[2][2];
    const char* cA = cur.A; const char* cB = cur.B;
    unsigned c00, c01, c10, c11, n00, n01, n10, n11;
    PG8_AOFFS(cur, c00, c01, c10, c11);
    PG8_STAGE(PG8_SB(0, 0), cB, vB0, vB1); PG8_STAGE(PG8_SB(0, 1), cB + hstepB, vB0, vB1); PG8_STAGE(PG8_SA(0, 0), cA, c00, c01); PG8_STAGE(PG8_SA(0, 1), cA, c10, c11);
    if (wr == 1) PG8_BAR;
    PG8_WAIT_V(2); PG8_BAR;
    PG8_STAGE(PG8_SB(1, 0), cB + kstep, vB0, vB1); PG8_STAGE(PG8_SA(1, 0), cA + kstep, c00, c01); PG8_STAGE(PG8_SB(1, 1), cB + hstepB + kstep, vB0, vB1);
    PG8_WAIT_V(6); PG8_BAR;
    for (;;) {
        const bool has_next = S.next(ui + 1, nxt);
        const char* nA = has_next ? nxt.A : cA; const char* nB = has_next ? nxt.B : cB;
        if (has_next) { PG8_AOFFS(nxt, n00, n01, n10, n11); } else { n00 = c00; n01 = c01; n10 = c10; n11 = c11; }
#pragma nounroll
        for (int t = 0; t < nt; t += 2) {
            const bool last = (t == nt - 2);
            const char* a1 = cA + (size_t)(t + 1) * kstep;
            const char* a2 = last ? nA : cA + (size_t)(t + 2) * kstep; const char* b2 = last ? nB : cB + (size_t)(t + 2) * kstep;
            const char* a3 = a2 + kstep; const char* b3 = b2 + kstep;
            const unsigned x00 = last ? n00 : c00, x01 = last ? n01 : c01, x10 = last ? n10 : c10, x11 = last ? n11 : c11;
            PG8_LDB(B0, 0, 0); PG8_LDB(B1, 0, 1); PG8_SCHED; PG8_LDA(At, 0, 0); PG8_STAGE(PG8_SA(1, 1), a1, c10, c11);
            PG8_WAIT_V(8); PG8_WAIT_L(0); PG8_BAR; PG8_MMA(0, 0, At, B0); PG8_MMA(0, 1, At, B1); PG8_BAR; PG8_SCHED;
            PG8_LDA(At, 0, 1); PG8_STAGE(PG8_SB(0, 0), b2, vB0, vB1); PG8_STAGE(PG8_SB(0, 1), b2 + hstepB, vB0, vB1); PG8_STAGE(PG8_SA(0, 0), a2, x00, x01);
            PG8_WAIT_V(8); PG8_WAIT_L(0); PG8_BAR; PG8_MMA(1, 0, At, B0); PG8_MMA(1, 1, At, B1); PG8_BAR; PG8_SCHED;
            PG8_LDB(B0, 1, 0); PG8_LDB(B1, 1, 1); PG8_SCHED; PG8_LDA(At, 1, 0); PG8_STAGE(PG8_SA(0, 1), a2, x10, x11);
            PG8_WAIT_V(8); PG8_WAIT_L(0); PG8_BAR; PG8_MMA(0, 0, At, B0); PG8_MMA(0, 1, At, B1); PG8_BAR; PG8_SCHED;
            PG8_LDA(At, 1, 1); PG8_STAGE(PG8_SB(1, 0), b3, vB0, vB1); PG8_STAGE(PG8_SB(1, 1), b3 + hstepB, vB0, vB1); PG8_STAGE(PG8_SA(1, 0), a3, x00, x01);
            PG8_WAIT_V(8); PG8_WAIT_L(0); PG8_BAR; PG8_MMA(1, 0, At, B0); PG8_MMA(1, 1, At, B1); PG8_BAR; PG8_SCHED;
        }
        if constexpr (ALIGN_EPI) { if (wr == 0) PG8_BAR; }
        E(acc, cur, wr, wc, fr, fq);
        if (!has_next) break;
#pragma unroll
        for (int a = 0; a < 2; ++a)
#pragma unroll
            for (int b = 0; b < 2; ++b)
#pragma unroll
                for (int m = 0; m < 4; ++m)
#pragma unroll
                    for (int n = 0; n < 2; ++n) acc[a][b][m][n] = (f32x4){0.f, 0.f, 0.f, 0.f};
        cur = nxt; cA = nA; cB = nB; c00 = n00; c01 = n01; c10 = n10; c11 = n11; ++ui;
        if constexpr (ALIGN_EPI) { if (wr == 1) PG8_BAR; }
    }
    PG8_WAIT_V(0);
    if constexpr (!ALIGN_EPI) { if (wr == 0) PG8_BAR; }
    PG8_BAR;
#undef PG8_SA
#undef PG8_SB
#undef PG8_STAGE
#undef PG8_LDA
#undef PG8_LDB
#undef PG8_MMA
#undef PG8_WAIT_V
#undef PG8_WAIT_L
#undef PG8_BAR
#undef PG8_SCHED
#undef PG8_AOFFS
}
}
namespace pg8 {
typedef const f32x4 (&AccRef)[2][2][4][2];
__device__ __forceinline__ u32x4 pack8(f32x4 a, f32x4 b) { u32x4 w; w.x = cvt_pk_bf16(a[0], a[1]); w.y = cvt_pk_bf16(a[2], a[3]); w.z = cvt_pk_bf16(b[0], b[1]); w.w = cvt_pk_bf16(b[2], b[3]); return w; }
__device__ __forceinline__ void unpack8(u32x4 w, f32x4& a, f32x4& b) { a = (f32x4){bf_lo(w.x), bf_hi(w.x), bf_lo(w.y), bf_hi(w.y)}; b = (f32x4){bf_lo(w.z), bf_hi(w.z), bf_lo(w.w), bf_hi(w.w)}; }

struct EpiInProj {
    unsigned char* ws; const float* rcos;
    __device__ __forceinline__ void operator()(AccRef acc, const GU& un, int wr, int wc, int fr, int fq) const {
        const int pn = un.pn; const int row0 = un.pm * BM + wr * 64 + fr;
        if (pn < 4) {
            const float* rsin = rcos + SEQ * 32;
            bf16_t* dst = (bf16_t*)(ws + WS_Q + (size_t)(pn >> 1) * (16 * MiB)); const int dcol = (4 * (pn & 1) + wc) * 64 + 8 * fq;
#pragma unroll
            for (int ai = 0; ai < 2; ++ai)
#pragma unroll
                for (int m = 0; m < 4; ++m) {
                    const int row = row0 + ai * HALF + m * 16; const int pos = row & (SEQ - 1);
                    const f32x4 c0 = *(const f32x4*)(rcos + pos * 32 + 8 * fq), c1 = *(const f32x4*)(rcos + pos * 32 + 8 * fq + 4);
                    const f32x4 s0 = *(const f32x4*)(rsin + pos * 32 + 8 * fq), s1 = *(const f32x4*)(rsin + pos * 32 + 8 * fq + 4);
                    const f32x4 a0 = acc[ai][0][m][0], a1 = acc[ai][0][m][1], b0 = acc[ai][1][m][0], b1 = acc[ai][1][m][1];
                    const f32x4 o0 = a0 * c0 - b0 * s0, o1 = a1 * c1 - b1 * s1, p0 = b0 * c0 + a0 * s0, p1 = b1 * c1 + a1 * s1;
                    bf16_t* rp = dst + (size_t)row * AW + dcol;
                    *(u32x4*)rp = pack8(o0, o1); *(u32x4*)(rp + 32) = pack8(p0, p1);
                }
        } else {
            static_assert(WS_K == WS_Q + 16 * MiB && WS_VG == WS_U + 32 * MiB && WS_GA == WS_U + 64 * MiB && WS_GB == WS_U + 96 * MiB, "in-proj output map");
            const int grp = (pn - 6) >> 2;
            bf16_t* dst = (bf16_t*)(ws + (pn < 6 ? WS_V : WS_U + (size_t)grp * (32 * MiB)));
            const int ldc = pn < 6 ? AW : GW; const int ct = pn < 6 ? pn - 4 : (pn - 6) & 3; const int act = pn < 6 ? 0 : (pn < 14 ? 1 : 2);
            const int col0 = ct * BM + wc * 32 + 8 * fq;
#pragma unroll
            for (int ai = 0; ai < 2; ++ai)
#pragma unroll
                for (int m = 0; m < 4; ++m) {
                    bf16_t* rp = dst + (size_t)(row0 + ai * HALF + m * 16) * ldc + col0;
#pragma unroll
                    for (int bj = 0; bj < 2; ++bj) {
                        f32x4 v0 = acc[ai][bj][m][0], v1 = acc[ai][bj][m][1];
                        if (act == 1) { f32x2 a = gelu_pk((f32x2){v0[0], v0[1]}), b = gelu_pk((f32x2){v0[2], v0[3]}), c = gelu_pk((f32x2){v1[0], v1[1]}), d = gelu_pk((f32x2){v1[2], v1[3]});
                            v0 = (f32x4){a.x, a.y, b.x, b.y}; v1 = (f32x4){c.x, c.y, d.x, d.y}; }
                        else if (act == 2) {
#pragma unroll
                            for (int j = 0; j < 4; ++j) { v0[j] = fast_sigmoid(v0[j]); v1[j] = fast_sigmoid(v1[j]); } }
                        *(u32x4*)(rp + bj * HALF) = pack8(v0, v1);
                    }
                }
        }
    }
};
template <bool ROWSCALE> struct EpiBf16 {
    bf16_t* O; int ldc; const float* roww;
    __device__ __forceinline__ void operator()(AccRef acc, const GU& un, int wr, int wc, int fr, int fq) const {
        const int row0 = un.pm * BM + wr * 64 + fr; const int col0 = un.pn * BM + wc * 32 + 8 * fq;
#pragma unroll
        for (int ai = 0; ai < 2; ++ai)
#pragma unroll
            for (int m = 0; m < 4; ++m) {
                const int row = row0 + ai * HALF + m * 16; bf16_t* rp = O + (size_t)row * ldc + col0;
                float s = 1.f; if constexpr (ROWSCALE) s = roww[row];
#pragma unroll
                for (int bj = 0; bj < 2; ++bj) *(u32x4*)(rp + bj * HALF) = pack8(acc[ai][bj][m][0] * s, acc[ai][bj][m][1] * s);
            }
    }
};
constexpr float YROW_SCALE = 32.f;
struct EpiDown {
    unsigned char* O;
    __device__ __forceinline__ void operator()(AccRef acc, const GU& un, int wr, int wc, int fr, int fq) const {
        const int r0 = wr * 64 + fr; const int col0 = un.pn * BM + wc * 32 + 8 * fq; const float* wts = (const float*)un.gidx;
#pragma unroll
        for (int ai = 0; ai < 2; ++ai)
#pragma unroll
            for (int m = 0; m < 4; ++m) {
                const int r = r0 + ai * HALF + m * 16; unsigned char* rp = O + (size_t)(un.pm * BM + r) * DM + col0;
                if (r < un.gcnt) { const float s = wts[r] * YROW_SCALE;
#pragma unroll
                for (int bj = 0; bj < 2; ++bj) { const f32x4 a = acc[ai][bj][m][0] * s, b = acc[ai][bj][m][1] * s;
                    int w0 = __builtin_amdgcn_cvt_pk_fp8_f32(a[0], a[1], 0, false); w0 = __builtin_amdgcn_cvt_pk_fp8_f32(a[2], a[3], w0, true);
                    int w1 = __builtin_amdgcn_cvt_pk_fp8_f32(b[0], b[1], 0, false); w1 = __builtin_amdgcn_cvt_pk_fp8_f32(b[2], b[3], w1, true);
                    *(u32x2*)(rp + bj * HALF) = (u32x2){(unsigned)w0, (unsigned)w1}; } }
            }
    }
};
template <bool ADD> struct EpiGate {
    bf16_t* O; const bf16_t* G;
    __device__ __forceinline__ void operator()(AccRef acc, const GU& un, int wr, int wc, int fr, int fq) const {
        const int row0 = un.pm * BM + wr * 64 + fr; const int col0 = un.pn * BM + wc * 32 + 8 * fq;
#pragma unroll
        for (int ai = 0; ai < 2; ++ai)
#pragma unroll
            for (int m = 0; m < 4; ++m) {
                const size_t off = (size_t)(row0 + ai * HALF + m * 16) * DM + col0;
#pragma unroll
                for (int bj = 0; bj < 2; ++bj) {
                    f32x4 g0, g1; unpack8(*(const u32x4*)(G + off + bj * HALF), g0, g1);
                    f32x4 v0 = acc[ai][bj][m][0] * g0, v1 = acc[ai][bj][m][1] * g1;
                    if constexpr (ADD) { f32x4 p0, p1; unpack8(*(const u32x4*)(O + off + bj * HALF), p0, p1); v0 += p0; v1 += p1; }
                    *(u32x4*)(O + off + bj * HALF) = pack8(v0, v1);
                }
            }
    }
};
struct EpiRouterShared {
    float* logits; bf16_t* shid;
    __device__ __forceinline__ void operator()(AccRef acc, const GU& un, int wr, int wc, int fr, int fq) const {
        const int row0 = un.pm * BM + wr * 64 + fr;
        if (un.pn == 0) {
#pragma unroll
            for (int ai = 0; ai < 2; ++ai)
#pragma unroll
                for (int m = 0; m < 4; ++m) { float* rp = logits + (size_t)(row0 + ai * HALF + m * 16) * NE + wc * 32 + 8 * fq;
#pragma unroll
                    for (int bj = 0; bj < 2; ++bj) { *(f32x4*)(rp + bj * HALF) = acc[ai][bj][m][0]; *(f32x4*)(rp + bj * HALF + 4) = acc[ai][bj][m][1]; } }
        } else {
            const int col0 = (un.pn - 1) * HALF + wc * 32 + 8 * fq;
#pragma unroll
            for (int ai = 0; ai < 2; ++ai)
#pragma unroll
                for (int m = 0; m < 4; ++m) {
                    f32x4 h0, h1;
#pragma unroll
                    for (int j = 0; j < 4; ++j) { const float g0 = acc[ai][0][m][0][j], g1 = acc[ai][0][m][1][j];
                        h0[j] = g0 * fast_sigmoid(g0) * acc[ai][1][m][0][j]; h1[j] = g1 * fast_sigmoid(g1) * acc[ai][1][m][1][j]; }
                    *(u32x4*)(shid + (size_t)(row0 + ai * HALF + m * 16) * SD + col0) = pack8(h0, h1);
                }
        }
    }
};
struct EpiGateUp {
    bf16_t* hid;
    __device__ __forceinline__ void operator()(AccRef acc, const GU& un, int wr, int wc, int fr, int fq) const {
        const int row0 = un.pm * BM + wr * 64 + fr; const int col0 = un.pn * HALF + wc * 32 + 8 * fq;
#pragma unroll
        for (int ai = 0; ai < 2; ++ai)
#pragma unroll
            for (int m = 0; m < 4; ++m) {
                f32x4 h0, h1;
#pragma unroll
                for (int j = 0; j < 4; ++j) { const float g0 = acc[ai][0][m][0][j], g1 = acc[ai][0][m][1][j];
                    h0[j] = g0 * fast_sigmoid(g0) * acc[ai][1][m][0][j]; h1[j] = g1 * fast_sigmoid(g1) * acc[ai][1][m][1][j]; }
                *(u32x4*)(hid + (size_t)(row0 + ai * HALF + m * 16) * ED + col0) = pack8(h0, h1);
            }
    }
};

struct GroupedOrder {
    int G, c, NPN, ntiles; const LAS unsigned short* tile_e; const LAS unsigned short* tstart; const LAS unsigned short* cnt;
    const char* Abase; size_t a_tile_stride;
    const char* Bbase; size_t b_exp_stride, b_tile_stride;
    const int* idxbase;
    bool gather;
    __device__ bool next(int i, GU& u) const {
        const long L = (long)i * G + c; const int tile = (int)(L / NPN);
        if (tile >= ntiles) return false;
        const int pn = (int)(L % NPN); const int e = tile_e[tile]; const int mt = tile - tstart[e];
        u.pm = tile; u.pn = pn; u.e = e; u.gcnt = (int)cnt[e] - mt * BM; u.gidx = idxbase + (size_t)e * BUCKET + mt * BM;
        u.A = gather ? Abase : Abase + (size_t)tile * a_tile_stride;
        u.B = Bbase + (size_t)e * b_exp_stride + (size_t)pn * b_tile_stride;
        return true;
    }
};
}
constexpr int RING_BYTES = 131072;
constexpr int L_TILE_E = RING_BYTES;
constexpr int L_TSTART = L_TILE_E + 1536;
constexpr int L_CNT = L_TSTART + 512;
constexpr int L_MISC = L_CNT + 512;
constexpr int LDS_BYTES = 147456;

struct Frame {
    LAS unsigned char* lds; volatile LAS unsigned* MISC; gu32* ctl;
    int tid, lane, wave, vcu, G;
};
struct Args { const float* in[24]; float* out; unsigned char* ws; int ph_lo, ph_hi; };
#define WSP(T_, off) ((T_*)(A.ws + (off)))

__device__ __forceinline__ void cvt_item(const float* W, int ldsrc, int s0, int k0, bf16_t* WT, int Kdst, int dst_row0, LAS float* scr, int lane) {
#pragma unroll 8
    for (int i = 0; i < 32; ++i) { const int kk = 2 * i + (lane >> 5); scr[kk * 33 + (lane & 31)] = W[(size_t)(k0 + kk) * ldsrc + s0 + (lane & 31)]; }
    LDS_WAIT(); asm volatile("" ::: "memory");
    const int c = lane & 7;
#pragma unroll
    for (int j = 0; j < 4; ++j) { const int n = (lane >> 3) + 8 * j; const LAS float* s = scr + (8 * c) * 33 + n;
        u32x4 o; o.x = cvt_pk_bf16(s[0 * 33], s[1 * 33]); o.y = cvt_pk_bf16(s[2 * 33], s[3 * 33]); o.z = cvt_pk_bf16(s[4 * 33], s[5 * 33]); o.w = cvt_pk_bf16(s[6 * 33], s[7 * 33]);
        *(u32x4*)(WT + (size_t)(dst_row0 + n) * Kdst + k0 + 8 * c) = o; }
    LDS_WAIT(); asm volatile("" ::: "memory");
}
__device__ __forceinline__ void cvt_gu_item(const float* Wg, const float* Wu, bf16_t* WT, int item, LAS float* scr, int lane) {
    const int kb = item >> 4, rb = item & 15; const int p = rb >> 3, bj = (rb >> 2) & 1, q = rb & 3;
    cvt_item(bj ? Wu : Wg, 256, 128 * p + 32 * q, 64 * kb, WT, 1024, 32 * rb, scr, lane);
}

__device__ __forceinline__ void p0_phase(Frame& F, const Args& A) {
    const float* c = A.in[1]; const float* w_ada = A.in[2]; const float* b_ada = A.in[3];
    float* mod = WSP(float, WS_MOD);
    if (blockIdx.x < 192) {
        LAS float* sc = (LAS float*)F.lds;
        LAS float* part = (LAS float*)(F.lds + 32768);
        for (int i = F.tid; i < NB * DM; i += NTHR) { const float v = c[i]; sc[i] = v / (1.f + expf(-v)); }
        __syncthreads();
        const int j0 = blockIdx.x * 32, col = F.lane & 31, kpar = F.lane >> 5;
        float acc[NB];
#pragma unroll
        for (int b = 0; b < NB; ++b) acc[b] = 0.f;
        for (int i = 0; i < 64; ++i) { const int k = F.wave * 128 + 2 * i + kpar; const float w = w_ada[(size_t)k * (6 * DM) + j0 + col];
#pragma unroll
            for (int b = 0; b < NB; ++b) acc[b] += sc[b * DM + k] * w; }
#pragma unroll
        for (int b = 0; b < NB; ++b) { acc[b] += __shfl_xor(acc[b], 32); if (F.lane < 32) part[(F.wave * NB + b) * 32 + col] = acc[b]; }
        __syncthreads();
        if (F.tid < 256) { const int b = F.tid >> 5, cc = F.tid & 31; float s = b_ada[j0 + cc];
#pragma unroll
            for (int w = 0; w < 8; ++w) s += part[(w * NB + b) * 32 + cc];
            mod[b * 6 * DM + j0 + cc] = s; }
        __syncthreads();
    }
    { const int gt = blockIdx.x * NTHR + F.tid;
      if (gt < SEQ * 32) { const int pos = gt >> 5, f = gt & 31; const float inv = powf(10000.f, -(float)f / 32.f); float sn, cs; sincosf((float)pos * inv, &sn, &cs);
          WSP(float, WS_ROPE)[gt] = cs; WSP(float, WS_ROPE)[SEQ * 32 + gt] = sn; } }
    LAS float* scr = (LAS float*)(F.lds + F.wave * 16384);
    const int gw = F.vcu * NWAVES + F.wave, NGW = F.G * NWAVES;
    constexpr int I_IN = 16 * 176, I_PA = 8 * 32, I_PB = 16 * 32, I_OUT = 16 * 32, I_RS = 16 * 24, I_SD = 4 * 32;
    constexpr int NIT = I_IN + I_PA + I_PB + I_OUT + I_RS + I_SD;
    for (int it = gw; it < NIT; it += NGW) {
        int r = it;
        if (r < I_IN) { const int kb = r / 176, rb = r % 176; const int pn = rb >> 3, blk = rb & 7; int s0;
            if (pn < 4) { const int base = (pn < 2) ? 0 : AW; s0 = base + (4 * (pn & 1) + (blk & 3)) * 64 + 32 * (blk >> 2); } else s0 = 32 * rb;
            cvt_item(A.in[4], INW, s0, 64 * kb, WSP(bf16_t, WS_WIN), DM, 32 * rb, scr, F.lane); continue; } r -= I_IN;
        if (r < I_PA) { cvt_item(A.in[9], DM, 32 * (r & 31), 64 * (r >> 5), WSP(bf16_t, WS_WPA), AW, 32 * (r & 31), scr, F.lane); continue; } r -= I_PA;
        if (r < I_PB) { cvt_item(A.in[10], DM, 32 * (r & 31), 64 * (r >> 5), WSP(bf16_t, WS_WPB), GW, 32 * (r & 31), scr, F.lane); continue; } r -= I_PB;
        if (r < I_OUT) { cvt_item(A.in[11], DM, 32 * (r & 31), 64 * (r >> 5), WSP(bf16_t, WS_WOUT), DM, 32 * (r & 31), scr, F.lane); continue; } r -= I_OUT;
        if (r < I_RS) { const int kb = r / 24, rb = r % 24;
            if (rb < 8) cvt_item(A.in[14], NE, 32 * rb, 64 * kb, WSP(bf16_t, WS_WRS), DM, 32 * rb, scr, F.lane);
            else cvt_gu_item(A.in[19], A.in[20], WSP(bf16_t, WS_WRS) + (size_t)256 * DM, kb * 16 + (rb - 8), scr, F.lane);
            continue; } r -= I_RS;
        cvt_item(A.in[21], DM, 32 * (r & 31), 64 * (r >> 5), WSP(bf16_t, WS_WSD), SD, 32 * (r & 31), scr, F.lane);
    }
}
__device__ __forceinline__ void p1_phase(Frame& F, const Args& A) {
    const int gw = F.vcu * NWAVES + F.wave, NGW = F.G * NWAVES;
    const float* x = A.in[0]; const float* mod = WSP(float, WS_MOD); bf16_t* h = WSP(bf16_t, WS_H);
    for (int m = gw; m < T; m += NGW) {
        const float* md = mod + (m / SEQ) * 6 * DM; const f32x4* xr = (const f32x4*)(x + (size_t)m * DM) + F.lane; u32x2* o8 = (u32x2*)(h + (size_t)m * DM) + F.lane;
#pragma unroll
        for (int j = 0; j < 4; ++j) { const f32x4 v = xr[64 * j]; const f32x4 sh = *((const f32x4*)md + F.lane + 64 * j), sc = *((const f32x4*)(md + DM) + F.lane + 64 * j);
            const f32x4 r = v * (sc + 1.f) + sh; u32x2 w; w.x = cvt_pk_bf16(r[0], r[1]); w.y = cvt_pk_bf16(r[2], r[3]); o8[64 * j] = w; }
    }
    LAS float* scr = (LAS float*)(F.lds + F.wave * 16384);
    constexpr int I_GU = 256, I_D = 128, I_E = I_GU + I_D;
    for (int it = gw; it < NE * I_E; it += NGW) {
        const int e = it / I_E, r = it % I_E;
        if (r < I_GU) cvt_gu_item(A.in[16] + (size_t)e * DM * ED, A.in[17] + (size_t)e * DM * ED, WSP(bf16_t, WS_WGU) + (size_t)e * 512 * DM, r, scr, F.lane);
        else { const int q = r - I_GU; cvt_item(A.in[18] + (size_t)e * ED * DM, DM, 32 * (q & 31), 64 * (q >> 5), WSP(bf16_t, WS_WD) + (size_t)e * DM * ED, ED, 32 * (q & 31), scr, F.lane); }
    }
}

__device__ __forceinline__ s16x4 tr_read(const LAS unsigned char* p) { return __builtin_bit_cast(s16x4, __builtin_amdgcn_ds_read_tr16_b64_v4i16((LAS s16x4*)p)); }
struct AttnPre { u32x4 k[4], v[4], q[2]; };
__device__ __forceinline__ void attn_decode(int u, int& p, int& b, int& h, int& d, int& r, int& n) {
    p = u >> 10; const int bh = (u & 1023) >> 4, cls = u & 15; b = bh >> 3; h = bh & 7;
    if (p == 0) { d = 1; r = 0; n = cls; } else if (p == 1) { d = 4; r = cls & 3; n = cls >> 2; } else { d = 16; r = cls; n = 0; }
}
__device__ __forceinline__ void attn_load(Frame& F, const Args& A, int u, AttnPre& P) {
    int p, b, h, d, r, n; attn_decode(u, p, b, h, d, r, n);
    const bf16_t* Q = WSP(bf16_t, WS_Q); const bf16_t* K = WSP(bf16_t, WS_K); const bf16_t* V = WSP(bf16_t, WS_V);
    const size_t tb = (size_t)b * SEQ;
#pragma unroll
    for (int i = 0; i < 4; ++i) { const int idx = F.tid + NTHR * i, row = idx >> 3, c = idx & 7; const int ci = (n - 1) * 128 + row;
        P.k[i] = (u32x4){0u, 0u, 0u, 0u}; P.v[i] = P.k[i];
        if (ci >= 0) { const size_t off = (tb + (size_t)ci * d + r) * AW + h * HD + c * 8; P.k[i] = *(const u32x4*)(K + off); P.v[i] = *(const u32x4*)(V + off); } }
#pragma unroll
    for (int i = 0; i < 2; ++i) { const int idx = F.tid + NTHR * i, row = idx >> 3, c = idx & 7;
        const size_t off = (tb + (size_t)(n * 128 + row) * d + r) * AW + h * HD + c * 8; P.q[i] = *(const u32x4*)(Q + off); }
}
__device__ __forceinline__ void attn_store_lds(Frame& F, const AttnPre& P) {
    LAS unsigned char* Qs = F.lds; LAS unsigned char* Ks = F.lds + 16384; LAS unsigned char* Vs = F.lds + 49152;
#pragma unroll
    for (int i = 0; i < 4; ++i) { const int idx = F.tid + NTHR * i, row = idx >> 3, c = idx & 7; const int lo = row * 128 + ((c ^ (row & 7)) << 4);
        *(LAS u32x4*)(Ks + lo) = P.k[i]; *(LAS u32x4*)(Vs + lo) = P.v[i]; }
#pragma unroll
    for (int i = 0; i < 2; ++i) { const int idx = F.tid + NTHR * i, row = idx >> 3, c = idx & 7; *(LAS u32x4*)(Qs + row * 128 + ((c ^ (row & 7)) << 4)) = P.q[i]; }
}
__device__ __forceinline__ void attn_compute(Frame& F, const Args& A, int u) {
    LAS unsigned char* Qs = F.lds; LAS unsigned char* Ks = F.lds + 16384; LAS unsigned char* Vs = F.lds + 49152;
    int p, b, h, d, r, n; attn_decode(u, p, b, h, d, r, n);
    const int lane = F.lane, w = F.wave, g = lane >> 4, li = lane & 15;
    const size_t tb = (size_t)b * SEQ;
    bf16x8 qf[2];
    { const int row = 16 * w + li;
#pragma unroll
      for (int ks = 0; ks < 2; ++ks) qf[ks] = *(const LAS bf16x8*)(Qs + row * 128 + (((4 * ks + g) ^ (row & 7)) << 4)); }
    f32x4 s[9];
#pragma unroll
    for (int kt = 0; kt < 9; ++kt) { const int krow = 16 * (w + kt) + li; f32x4 a = (f32x4){0.f, 0.f, 0.f, 0.f};
#pragma unroll
        for (int ks = 0; ks < 2; ++ks) { const bf16x8 kf = *(const LAS bf16x8*)(Ks + krow * 128 + (((4 * ks + g) ^ (krow & 7)) << 4)); a = __builtin_amdgcn_mfma_f32_16x16x32_bf16(kf, qf[ks], a, 0, 0, 0); }
        s[kt] = a; }
    float mx = -INFINITY;
#pragma unroll
    for (int kt = 0; kt < 9; ++kt)
#pragma unroll
        for (int rr = 0; rr < 4; ++rr) { const int kk = 16 * kt + 4 * g + rr; const int kj = 16 * w + kk;
            const bool ok = (kk >= li) && (kk <= li + 128) && (n > 0 || kj >= 128);
            const float v = ok ? s[kt][rr] : -INFINITY; s[kt][rr] = v; mx = fmaxf(mx, v); }
    mx = fmaxf(mx, __shfl_xor(mx, 16)); mx = fmaxf(mx, __shfl_xor(mx, 32));
    const float C = 0.125f * 1.4426950408889634f; float ls = 0.f;
#pragma unroll
    for (int kt = 0; kt < 9; ++kt)
#pragma unroll
        for (int rr = 0; rr < 4; ++rr) { const float e = __builtin_amdgcn_exp2f((s[kt][rr] - mx) * C); s[kt][rr] = e; ls += e; }
    ls += __shfl_xor(ls, 16); ls += __shfl_xor(ls, 32);
    f32x4 o[4];
#pragma unroll
    for (int nt = 0; nt < 4; ++nt) o[nt] = (f32x4){0.f, 0.f, 0.f, 0.f};
    const int q4 = li >> 2, p4 = li & 3;
#pragma unroll
    for (int k2 = 0; k2 < 5; ++k2) {
        const int t0 = 2 * k2, t1 = 2 * k2 + 1;
        u32x4 pw; pw.x = cvt_pk_bf16(s[t0][0], s[t0][1]); pw.y = cvt_pk_bf16(s[t0][2], s[t0][3]);
        if (t1 < 9) { pw.z = cvt_pk_bf16(s[t1 < 9 ? t1 : 8][0], s[t1 < 9 ? t1 : 8][1]); pw.w = cvt_pk_bf16(s[t1 < 9 ? t1 : 8][2], s[t1 < 9 ? t1 : 8][3]); } else { pw.z = 0u; pw.w = 0u; }
        const bf16x8 pa = __builtin_bit_cast(bf16x8, pw);
        int KT1 = w + t1; if (KT1 > 15) KT1 = 15;
        const int r0 = 16 * (w + t0) + 4 * g + q4, r1 = 16 * KT1 + 4 * g + q4;
#pragma unroll
        for (int nt = 0; nt < 4; ++nt) { const int ch = 2 * nt + (p4 >> 1);
            const s16x4 lo = tr_read(Vs + r0 * 128 + ((ch ^ (r0 & 7)) << 4) + (p4 & 1) * 8), hi = tr_read(Vs + r1 * 128 + ((ch ^ (r1 & 7)) << 4) + (p4 & 1) * 8);
            const bf16x8 vb = (bf16x8){lo[0], lo[1], lo[2], lo[3], hi[0], hi[1], hi[2], hi[3]};
            o[nt] = __builtin_amdgcn_mfma_f32_16x16x32_bf16(pa, vb, o[nt], 0, 0, 0); }
    }
    const float linv = 1.f / ls;
    LAS bf16_t* st = (LAS bf16_t*)(Qs + 16 * w * 128);
#pragma unroll
    for (int rr = 0; rr < 4; ++rr) { const float sc = __shfl(linv, 4 * g + rr);
#pragma unroll
        for (int nt = 0; nt < 4; ++nt) st[(4 * g + rr) * 64 + 16 * nt + li] = (bf16_t)(cvt_pk_bf16(o[nt][rr] * sc, 0.f) & 0xffffu); }
    LDS_WAIT(); asm volatile("" ::: "memory");
    bf16_t* OP = WSP(bf16_t, WS_OP) + (size_t)p * T * AW; float* LSE = WSP(float, WS_LSE) + (size_t)p * T * NH;
#pragma unroll
    for (int i = 0; i < 2; ++i) { const int cidx = lane + 64 * i, row = cidx >> 3, c = cidx & 7;
        const size_t tok = tb + (size_t)(n * 128 + 16 * w + row) * d + r;
        *(u32x4*)(OP + tok * AW + h * HD + c * 8) = *(const LAS u32x4*)((const LAS unsigned char*)st + row * 128 + c * 16); }
    if (lane < 16) { const size_t tok = tb + (size_t)(n * 128 + 16 * w + li) * d + r; LSE[tok * NH + h] = mx * 0.125f + logf(ls); }
}
__device__ __forceinline__ void attn_phase(Frame& F, const Args& A) {
    int u = F.vcu; AttnPre P;
    if (u < 3072) attn_load(F, A, u, P);
    while (u < 3072) {
        attn_store_lds(F, P);
        __syncthreads();
        const int un = u + F.G;
        if (un < 3072) attn_load(F, A, un, P);
        attn_compute(F, A, u);
        __syncthreads();
        u = un;
    }
}
__device__ __forceinline__ void sgu_unit(Frame& F, const Args& A, int bc, int g, bool do_stats) {
    LAS unsigned char* Ws = F.lds; LAS unsigned char* Vn = F.lds + 32768; LAS f32x2* stats = (LAS f32x2*)(F.lds + 65536);
    const size_t t0 = (size_t)bc * 128;
    const bf16_t* VG = WSP(bf16_t, WS_VG); const bf16_t* U = WSP(bf16_t, WS_U); bf16_t* SG = WSP(bf16_t, WS_SG);
    const float* lng = A.in[5]; const float* lnb = A.in[6]; const float* wsp = A.in[7] + (size_t)g * 128 * 128; const float* bsp = A.in[8] + g * 128;
    const int tid = F.tid, lane = F.lane, w = F.wave, g4 = lane >> 4, li = lane & 15;
    if (do_stats) { const int row = tid >> 2, qd = tid & 3; const u32x4* pr = (const u32x4*)(VG + (t0 + row) * GW + qd * 256); float s1 = 0.f, s2 = 0.f;
#pragma unroll 8
      for (int i = 0; i < 32; ++i) { const u32x4 v = pr[i];
#pragma unroll
          for (int j = 0; j < 4; ++j) { const float a = bf_lo(v[j]), c = bf_hi(v[j]); s1 += a + c; s2 += a * a + c * c; } }
      s1 += __shfl_xor(s1, 1); s2 += __shfl_xor(s2, 1); s1 += __shfl_xor(s1, 2); s2 += __shfl_xor(s2, 2);
      const float mean = s1 * (1.f / 1024.f); const float var = fmaxf(s2 * (1.f / 1024.f) - mean * mean, 0.f);
      if (qd == 0) stats[row] = (f32x2){mean, 1.f / sqrtf(var + LN_EPS)}; }
#pragma unroll
    for (int i = 0; i < 8; ++i) { const int idx = tid + NTHR * i, trow = idx >> 5, c4 = idx & 31; f32x4 v = *(const f32x4*)(wsp + trow * 128 + c4 * 4);
#pragma unroll
        for (int j = 0; j < 4; ++j) if (4 * c4 + j > trow) v[j] = 0.f;
        u32x2 o; o.x = cvt_pk_bf16(v[0], v[1]); o.y = cvt_pk_bf16(v[2], v[3]);
        *(LAS u32x2*)(Ws + trow * 256 + (((c4 >> 1) ^ (trow & 15)) << 4) + (c4 & 1) * 8) = o; }
    __syncthreads();
#pragma unroll
    for (int i = 0; i < 4; ++i) { const int idx = tid + NTHR * i, srow = idx >> 4, c16 = idx & 15; const int ch0 = g * 128 + c16 * 8;
        const u32x4 v = *(const u32x4*)(VG + (t0 + srow) * GW + ch0); const f32x2 st = stats[srow];
        const f32x4 ga = *(const f32x4*)(lng + ch0), gb = *(const f32x4*)(lng + ch0 + 4), ba = *(const f32x4*)(lnb + ch0), bb = *(const f32x4*)(lnb + ch0 + 4);
        f32x4 x0, x1; pg8::unpack8(v, x0, x1);
        x0 = (x0 - st.x) * st.y * ga + ba; x1 = (x1 - st.x) * st.y * gb + bb;
        *(LAS u32x4*)(Vn + srow * 256 + ((c16 ^ (srow & 15)) << 4)) = pg8::pack8(x0, x1); }
    __syncthreads();
    f32x4 acc[8];
#pragma unroll
    for (int nt = 0; nt < 8; ++nt) acc[nt] = (f32x4){0.f, 0.f, 0.f, 0.f};
    const int nks = (w >> 1) + 1; const int arow = 16 * w + li; const int q4 = li >> 2, p4 = li & 3;
    for (int ks = 0; ks < nks; ++ks) {
        const bf16x8 af = *(const LAS bf16x8*)(Ws + arow * 256 + (((4 * ks + g4) ^ (arow & 15)) << 4));
        const int r0 = 32 * ks + 8 * g4 + q4, r1 = r0 + 4;
#pragma unroll
        for (int nt = 0; nt < 8; ++nt) { const int ch = 2 * nt + (p4 >> 1);
            const s16x4 lo = tr_read(Vn + r0 * 256 + ((ch ^ (r0 & 15)) << 4) + (p4 & 1) * 8), hi = tr_read(Vn + r1 * 256 + ((ch ^ (r1 & 15)) << 4) + (p4 & 1) * 8);
            const bf16x8 vb = (bf16x8){lo[0], lo[1], lo[2], lo[3], hi[0], hi[1], hi[2], hi[3]};
            acc[nt] = __builtin_amdgcn_mfma_f32_16x16x32_bf16(af, vb, acc[nt], 0, 0, 0); }
    }
    LAS bf16_t* st = (LAS bf16_t*)(Ws + 16 * w * 256);
#pragma unroll
    for (int rr = 0; rr < 4; ++rr) { const float bias = bsp[16 * w + 4 * g4 + rr];
#pragma unroll
        for (int nt = 0; nt < 8; ++nt) st[(4 * g4 + rr) * 128 + 16 * nt + li] = (bf16_t)(cvt_pk_bf16(acc[nt][rr] + bias, 0.f) & 0xffffu); }
    LDS_WAIT(); asm volatile("" ::: "memory");
#pragma unroll
    for (int i = 0; i < 4; ++i) { const int cidx = lane + 64 * i, row = cidx >> 4, c16 = cidx & 15; const size_t off = (t0 + 16 * w + row) * GW + g * 128 + c16 * 8;
        f32x4 a0, a1, u0, u1; pg8::unpack8(*(const LAS u32x4*)((const LAS unsigned char*)st + row * 256 + c16 * 16), a0, a1); pg8::unpack8(*(const u32x4*)(U + off), u0, u1);
        *(u32x4*)(SG + off) = pg8::pack8(a0 * u0, a1 * u1); }
    __syncthreads();
}
__device__ __forceinline__ void sgu_phase(Frame& F, const Args& A) {
    for (int uu = F.vcu; uu < 256; uu += F.G) {
        const int bc = uu >> 1, g0 = 4 * (uu & 1);
        for (int gi = 0; gi < 4; ++gi) sgu_unit(F, A, bc, g0 + gi, gi == 0);
    }
}
__device__ __forceinline__ void p4_phase(Frame& F, const Args& A) {
    const bf16_t* OP = WSP(bf16_t, WS_OP); const float* LSE = WSP(float, WS_LSE); bf16_t* OA = WSP(bf16_t, WS_OA);
    for (int idx = F.vcu * NTHR + F.tid; idx < T * 64; idx += F.G * NTHR) {
        const int t = idx >> 6, h = (idx >> 3) & 7, c = idx & 7;
        const float l0 = LSE[(size_t)t * NH + h], l1 = LSE[(size_t)(T + t) * NH + h], l2 = LSE[(size_t)(2 * T + t) * NH + h];
        const float m = fmaxf(l0, fmaxf(l1, l2)); float w0 = expf(l0 - m), w1 = expf(l1 - m), w2 = expf(l2 - m); const float inv = 1.f / (w0 + w1 + w2); w0 *= inv; w1 *= inv; w2 *= inv;
        const size_t off = (size_t)t * AW + h * HD + c * 8;
        f32x4 a0, a1, b0, b1, c0, c1; pg8::unpack8(*(const u32x4*)(OP + off), a0, a1); pg8::unpack8(*(const u32x4*)(OP + (size_t)T * AW + off), b0, b1); pg8::unpack8(*(const u32x4*)(OP + (size_t)2 * T * AW + off), c0, c1);
        *(u32x4*)(OA + off) = pg8::pack8(a0 * w0 + b0 * w1 + c0 * w2, a1 * w0 + b1 * w1 + c1 * w2);
    }
}
__device__ __forceinline__ void p7_phase(Frame& F, const Args& A) {
    const int gw = F.vcu * NWAVES + F.wave, NGW = F.G * NWAVES;
    const float* x = A.in[0]; const float* mod = WSP(float, WS_MOD); const bf16_t* mix = WSP(bf16_t, WS_MIX); float* x1 = WSP(float, WS_X1); bf16_t* h2 = WSP(bf16_t, WS_H);
    const float* g1 = A.in[12]; const float* b1 = A.in[13];
    for (int m = gw; m < T; m += NGW) {
        const float* md = mod + (m / SEQ) * 6 * DM; const f32x4* xr = (const f32x4*)(x + (size_t)m * DM) + F.lane; const u32x2* mr = (const u32x2*)(mix + (size_t)m * DM) + F.lane;
        f32x4 v[4]; float s = 0.f;
#pragma unroll
        for (int j = 0; j < 4; ++j) { const f32x4 xv = xr[64 * j]; const u32x2 mw = mr[64 * j]; const f32x4 gv = *((const f32x4*)(md + 2 * DM) + F.lane + 64 * j);
            const f32x4 mv = (f32x4){bf_lo(mw.x), bf_hi(mw.x), bf_lo(mw.y), bf_hi(mw.y)};
            v[j] = xv * ALPHA + gv * mv; s += (v[j][0] + v[j][1]) + (v[j][2] + v[j][3]); }
        const float mean = wave_sum(s) * (1.f / DM); float s2 = 0.f;
#pragma unroll
        for (int j = 0; j < 4; ++j) { v[j] = v[j] - mean; s2 += (v[j][0] * v[j][0] + v[j][1] * v[j][1]) + (v[j][2] * v[j][2] + v[j][3] * v[j][3]); }
        const float rstd = 1.f / sqrtf(wave_sum(s2) * (1.f / DM) + LN_EPS);
        f32x4* xo = (f32x4*)(x1 + (size_t)m * DM) + F.lane; u32x2* ho = (u32x2*)(h2 + (size_t)m * DM) + F.lane;
#pragma unroll
        for (int j = 0; j < 4; ++j) { const f32x4 gg = *((const f32x4*)g1 + F.lane + 64 * j), bb = *((const f32x4*)b1 + F.lane + 64 * j);
            const f32x4 o = v[j] * rstd * gg + bb; xo[64 * j] = o;
            const f32x4 sh = *((const f32x4*)(md + 3 * DM) + F.lane + 64 * j), sc = *((const f32x4*)(md + 4 * DM) + F.lane + 64 * j);
            const f32x4 r = o * (sc + 1.f) + sh; u32x2 wv; wv.x = cvt_pk_bf16(r[0], r[1]); wv.y = cvt_pk_bf16(r[2], r[3]); ho[64 * j] = wv; }
    }
}
__device__ __forceinline__ unsigned f2ord(float f) { const unsigned u = __float_as_uint(f); return (u & 0x80000000u) ? ~u : (u | 0x80000000u); }
__device__ __forceinline__ void p9_phase(Frame& F, const Args& A) {
    const int gw = F.vcu * NWAVES + F.wave, NGW = F.G * NWAVES, lane = F.lane;
    const float* logits = WSP(float, WS_LOGITS); const float* rbias = A.in[15];
    unsigned* cnt = (unsigned*)(F.ctl + CW_CNT); int* tok_e = WSP(int, WS_TOKE); int* tok_r = WSP(int, WS_TOKR); int* btok = WSP(int, WS_BTOK); float* bw = WSP(float, WS_BW);
    const f32x4 rb = *((const f32x4*)rbias + lane);
    for (int t = gw; t < T; t += NGW) {
        const f32x4 lg = *((const f32x4*)(logits + (size_t)t * NE) + lane);
        f32x4 sc, bi;
#pragma unroll
        for (int i = 0; i < 4; ++i) { sc[i] = 1.f / (1.f + expf(-lg[i])); bi[i] = sc[i] + rb[i]; }
        float m1 = fmaxf(bi[0], bi[1]), m2 = fminf(bi[0], bi[1]);
#pragma unroll
        for (int i = 2; i < 4; ++i) { const float v = bi[i]; m2 = fmaxf(m2, fminf(m1, v)); m1 = fmaxf(m1, v); }
#pragma unroll
        for (int o = 1; o < 8; o <<= 1) { const float o1 = __shfl_xor(m1, o), o2 = __shfl_xor(m2, o); const float n1 = fmaxf(m1, o1), n2 = fmaxf(fminf(m1, o1), fmaxf(m2, o2)); m1 = n1; m2 = n2; }
        const float gs = m1 + m2; const int grp = lane >> 3; int rank = 0;
#pragma unroll
        for (int gg = 0; gg < 8; ++gg) { const float v = __shfl(gs, 8 * gg); rank += (v > gs || (v == gs && gg < grp)) ? 1 : 0; }
        const bool sel = rank < 4;
        unsigned long long key[4];
#pragma unroll
        for (int i = 0; i < 4; ++i) key[i] = sel ? (((unsigned long long)f2ord(bi[i]) << 32) | (unsigned)(255 - (4 * lane + i))) : 0ull;
        int my_e = 0; float my_s = 0.f, wsum = 0.f;
#pragma unroll
        for (int r = 0; r < TOPK; ++r) {
            unsigned long long k = key[0] > key[1] ? key[0] : key[1]; { const unsigned long long k2 = key[2] > key[3] ? key[2] : key[3]; k = k > k2 ? k : k2; }
#pragma unroll
            for (int o = 1; o < 64; o <<= 1) { const unsigned long long ok = __shfl_xor(k, o); k = ok > k ? ok : k; }
            const int e = 255 - (int)(k & 0xffull); const int owner = e >> 2, sub = e & 3;
            const float sv = (sub == 0) ? sc[0] : (sub == 1) ? sc[1] : (sub == 2) ? sc[2] : sc[3];
            const float ssel = __shfl(sv, owner);
            if (lane == owner) {
#pragma unroll
                for (int i = 0; i < 4; ++i) if (i == sub) key[i] = 0ull; }
            wsum += ssel; if (lane == r) { my_e = e; my_s = ssel; }
        }
        if (lane < TOPK) {
            const float wv = 2.5f * my_s / wsum;
            const unsigned rk = atomicAdd(&cnt[my_e], 1u);
            tok_e[t * TOPK + lane] = my_e; tok_r[t * TOPK + lane] = (int)rk;
            if (rk < (unsigned)BUCKET) { btok[(size_t)my_e * BUCKET + rk] = t; bw[(size_t)my_e * BUCKET + rk] = wv; }
        }
    }
}
__device__ __forceinline__ void build_tile_table(Frame& F, const Args& A) {
    LAS unsigned short* tile_e = (LAS unsigned short*)(F.lds + L_TILE_E); LAS unsigned short* tstart = (LAS unsigned short*)(F.lds + L_TSTART);
    const unsigned* cnt = (const unsigned*)(F.ctl + CW_CNT);
    __syncthreads();
    int val = 0, incl = 0;
    if (F.tid < NE) { unsigned c = __hip_atomic_load(cnt + F.tid, RLX_AGENT); if (c > (unsigned)BUCKET) c = BUCKET; ((LAS unsigned short*)(F.lds + L_CNT))[F.tid] = (unsigned short)c; val = (int)((c + 255u) >> 8); incl = val;
#pragma unroll
        for (int o = 1; o < 64; o <<= 1) { const int v = __shfl_up(incl, o); if (F.lane >= o) incl += v; }
        if (F.lane == 63) F.MISC[F.wave] = (unsigned)incl; }
    __syncthreads();
    if (F.tid < NE) { int off = 0;
#pragma unroll
        for (int w = 0; w < 4; ++w) if (w < F.wave) off += (int)F.MISC[w];
        const int st = off + incl - val; tstart[F.tid] = (unsigned short)st;
        for (int k = 0; k < val; ++k) tile_e[st + k] = (unsigned short)F.tid;
        if (F.tid == NE - 1) F.MISC[4] = (unsigned)(off + incl); }
    __syncthreads();
}
__device__ __forceinline__ void p12_phase(Frame& F, const Args& A) {
    const int gw = F.vcu * NWAVES + F.wave, NGW = F.G * NWAVES;
    const LAS unsigned short* tstart = (const LAS unsigned short*)(F.lds + L_TSTART);
    const float* mod = WSP(float, WS_MOD); const float* x1 = WSP(float, WS_X1); const bf16_t* ysh = WSP(bf16_t, WS_YSH); const unsigned char* yrow = WSP(unsigned char, WS_YROW);
    const int* tok_e = WSP(int, WS_TOKE); const int* tok_r = WSP(int, WS_TOKR); const float* g2 = A.in[22]; const float* b2 = A.in[23]; float* out = A.out;
    const int c0 = 16 * F.lane;
    for (int m = gw; m < T; m += NGW) {
        const float* md = mod + (m / SEQ) * 6 * DM;
        f32x4 f[4];
#pragma unroll
        for (int j = 0; j < 4; ++j) f[j] = (f32x4){0.f, 0.f, 0.f, 0.f};
#pragma unroll
        for (int k = 0; k < TOPK; ++k) { const int e = tok_e[m * TOPK + k], rk = tok_r[m * TOPK + k]; const size_t pos = (size_t)tstart[e] * 256 + rk;
            const u32x4 w = *(const u32x4*)(yrow + pos * DM + c0);
#pragma unroll
            for (int j = 0; j < 4; ++j) { const f32x2 lo = __builtin_amdgcn_cvt_pk_f32_fp8((int)w[j], false), hi = __builtin_amdgcn_cvt_pk_f32_fp8((int)w[j], true); f[j] += (f32x4){lo.x, lo.y, hi.x, hi.y}; } }
        { const u32x4 s0 = *(const u32x4*)(ysh + (size_t)m * DM + c0), s1 = *(const u32x4*)(ysh + (size_t)m * DM + c0 + 8); f32x4 a, b, c, d; pg8::unpack8(s0, a, b); pg8::unpack8(s1, c, d);
          const float is = 1.f / pg8::YROW_SCALE; f[0] = f[0] * is + a; f[1] = f[1] * is + b; f[2] = f[2] * is + c; f[3] = f[3] * is + d; }
        const f32x4* xr = (const f32x4*)(x1 + (size_t)m * DM + c0); f32x4 v[4]; float s = 0.f;
#pragma unroll
        for (int j = 0; j < 4; ++j) { const f32x4 gv = *((const f32x4*)(md + 5 * DM + c0) + j); v[j] = xr[j] * ALPHA + gv * f[j]; s += (v[j][0] + v[j][1]) + (v[j][2] + v[j][3]); }
        const float mean = wave_sum(s) * (1.f / DM); float s2 = 0.f;
#pragma unroll
        for (int j = 0; j < 4; ++j) { v[j] = v[j] - mean; s2 += (v[j][0] * v[j][0] + v[j][1] * v[j][1]) + (v[j][2] * v[j][2] + v[j][3] * v[j][3]); }
        const float rstd = 1.f / sqrtf(wave_sum(s2) * (1.f / DM) + LN_EPS);
        f32x4* oo = (f32x4*)(out + (size_t)m * DM + c0);
#pragma unroll
        for (int j = 0; j < 4; ++j) { const f32x4 gg = *((const f32x4*)(g2 + c0) + j), bb = *((const f32x4*)(b2 + c0) + j); oo[j] = v[j] * rstd * gg + bb; }
    }
}
constexpr int NPHASE = 13;

__global__ void __launch_bounds__(NTHR, 2) mk_fwd(Args args) {
    extern __shared__ __attribute__((aligned(16))) unsigned char lds_raw[];
    Frame F;
    F.lds = (LAS unsigned char*)lds_raw; F.MISC = (volatile LAS unsigned*)(F.lds + L_MISC);
    F.tid = threadIdx.x; F.lane = F.tid & 63; F.wave = __builtin_amdgcn_readfirstlane(F.tid >> 6);
    F.G = gridDim.x; { const int bx = blockIdx.x; F.vcu = (F.G % 8 == 0) ? (bx % 8) * (F.G / 8) + bx / 8 : bx; }
    const Args& A = args;
    F.ctl = (gu32*)(args.ws + WS_CTL);
    if (F.tid < 64) F.MISC[F.tid] = 0u;
    __syncthreads();
    const int lo = args.ph_lo, hi = args.ph_hi;
    XcdBarrier bar; bar.bar = (unsigned*)(F.ctl + CW_BAR); bar.x = 0; bar.st = nullptr;
    if (hi - lo > 1) bar = xcd_barrier_post((unsigned*)(F.ctl + CW_BAR), F.MISC + 8);
#ifndef REPEAT_MASK
#define REPEAT_MASK 0
#endif
#define IN(k) (lo <= (k) && (k) < hi)
#define REP(k) _Pragma("nounroll") for (int rep_ = 0; rep_ < (((REPEAT_MASK >> (k)) & 1) ? 2 : 1); ++rep_)
#define SEAM(k) do { if (IN(k) && IN((k) + 1)) xcd_barrier(bar); } while (0)
    LAS unsigned char* ring = F.lds;

    if (IN(0)) REP(0) { p0_phase(F, A); } SEAM(0);
    if (IN(1)) REP(1) { p1_phase(F, A); } SEAM(1);
    if (IN(2)) REP(2) {
        pg8::StaticOrder S; S.init(WSP(bf16_t, WS_H), WSP(bf16_t, WS_WIN), T, INW, DM * 2, DM * 2, F.G, (int)blockIdx.x);
        pg8::EpiInProj E{A.ws, WSP(float, WS_ROPE)};
        pg8::gemm_phase<pg8::EpiInProj, pg8::StaticOrder, false, true>(ring, DM, DM * 2, DM * 2, S, E);
    } SEAM(2);
    if (IN(3)) REP(3) { REP(13) attn_phase(F, A); REP(14) sgu_phase(F, A); } SEAM(3);
    if (IN(4)) REP(4) { p4_phase(F, A); } SEAM(4);
    if (IN(5)) REP(5) {
        { pg8::StaticOrder S; S.init(WSP(bf16_t, WS_OA), WSP(bf16_t, WS_WPA), T, DM, AW * 2, AW * 2, F.G, (int)blockIdx.x);
          pg8::EpiGate<false> E{WSP(bf16_t, WS_MERGED), WSP(bf16_t, WS_GA)};
          pg8::gemm_phase<pg8::EpiGate<false>, pg8::StaticOrder, false, false>(ring, AW, AW * 2, AW * 2, S, E); }
        { pg8::StaticOrder S; S.init(WSP(bf16_t, WS_SG), WSP(bf16_t, WS_WPB), T, DM, GW * 2, GW * 2, F.G, (int)blockIdx.x);
          pg8::EpiGate<true> E{WSP(bf16_t, WS_MERGED), WSP(bf16_t, WS_GB)};
          pg8::gemm_phase<pg8::EpiGate<true>, pg8::StaticOrder, false, false>(ring, GW, GW * 2, GW * 2, S, E); }
    } SEAM(5);
    if (IN(6)) REP(6) {
        pg8::StaticOrder S; S.init(WSP(bf16_t, WS_MERGED), WSP(bf16_t, WS_WOUT), T, DM, DM * 2, DM * 2, F.G, (int)blockIdx.x);
        pg8::EpiBf16<false> E{WSP(bf16_t, WS_MIX), DM, nullptr};
        pg8::gemm_phase<pg8::EpiBf16<false>, pg8::StaticOrder, false, false>(ring, DM, DM * 2, DM * 2, S, E);
    } SEAM(6);
    if (IN(7)) REP(7) { p7_phase(F, A); } SEAM(7);
    if (IN(8)) REP(8) {
        pg8::StaticOrder S; S.init(WSP(bf16_t, WS_H), WSP(bf16_t, WS_WRS), T, 768, DM * 2, DM * 2, F.G, (int)blockIdx.x);
        pg8::EpiRouterShared E{WSP(float, WS_LOGITS), WSP(bf16_t, WS_SHID)};
        pg8::gemm_phase<pg8::EpiRouterShared, pg8::StaticOrder, false, true>(ring, DM, DM * 2, DM * 2, S, E);
    } SEAM(8);
    if (IN(9)) REP(9) { p9_phase(F, A); } SEAM(9);
    if (IN(10)) REP(10) {
        build_tile_table(F, A);
        pg8::GroupedOrder S; S.G = F.G; S.c = F.vcu; S.NPN = 2; S.ntiles = (int)F.MISC[4]; S.tile_e = (const LAS unsigned short*)(F.lds + L_TILE_E); S.tstart = (const LAS unsigned short*)(F.lds + L_TSTART);
        S.cnt = (const LAS unsigned short*)(F.lds + L_CNT); S.Abase = (const char*)WSP(bf16_t, WS_H); S.a_tile_stride = 0; S.Bbase = (const char*)WSP(bf16_t, WS_WGU); S.b_exp_stride = (size_t)512 * DM * 2; S.b_tile_stride = (size_t)256 * DM * 2;
        S.idxbase = WSP(int, WS_BTOK); S.gather = true;
        pg8::EpiGateUp E{WSP(bf16_t, WS_HID)};
        pg8::gemm_phase<pg8::EpiGateUp, pg8::GroupedOrder, true, true>(ring, DM, DM * 2, DM * 2, S, E);
    } SEAM(10);
    if (IN(11)) REP(11) {
        build_tile_table(F, A);
        { pg8::GroupedOrder S; S.G = F.G; S.c = F.vcu; S.NPN = 4; S.ntiles = (int)F.MISC[4]; S.tile_e = (const LAS unsigned short*)(F.lds + L_TILE_E); S.tstart = (const LAS unsigned short*)(F.lds + L_TSTART);
          S.cnt = (const LAS unsigned short*)(F.lds + L_CNT); S.Abase = (const char*)WSP(bf16_t, WS_HID); S.a_tile_stride = (size_t)256 * ED * 2; S.Bbase = (const char*)WSP(bf16_t, WS_WD); S.b_exp_stride = (size_t)DM * ED * 2; S.b_tile_stride = (size_t)256 * ED * 2;
          S.idxbase = WSP(int, WS_BW); S.gather = false;
          pg8::EpiDown E{WSP(unsigned char, WS_YROW)};
          pg8::gemm_phase<pg8::EpiDown, pg8::GroupedOrder, false, true>(ring, ED, ED * 2, ED * 2, S, E); }
        { pg8::StaticOrder S; S.init(WSP(bf16_t, WS_SHID), WSP(bf16_t, WS_WSD), T, DM, SD * 2, SD * 2, F.G, (int)blockIdx.x);
          pg8::EpiBf16<false> E{WSP(bf16_t, WS_YSH), DM, nullptr};
          pg8::gemm_phase<pg8::EpiBf16<false>, pg8::StaticOrder, false, false>(ring, SD, SD * 2, SD * 2, S, E); }
    } SEAM(11);
    if (IN(12)) REP(12) { build_tile_table(F, A); p12_phase(F, A); }
#undef IN
#undef REP
#undef SEAM
}

#ifndef MK_SPLIT
#define MK_SPLIT 0
#endif
static int mk_grid(size_t ws_size) {
    static int grid = 0;
    if (grid == 0) {
        int dev = 0, cus = 0, per_cu = 0;
        if (ws_size < WS_END) { fprintf(stderr, "kernel_launch: workspace too small (%zu < %zu)\n", ws_size, (size_t)WS_END); grid = -1; return -1; }
        if (hipGetDevice(&dev) != hipSuccess || hipDeviceGetAttribute(&cus, hipDeviceAttributeMultiprocessorCount, dev) != hipSuccess) { grid = -1; return -1; }
        if (hipFuncSetAttribute((const void*)mk_fwd, hipFuncAttributeMaxDynamicSharedMemorySize, LDS_BYTES) != hipSuccess) { fprintf(stderr, "kernel_launch: hipFuncSetAttribute failed\n"); grid = -1; return -1; }
        if (hipOccupancyMaxActiveBlocksPerMultiprocessor(&per_cu, (const void*)mk_fwd, NTHR, LDS_BYTES) != hipSuccess || per_cu < 1) { fprintf(stderr, "kernel_launch: occupancy query says %d blocks/CU\n", per_cu); (void)hipGetLastError(); grid = -1; return -1; }
        grid = cus;
    }
    return grid;
}
static void mk_run(void* const* d_in, float* out, void* d_ws, int grid, int lo, int hi, hipStream_t stream) {
    Args a{};
    for (int i = 0; i < 24; ++i) a.in[i] = (const float*)d_in[i];
    a.out = out; a.ws = (unsigned char*)d_ws; a.ph_lo = lo; a.ph_hi = hi;
#ifndef MK_COOP
#define MK_COOP 1
#endif
    if (MK_COOP && hi - lo > 1) {
        void* kargs[] = {&a};
        hipError_t e = hipLaunchCooperativeKernel((const void*)mk_fwd, dim3(grid), dim3(NTHR), kargs, LDS_BYTES, stream);
        if (e != hipSuccess) fprintf(stderr, "kernel_launch: cooperative launch failed: %s (grid %d)\n", hipGetErrorString(e), grid);
    } else {
        hipLaunchKernelGGL(mk_fwd, dim3(grid), dim3(NTHR), LDS_BYTES, stream, a);
    }
}
static int mk_launch(void* const* d_in, float* out, void* d_ws, size_t ws_size, hipStream_t stream) {
    const int grid = mk_grid(ws_size);
    if (grid < 0) return -1;
    (void)hipMemsetAsync((char*)d_ws + WS_CTL, 0, CTL_ZERO_BYTES, stream);
#if MK_SPLIT
#ifndef EXTRA_PHASE
#define EXTRA_PHASE -1
#endif
    for (int p = 0; p < NPHASE; ++p) { mk_run(d_in, out, d_ws, grid, p, p + 1, stream); if (p == EXTRA_PHASE) mk_run(d_in, out, d_ws, grid, p, p + 1, stream); }
#else
    mk_run(d_in, out, d_ws, grid, 0, NPHASE, stream);
#endif
    return 0;
}
extern "C" void kernel_launch(void* const* d_in, const int* in_sizes, int n_in, void* d_out, int out_size, void* d_ws, size_t ws_size, hipStream_t stream) {
    (void)in_sizes; (void)n_in; (void)out_size;
#if PROBE
    probe::run(d_in, d_out, d_ws, ws_size, stream);
#else
    mk_launch(d_in, (float*)d_out, d_ws, ws_size, stream);
#endif
}
```

```cpp
#define PROBE 0
#define PROBE_STAGE -1
#define MK_SPLIT 0
#define REPEAT_MASK 0
#define EXTRA_PHASE -1
#define MK_COOP 1
#define TIME_PHASE -1
#include <hip/hip_runtime.h>
#include <math.h>
#include <stdint.h>
#include <cstdio>

#define LAS __attribute__((address_space(3)))
#define GAS __attribute__((address_space(1)))
typedef unsigned short bf16_t;
typedef short bf16x8 __attribute__((ext_vector_type(8)));
typedef short s16x4 __attribute__((ext_vector_type(4)));
typedef float f32x4 __attribute__((ext_vector_type(4)));
typedef float f32x2 __attribute__((ext_vector_type(2)));
typedef unsigned u32x4 __attribute__((ext_vector_type(4)));
typedef unsigned u32x2 __attribute__((ext_vector_type(2)));
typedef GAS unsigned gu32;

constexpr int NB = 8, SEQ = 2048, DM = 1024, T = NB * SEQ;
constexpr int NH = 8, HD = 64, AW = 512, GW = 1024, INW = 5632;
constexpr int NE = 256, TOPK = 8, ED = 256, SD = 256;
constexpr float ALPHA = 1.189207115002721f;
constexpr float LN_EPS = 1e-5f;
constexpr int NWAVES = 8, NTHR = 512;
constexpr int BUCKET = 16384;
constexpr int MAXTILES = 768;

constexpr size_t MiB = 1u << 20;
constexpr size_t WS_CTL = 0, CTL_ZERO_BYTES = 128 * 1024;
constexpr size_t WS_MOD = 1 * MiB;
constexpr size_t WS_ROPE = 1 * MiB + 256 * 1024;
constexpr size_t WS_WPA = 2 * MiB, WS_WPB = 3 * MiB, WS_WOUT = 5 * MiB, WS_WRS = 7 * MiB, WS_WSD = 8 * MiB + 512 * 1024;
constexpr size_t WS_WD = 10 * MiB;
constexpr size_t WS_X1 = 138 * MiB;
constexpr size_t WS_HID = 202 * MiB;
constexpr size_t WS_SHID = 298 * MiB;
constexpr size_t WS_YSH = 306 * MiB;
constexpr size_t WS_TOKE = 338 * MiB, WS_TOKR = WS_TOKE + 512 * 1024, WS_TOKW = WS_TOKR + 512 * 1024;
constexpr size_t WS_BTOK = 340 * MiB, WS_BW = 356 * MiB;
constexpr size_t WS_D = 372 * MiB;
constexpr size_t WS_YROW = WS_D;
constexpr size_t WS_WGU = 372 * MiB;
constexpr size_t WS_WIN = 628 * MiB;
constexpr size_t WS_H = 640 * MiB;
constexpr size_t WS_OP = 628 * MiB, WS_LSE = 676 * MiB;
constexpr size_t WS_Q = 678 * MiB, WS_K = 694 * MiB, WS_V = 710 * MiB;
constexpr size_t WS_MERGED = 678 * MiB;
constexpr size_t WS_U = 726 * MiB, WS_VG = 758 * MiB;
constexpr size_t WS_MIX = 726 * MiB;
constexpr size_t WS_LOGITS = 758 * MiB;
constexpr size_t WS_GA = 790 * MiB, WS_GB = 822 * MiB;
constexpr size_t WS_OA = 854 * MiB, WS_SG = 870 * MiB;
constexpr size_t WS_END = 902 * MiB;
constexpr size_t WS_GOLD = 960 * MiB;
constexpr int CW_BAR = 1024;
constexpr int CW_CNT = 8192, CNT_STRIDE = 64;
static_assert((CW_CNT + 256 * CNT_STRIDE) * 4 <= (int)CTL_ZERO_BYTES, "CTL map");

#define RLX_AGENT __ATOMIC_RELAXED, __HIP_MEMORY_SCOPE_AGENT
#define LDS_WAIT() asm volatile("s_waitcnt lgkmcnt(0)" ::: "memory")
#define VM_WAIT() asm volatile("s_waitcnt vmcnt(0)" ::: "memory")
__device__ __forceinline__ unsigned cvt_pk_bf16(float lo, float hi) { unsigned r; asm volatile("v_cvt_pk_bf16_f32 %0, %1, %2" : "=v"(r) : "v"(lo), "v"(hi)); return r; }
__device__ __forceinline__ float bf_lo(unsigned u) { return __uint_as_float(u << 16); }
__device__ __forceinline__ float bf_hi(unsigned u) { return __uint_as_float(u & 0xffff0000u); }
__device__ __forceinline__ float wave_sum(float v) {
#pragma unroll
    for (int o = 1; o < 64; o <<= 1) v += __shfl_xor(v, o);
    return v;
}
__device__ __forceinline__ float fast_sigmoid(float x) { return __builtin_amdgcn_rcpf(1.f + __builtin_amdgcn_exp2f(-1.4426950408889634f * x)); }
__device__ __forceinline__ f32x2 gelu_pk(f32x2 v) {
    const f32x2 av = __builtin_elementwise_abs(v), d = av * 0.2316418882f + 1.0f;
    f32x2 t; t.x = __builtin_amdgcn_rcpf(d.x); t.y = __builtin_amdgcn_rcpf(d.y);
    f32x2 q = t * 0.5307027145f + (-0.7265760135f); q = q * t + 0.7107068705f; q = q * t + (-0.142248368f); q = q * t + 0.127414796f; q = q * t;
    const f32x2 s = (v * v) * (-0.72134752044f);
    f32x2 e; e.x = __builtin_amdgcn_exp2f(s.x); e.y = __builtin_amdgcn_exp2f(s.y);
    const f32x2 m = v * (q * e), r = v - m;
    f32x2 o; o.x = v.x < 0.f ? m.x : r.x; o.y = v.y < 0.f ? m.y : r.y; return o;
}

#define XB_TMO      128
#define XB_XCNT(j)  (256  + 64 * (j))
#define XB_XSUB(j)  (1280 + 64 * (j))
#define XB_XGEN(j)  (2304 + 64 * (j))
#define XB_TOP      3328
#define XB_TOPGEN   3392
#define XCD_BAR_WORDS 3456
#define XB_SPIN_CAP (1u << 18)
__device__ __forceinline__ unsigned xb_ld(unsigned* p)              { return __hip_atomic_load(p, __ATOMIC_RELAXED, __HIP_MEMORY_SCOPE_AGENT); }
__device__ __forceinline__ unsigned xb_add(unsigned* p, unsigned v) { return __hip_atomic_fetch_add(p, v, __ATOMIC_RELAXED, __HIP_MEMORY_SCOPE_AGENT); }
__device__ __forceinline__ unsigned xb_xcc_id() { return (unsigned)__builtin_amdgcn_s_getreg((3 << 11) | 20) & 0xFu; }
#define XB_SPIN(cond, bar) do { unsigned _sp = 0; while (cond) { __builtin_amdgcn_s_sleep(1); \
    if ((++_sp & 255u) == 0u) { if (xb_ld(&(bar)[XB_TMO])) break; if (_sp > XB_SPIN_CAP) { atomicAdd(&(bar)[XB_TMO], 1u); break; } } } } while (0)
struct XcdBarrier { unsigned* bar; unsigned x; volatile LAS unsigned* st; };
__device__ __forceinline__ XcdBarrier xcd_barrier_post(unsigned* bar, volatile LAS unsigned* st) {
    XcdBarrier b; b.bar = bar; b.x = xb_xcc_id(); b.st = st;
    if (threadIdx.x == 0) (void)xb_add(&bar[XB_XCNT(b.x)], 1u);
    return b;
}
__device__ __forceinline__ void xcd_barrier_complete(unsigned* bar, unsigned x, unsigned& nloc, unsigned& nx) {
    const unsigned G = gridDim.x * gridDim.y * gridDim.z;
    unsigned sum, cnt, mine, sp = 0u;
    for (;;) {
        sum = 0u; cnt = 0u; mine = 0u;
#pragma unroll
        for (unsigned j = 0; j < 16; ++j) { const unsigned c = xb_ld(&bar[XB_XCNT(j)]); sum += c; cnt += (c > 0u) ? 1u : 0u; mine = (j == x) ? c : mine; }
        if (sum == G) break;
        __builtin_amdgcn_s_sleep(1);
        if ((++sp & 255u) == 0u) { if (xb_ld(&bar[XB_TMO])) break; if (sp > XB_SPIN_CAP) { atomicAdd(&bar[XB_TMO], 1u); break; } }
    }
    nloc = mine > 0u ? mine : 1u; nx = cnt > 0u ? cnt : 1u;
}
__device__ __forceinline__ void xcd_barrier(const XcdBarrier& b) {
    asm volatile("s_waitcnt vmcnt(0)" ::: "memory");
    __syncthreads();
    if (threadIdx.x == 0) {
        unsigned* bar = b.bar;
        __builtin_amdgcn_s_waitcnt(0);
        unsigned nloc = b.st[0], nx = b.st[1];
        if (nloc == 0u) { xcd_barrier_complete(bar, b.x, nloc, nx); b.st[0] = nloc; b.st[1] = nx; }
        const unsigned old = xb_add(&bar[XB_XSUB(b.x)], 1u);
        const unsigned gen = old / nloc;
        if (old + 1u == (gen + 1u) * nloc) {
            __builtin_amdgcn_fence(__ATOMIC_RELEASE, "agent");
            asm volatile("s_waitcnt vmcnt(0)" ::: "memory");
            const unsigned og = xb_add(&bar[XB_TOP], 1u);
            const unsigned tg = og / nx;
            if (og + 1u == (tg + 1u) * nx) xb_add(&bar[XB_TOPGEN], 1u);
            else XB_SPIN(xb_ld(&bar[XB_TOPGEN]) == tg, bar);
            __builtin_amdgcn_fence(__ATOMIC_ACQUIRE, "agent");
            xb_add(&bar[XB_XGEN(b.x)], 1u);
            asm volatile("s_waitcnt vmcnt(0)" ::: "memory");
        } else {
            XB_SPIN(xb_ld(&bar[XB_XGEN(b.x)]) == gen, bar);
            __builtin_amdgcn_fence(__ATOMIC_ACQUIRE, "agent");
            asm volatile("s_waitcnt vmcnt(0)" ::: "memory");
        }
    }
    __syncthreads();
}

namespace pg8 {
constexpr int BM = 256, BK = 64, HALF = 128, HTB = HALF * BK * 2, STAGE_BYTES = 8 * HTB, NXCD = 8, WGM = 8;
__host__ __device__ __forceinline__ int lds_byte(int r, int c) { const int st = (r >> 4) * 2 + (c >> 5), rr = r & 15, cc = c & 31, ob = rr * 64 + cc * 2; return st * 1024 + (ob ^ (((ob >> 9) & 1) << 5)); }
__host__ __device__ __forceinline__ void stage_rc(int b, int& R, int& C) { const int st = b / 1024, sb = b % 1024, swz = sb ^ (((sb >> 9) & 1) << 5); R = (st >> 1) * 16 + swz / 64; C = (st & 1) * 32 + (swz % 64) / 2; }
__host__ __device__ __forceinline__ int perm32(int rho) { const int n = rho >> 4, i = rho & 15; return 8 * (i >> 2) + 4 * n + (i & 3); }

struct GU { const char* A; const char* B; const int* gidx; int gcnt; int pm, pn, e; };

struct StaticOrder {
    int nM, nN, nwg, G, c; const char* A; const char* B; size_t tstepA, tstepB;
    __device__ void init(const void* A_, const void* B_, int M, int N, unsigned lda, unsigned ldb, int G_, int c_) { nM = M / BM; nN = N / BM; nwg = nM * nN; G = G_; c = c_; A = (const char*)A_; B = (const char*)B_; tstepA = (size_t)BM * lda; tstepB = (size_t)BM * ldb; }
    __device__ bool next(int i, GU& u) const {
        const long L = (long)i * G + c; if (L >= nwg) return false;
        int wgid = (int)L; { const int q = nwg / NXCD, r = nwg % NXCD, xcd = wgid % NXCD, off = wgid / NXCD; wgid = (xcd < r ? xcd * (q + 1) : r * (q + 1) + (xcd - r) * q) + off; }
        const int nig = WGM * nN, gid = wgid / nig, fm = gid * WGM, gsz = (nM - fm) < WGM ? (nM - fm) : WGM;
        u.pm = fm + ((wgid % nig) % gsz); u.pn = (wgid % nig) / gsz; u.e = 0; u.gidx = nullptr; u.gcnt = BM;
        u.A = A + (size_t)u.pm * tstepA; u.B = B + (size_t)u.pn * tstepB; return true;
    }
};

template <class Epi, class Sched, bool GATHER, bool ALIGN_EPI, bool SKIP = false>
__device__ __forceinline__ void gemm_phase(LAS unsigned char* lds, const int K, const unsigned lda, const unsigned ldb, const Sched& S, const Epi& E) {
    const int tid = threadIdx.x, wid = __builtin_amdgcn_readfirstlane(tid >> 6), lane = tid & 63, wr = wid >> 2, wc = wid & 3, fr = lane & 15, fq = lane >> 4;
    const int nt = K / BK;
    int R0, C0, R1, C1; stage_rc(tid * 16, R0, C0); stage_rc(tid * 16 + 8192, R1, C1);
    const int Rb0 = (R0 & ~31) + perm32(R0 & 31), Rb1 = (R1 & ~31) + perm32(R1 & 31);
    const unsigned vB0 = (unsigned)Rb0 * ldb + (unsigned)C0 * 2u, vB1 = (unsigned)Rb1 * ldb + (unsigned)C1 * 2u;
    const size_t kstep = (size_t)(BK * 2);
    const size_t hstepB = (size_t)HALF * ldb;
    const unsigned ldsw = (unsigned)wid * 1024u;
    const int aoff = lds_byte(wr * 64 + fr, fq * 8), boff = lds_byte(wc * 32 + fr, fq * 8);
#define PG8_SA(b, h) (((b) * 2 + (h)) * HTB)
#define PG8_SB(b, h) ((4 + (b) * 2 + (h)) * HTB)
#define PG8_STAGE(bufoff, gbase, v0, v1) do { \
        __builtin_amdgcn_global_load_lds((const unsigned*)((const char*)(gbase) + (v0)), (LAS unsigned*)(lds + (bufoff) + ldsw), 16, 0, 0); \
        __builtin_amdgcn_global_load_lds((const unsigned*)((const char*)(gbase) + (v1)), (LAS unsigned*)(lds + (bufoff) + ldsw + 8192), 16, 0, 0); } while (0)
#define PG8_LDA(dst, b, h) do { _Pragma("unroll") for (int m = 0; m < 4; ++m) _Pragma("unroll") for (int k = 0; k < 2; ++k) dst[m][k] = *(const LAS bf16x8*)(lds + PG8_SA(b, h) + aoff + m * 2048 + k * 1024); } while (0)
#define PG8_LDB(dst, b, h) do { _Pragma("unroll") for (int n = 0; n < 2; ++n) _Pragma("unroll") for (int k = 0; k < 2; ++k) dst[n][k] = *(const LAS bf16x8*)(lds + PG8_SB(b, h) + boff + n * 2048 + k * 1024); } while (0)
#define PG8_MMA(ai, bj, At, Bt) do { if (SKIP && !((ai) ? do1 : do0)) break; __builtin_amdgcn_s_setprio(1); _Pragma("unroll") for (int m = 0; m < 4; ++m) _Pragma("unroll") for (int n = 0; n < 2; ++n) _Pragma("unroll") for (int k = 0; k < 2; ++k) \
        acc[ai][bj][m][n] = __builtin_amdgcn_mfma_f32_16x16x32_bf16(Bt[n][k], At[m][k], acc[ai][bj][m][n], 0, 0, 0); __builtin_amdgcn_s_setprio(0); } while (0)
#define PG8_WAIT_V(n) asm volatile("s_waitcnt vmcnt(" #n ")" ::: "memory")
#define PG8_WAIT_L(n) asm volatile("s_waitcnt lgkmcnt(" #n ")" ::: "memory")
#define PG8_BAR __builtin_amdgcn_s_barrier()
#define PG8_SCHED __builtin_amdgcn_sched_barrier(0)
#define PG8_AOFFS(u, o00, o01, o10, o11) do { \
        if constexpr (GATHER) { \
            const int i00 = R0 < (u).gcnt ? (u).gidx[R0] : 0, i01 = R1 < (u).gcnt ? (u).gidx[R1] : 0; \
            const int i10 = (HALF + R0) < (u).gcnt ? (u).gidx[HALF + R0] : 0, i11 = (HALF + R1) < (u).gcnt ? (u).gidx[HALF + R1] : 0; \
            o00 = (unsigned)i00 * lda + (unsigned)C0 * 2u; o01 = (unsigned)i01 * lda + (unsigned)C1 * 2u; \
            o10 = (unsigned)i10 * lda + (unsigned)C0 * 2u; o11 = (unsigned)i11 * lda + (unsigned)C1 * 2u; \
            asm volatile("s_waitcnt vmcnt(0)" : "+v"(o00), "+v"(o01), "+v"(o10), "+v"(o11) :: "memory"); \
        } else { \
            o00 = (unsigned)R0 * lda + (unsigned)C0 * 2u; o01 = (unsigned)R1 * lda + (unsigned)C1 * 2u; \
            o10 = (unsigned)(HALF + R0) * lda + (unsigned)C0 * 2u; o11 = (unsigned)(HALF + R1) * lda + (unsigned)C1 * 2u; \
        } } while (0)
    GU cur, nxt; int ui = 0;
    if (!S.next(0, cur)) return;
    f32x4 acc[2][2][4][2];
#pragma unroll
    for (int a = 0; a < 2; ++a)
#pragma unroll
        for (int b = 0; b < 2; ++b)
#pragma unroll
            for (int m = 0; m < 4; ++m)
#pragma unroll
                for (int n = 0; n < 2; ++n) acc[a][b][m][n] = (f32x4){0.f, 0.f, 0.f, 0.f};
    bf16x8 At[4][2], B0[2][2], B1[2][2];
    const char* cA = cur.A; const char* cB = cur.B;
    unsigned c00, c01, c10, c11, n00, n01, n10, n11;
    PG8_AOFFS(cur, c00, c01, c10, c11);
    PG8_STAGE(PG8_SB(0, 0), cB, vB0, vB1); PG8_STAGE(PG8_SB(0, 1), cB + hstepB, vB0, vB1); PG8_STAGE(PG8_SA(0, 0), cA, c00, c01); PG8_STAGE(PG8_SA(0, 1), cA, c10, c11);
    if (wr == 1) PG8_BAR;
    PG8_WAIT_V(2); PG8_BAR;
    PG8_STAGE(PG8_SB(1, 0), cB + kstep, vB0, vB1); PG8_STAGE(PG8_SA(1, 0), cA + kstep, c00, c01); PG8_STAGE(PG8_SB(1, 1), cB + hstepB + kstep, vB0, vB1);
    PG8_WAIT_V(6); PG8_BAR;
    for (;;) {
        const bool has_next = S.next(ui + 1, nxt);
        const bool do0 = !SKIP || (wr * 64 < cur.gcnt), do1 = !SKIP || (HALF + wr * 64 < cur.gcnt);
        const char* nA = has_next ? nxt.A : cA; const char* nB = has_next ? nxt.B : cB;
        if (has_next) { PG8_AOFFS(nxt, n00, n01, n10, n11); } else { n00 = c00; n01 = c01; n10 = c10; n11 = c11; }
#pragma nounroll
        for (int t = 0; t < nt; t += 2) {
            const bool last = (t == nt - 2);
            const char* a1 = cA + (size_t)(t + 1) * kstep;
            const char* a2 = last ? nA : cA + (size_t)(t + 2) * kstep; const char* b2 = last ? nB : cB + (size_t)(t + 2) * kstep;
            const char* a3 = a2 + kstep; const char* b3 = b2 + kstep;
            const unsigned x00 = last ? n00 : c00, x01 = last ? n01 : c01, x10 = last ? n10 : c10, x11 = last ? n11 : c11;
            PG8_LDB(B0, 0, 0); PG8_LDB(B1, 0, 1); PG8_SCHED; PG8_LDA(At, 0, 0); PG8_STAGE(PG8_SA(1, 1), a1, c10, c11);
            PG8_WAIT_V(8); PG8_WAIT_L(0); PG8_BAR; PG8_MMA(0, 0, At, B0); PG8_MMA(0, 1, At, B1); PG8_BAR; PG8_SCHED;
            PG8_LDA(At, 0, 1); PG8_STAGE(PG8_SB(0, 0), b2, vB0, vB1); PG8_STAGE(PG8_SB(0, 1), b2 + hstepB, vB0, vB1); PG8_STAGE(PG8_SA(0, 0), a2, x00, x01);
            PG8_WAIT_V(8); PG8_WAIT_L(0); PG8_BAR; PG8_MMA(1, 0, At, B0); PG8_MMA(1, 1, At, B1); PG8_BAR; PG8_SCHED;
            PG8_LDB(B0, 1, 0); PG8_LDB(B1, 1, 1); PG8_SCHED; PG8_LDA(At, 1, 0); PG8_STAGE(PG8_SA(0, 1), a2, x10, x11);
            PG8_WAIT_V(8); PG8_WAIT_L(0); PG8_BAR; PG8_MMA(0, 0, At, B0); PG8_MMA(0, 1, At, B1); PG8_BAR; PG8_SCHED;
            PG8_LDA(At, 1, 1); PG8_STAGE(PG8_SB(1, 0), b3, vB0, vB1); PG8_STAGE(PG8_SB(1, 1), b3 + hstepB, vB0, vB1); PG8_STAGE(PG8_SA(1, 0), a3, x00, x01);
            PG8_WAIT_V(8); PG8_WAIT_L(0); PG8_BAR; PG8_MMA(1, 0, At, B0); PG8_MMA(1, 1, At, B1); PG8_BAR; PG8_SCHED;
        }
        if constexpr (ALIGN_EPI) { if (wr == 0) PG8_BAR; }
        E(acc, cur, wr, wc, fr, fq);
        if (!has_next) break;
#pragma unroll
        for (int a = 0; a < 2; ++a)
#pragma unroll
            for (int b = 0; b < 2; ++b)
#pragma unroll
                for (int m = 0; m < 4; ++m)
#pragma unroll
                    for (int n = 0; n < 2; ++n) acc[a][b][m][n] = (f32x4){0.f, 0.f, 0.f, 0.f};
        cur = nxt; cA = nA; cB = nB; c00 = n00; c01 = n01; c10 = n10; c11 = n11; ++ui;
        if constexpr (ALIGN_EPI) { if (wr == 1) PG8_BAR; }
    }
    PG8_WAIT_V(0);
    if constexpr (!ALIGN_EPI) { if (wr == 0) PG8_BAR; }
    PG8_BAR;
#undef PG8_SA
#undef PG8_SB
#undef PG8_STAGE
#undef PG8_LDA
#undef PG8_LDB
#undef PG8_MMA
#undef PG8_WAIT_V
#undef PG8_WAIT_L
#undef PG8_BAR
#undef PG8_SCHED
#undef PG8_AOFFS
}
}
namespace pg8 {
typedef const f32x4 (&AccRef)[2][2][4][2];
__device__ __forceinline__ u32x4 pack8(f32x4 a, f32x4 b) { u32x4 w; w.x = cvt_pk_bf16(a[0], a[1]); w.y = cvt_pk_bf16(a[2], a[3]); w.z = cvt_pk_bf16(b[0], b[1]); w.w = cvt_pk_bf16(b[2], b[3]); return w; }
__device__ __forceinline__ void unpack8(u32x4 w, f32x4& a, f32x4& b) { a = (f32x4){bf_lo(w.x), bf_hi(w.x), bf_lo(w.y), bf_hi(w.y)}; b = (f32x4){bf_lo(w.z), bf_hi(w.z), bf_lo(w.w), bf_hi(w.w)}; }

struct EpiInProj {
    unsigned char* ws; const float* rcos;
    __device__ __forceinline__ void operator()(AccRef acc, const GU& un, int wr, int wc, int fr, int fq) const {
        const int pn = un.pn; const int row0 = un.pm * BM + wr * 64 + fr;
        if (pn < 4) {
            const float* rsin = rcos + SEQ * 32;
            bf16_t* dst = (bf16_t*)(ws + WS_Q + (size_t)(pn >> 1) * (16 * MiB)); const int dcol = (4 * (pn & 1) + wc) * 64 + 8 * fq;
#pragma unroll
            for (int ai = 0; ai < 2; ++ai)
#pragma unroll
                for (int m = 0; m < 4; ++m) {
                    const int row = row0 + ai * HALF + m * 16; const int pos = row & (SEQ - 1);
                    const f32x4 c0 = *(const f32x4*)(rcos + pos * 32 + 8 * fq), c1 = *(const f32x4*)(rcos + pos * 32 + 8 * fq + 4);
                    const f32x4 s0 = *(const f32x4*)(rsin + pos * 32 + 8 * fq), s1 = *(const f32x4*)(rsin + pos * 32 + 8 * fq + 4);
                    const f32x4 a0 = acc[ai][0][m][0], a1 = acc[ai][0][m][1], b0 = acc[ai][1][m][0], b1 = acc[ai][1][m][1];
                    const f32x4 o0 = a0 * c0 - b0 * s0, o1 = a1 * c1 - b1 * s1, p0 = b0 * c0 + a0 * s0, p1 = b1 * c1 + a1 * s1;
                    bf16_t* rp = dst + (size_t)row * AW + dcol;
                    *(u32x4*)rp = pack8(o0, o1); *(u32x4*)(rp + 32) = pack8(p0, p1);
                }
        } else {
            static_assert(WS_K == WS_Q + 16 * MiB && WS_VG == WS_U + 32 * MiB && WS_GA == WS_U + 64 * MiB && WS_GB == WS_U + 96 * MiB, "in-proj output map");
            const int grp = (pn - 6) >> 2;
            bf16_t* dst = (bf16_t*)(ws + (pn < 6 ? WS_V : WS_U + (size_t)grp * (32 * MiB)));
            const int ldc = pn < 6 ? AW : GW; const int ct = pn < 6 ? pn - 4 : (pn - 6) & 3; const int act = pn < 6 ? 0 : (pn < 14 ? 1 : 2);
            const int col0 = ct * BM + wc * 32 + 8 * fq;
#pragma unroll
            for (int ai = 0; ai < 2; ++ai)
#pragma unroll
                for (int m = 0; m < 4; ++m) {
                    bf16_t* rp = dst + (size_t)(row0 + ai * HALF + m * 16) * ldc + col0;
#pragma unroll
                    for (int bj = 0; bj < 2; ++bj) {
                        f32x4 v0 = acc[ai][bj][m][0], v1 = acc[ai][bj][m][1];
                        if (act == 1) { f32x2 a = gelu_pk((f32x2){v0[0], v0[1]}), b = gelu_pk((f32x2){v0[2], v0[3]}), c = gelu_pk((f32x2){v1[0], v1[1]}), d = gelu_pk((f32x2){v1[2], v1[3]});
                            v0 = (f32x4){a.x, a.y, b.x, b.y}; v1 = (f32x4){c.x, c.y, d.x, d.y}; }
                        else if (act == 2) {
#pragma unroll
                            for (int j = 0; j < 4; ++j) { v0[j] = fast_sigmoid(v0[j]); v1[j] = fast_sigmoid(v1[j]); } }
                        *(u32x4*)(rp + bj * HALF) = pack8(v0, v1);
                    }
                }
        }
    }
};
template <bool ROWSCALE> struct EpiBf16 {
    bf16_t* O; int ldc; const float* roww;
    __device__ __forceinline__ void operator()(AccRef acc, const GU& un, int wr, int wc, int fr, int fq) const {
        const int row0 = un.pm * BM + wr * 64 + fr; const int col0 = un.pn * BM + wc * 32 + 8 * fq;
#pragma unroll
        for (int ai = 0; ai < 2; ++ai)
#pragma unroll
            for (int m = 0; m < 4; ++m) {
                const int row = row0 + ai * HALF + m * 16; bf16_t* rp = O + (size_t)row * ldc + col0;
                float s = 1.f; if constexpr (ROWSCALE) s = roww[row];
#pragma unroll
                for (int bj = 0; bj < 2; ++bj) *(u32x4*)(rp + bj * HALF) = pack8(acc[ai][bj][m][0] * s, acc[ai][bj][m][1] * s);
            }
    }
};
constexpr float YROW_SCALE = 32.f;
struct EpiDown {
    unsigned char* O;
    __device__ __forceinline__ void operator()(AccRef acc, const GU& un, int wr, int wc, int fr, int fq) const {
        const int r0 = wr * 64 + fr; const int col0 = un.pn * BM + wc * 32 + 8 * fq; const float* wts = (const float*)un.gidx;
#pragma unroll
        for (int ai = 0; ai < 2; ++ai)
#pragma unroll
            for (int m = 0; m < 4; ++m) {
                const int r = r0 + ai * HALF + m * 16; unsigned char* rp = O + (size_t)(un.pm * BM + r) * DM + col0;
                if (r < un.gcnt) { const float s = (wts ? wts[r] : 1.f) * YROW_SCALE;
#pragma unroll
                for (int bj = 0; bj < 2; ++bj) { const f32x4 a = acc[ai][bj][m][0] * s, b = acc[ai][bj][m][1] * s;
                    int w0 = __builtin_amdgcn_cvt_pk_fp8_f32(a[0], a[1], 0, false); w0 = __builtin_amdgcn_cvt_pk_fp8_f32(a[2], a[3], w0, true);
                    int w1 = __builtin_amdgcn_cvt_pk_fp8_f32(b[0], b[1], 0, false); w1 = __builtin_amdgcn_cvt_pk_fp8_f32(b[2], b[3], w1, true);
                    *(u32x2*)(rp + bj * HALF) = (u32x2){(unsigned)w0, (unsigned)w1}; } }
            }
    }
};
template <bool ADD> struct EpiGate {
    bf16_t* O; const bf16_t* G;
    __device__ __forceinline__ void operator()(AccRef acc, const GU& un, int wr, int wc, int fr, int fq) const {
        const int row0 = un.pm * BM + wr * 64 + fr; const int col0 = un.pn * BM + wc * 32 + 8 * fq;
#pragma unroll
        for (int ai = 0; ai < 2; ++ai)
#pragma unroll
            for (int m = 0; m < 4; ++m) {
                const size_t off = (size_t)(row0 + ai * HALF + m * 16) * DM + col0;
#pragma unroll
                for (int bj = 0; bj < 2; ++bj) {
                    f32x4 g0, g1; unpack8(*(const u32x4*)(G + off + bj * HALF), g0, g1);
                    f32x4 v0 = acc[ai][bj][m][0] * g0, v1 = acc[ai][bj][m][1] * g1;
                    if constexpr (ADD) { f32x4 p0, p1; unpack8(*(const u32x4*)(O + off + bj * HALF), p0, p1); v0 += p0; v1 += p1; }
                    *(u32x4*)(O + off + bj * HALF) = pack8(v0, v1);
                }
            }
    }
};
struct EpiRouterShared {
    float* logits; bf16_t* shid;
    __device__ __forceinline__ void operator()(AccRef acc, const GU& un, int wr, int wc, int fr, int fq) const {
        const int row0 = un.pm * BM + wr * 64 + fr;
        if (un.pn == 0) {
#pragma unroll
            for (int ai = 0; ai < 2; ++ai)
#pragma unroll
                for (int m = 0; m < 4; ++m) { float* rp = logits + (size_t)(row0 + ai * HALF + m * 16) * NE + wc * 32 + 8 * fq;
#pragma unroll
                    for (int bj = 0; bj < 2; ++bj) { *(f32x4*)(rp + bj * HALF) = acc[ai][bj][m][0]; *(f32x4*)(rp + bj * HALF + 4) = acc[ai][bj][m][1]; } }
        } else {
            const int col0 = (un.pn - 1) * HALF + wc * 32 + 8 * fq;
#pragma unroll
            for (int ai = 0; ai < 2; ++ai)
#pragma unroll
                for (int m = 0; m < 4; ++m) {
                    f32x4 h0, h1;
#pragma unroll
                    for (int j = 0; j < 4; ++j) { const float g0 = acc[ai][0][m][0][j], g1 = acc[ai][0][m][1][j];
                        h0[j] = g0 * fast_sigmoid(g0) * acc[ai][1][m][0][j]; h1[j] = g1 * fast_sigmoid(g1) * acc[ai][1][m][1][j]; }
                    *(u32x4*)(shid + (size_t)(row0 + ai * HALF + m * 16) * SD + col0) = pack8(h0, h1);
                }
        }
    }
};
struct EpiGateUp {
    bf16_t* hid;
    __device__ __forceinline__ void operator()(AccRef acc, const GU& un, int wr, int wc, int fr, int fq) const {
        const int row0 = un.pm * BM + wr * 64 + fr; const int col0 = un.pn * HALF + wc * 32 + 8 * fq;
#pragma unroll
        for (int ai = 0; ai < 2; ++ai)
#pragma unroll
            for (int m = 0; m < 4; ++m) {
                f32x4 h0, h1;
#pragma unroll
                for (int j = 0; j < 4; ++j) { const float g0 = acc[ai][0][m][0][j], g1 = acc[ai][0][m][1][j];
                    h0[j] = g0 * fast_sigmoid(g0) * acc[ai][1][m][0][j]; h1[j] = g1 * fast_sigmoid(g1) * acc[ai][1][m][1][j]; }
                *(u32x4*)(hid + (size_t)(row0 + ai * HALF + m * 16) * ED + col0) = pack8(h0, h1);
            }
    }
};

struct GroupedOrder {
    int G, c, NPN, ntiles; const LAS unsigned short* tile_e; const LAS unsigned short* tstart; const LAS unsigned short* cnt;
    const char* Abase; size_t a_tile_stride;
    const char* Bbase; size_t b_exp_stride, b_tile_stride;
    const int* idxbase;
    bool gather;
    __device__ bool next(int i, GU& u) const {
        const long L = (long)i * G + c; const int tile = (int)(L / NPN);
        if (tile >= ntiles) return false;
        const int pn = (int)(L % NPN); const int e = tile_e[tile]; const int mt = tile - tstart[e];
        u.pm = tile; u.pn = pn; u.e = e; u.gcnt = (int)cnt[e] - mt * BM; u.gidx = idxbase + (size_t)e * BUCKET + mt * BM;
        u.A = gather ? Abase : Abase + (size_t)tile * a_tile_stride;
        u.B = Bbase + (size_t)e * b_exp_stride + (size_t)pn * b_tile_stride;
        return true;
    }
};
}
constexpr int RING_BYTES = 131072;
constexpr int L_TILE_E = RING_BYTES;
constexpr int L_TSTART = L_TILE_E + 1536;
constexpr int L_CNT = L_TSTART + 512;
constexpr int L_HPRE = L_CNT + 512;
constexpr int L_MISC = L_HPRE + 512;
constexpr int LDS_BYTES = 147456;

struct Frame {
    LAS unsigned char* lds; volatile LAS unsigned* MISC; gu32* ctl;
    int tid, lane, wave, vcu, G;
};
struct Args { const float* in[24]; float* out; unsigned char* ws; int ph_lo, ph_hi; };
#define WSP(T_, off) ((T_*)(A.ws + (off)))

__device__ __forceinline__ void cvt_item(const float* W, int ldsrc, int s0, int k0, bf16_t* WT, int Kdst, int dst_row0, LAS float* scr, int lane) {
    float wv[32];
#pragma unroll
    for (int i = 0; i < 32; ++i) { const int kk = 2 * i + (lane >> 5); wv[i] = W[(size_t)(k0 + kk) * ldsrc + s0 + (lane & 31)]; }
#pragma unroll
    for (int i = 0; i < 32; ++i) { const int kk = 2 * i + (lane >> 5); scr[kk * 33 + (lane & 31)] = wv[i]; }
    LDS_WAIT(); asm volatile("" ::: "memory");
    const int c = lane & 7;
#pragma unroll
    for (int j = 0; j < 4; ++j) { const int n = (lane >> 3) + 8 * j; const LAS float* s = scr + (8 * c) * 33 + n;
        u32x4 o; o.x = cvt_pk_bf16(s[0 * 33], s[1 * 33]); o.y = cvt_pk_bf16(s[2 * 33], s[3 * 33]); o.z = cvt_pk_bf16(s[4 * 33], s[5 * 33]); o.w = cvt_pk_bf16(s[6 * 33], s[7 * 33]);
        *(u32x4*)(WT + (size_t)(dst_row0 + n) * Kdst + k0 + 8 * c) = o; }
    LDS_WAIT(); asm volatile("" ::: "memory");
}
__device__ __forceinline__ void cvt_gu_item(const float* Wg, const float* Wu, bf16_t* WT, int item, LAS float* scr, int lane) {
    const int kb = item >> 4, rb = item & 15; const int p = rb >> 3, bj = (rb >> 2) & 1, q = rb & 3;
    cvt_item(bj ? Wu : Wg, 256, 128 * p + 32 * q, 64 * kb, WT, 1024, 32 * rb, scr, lane);
}

struct CvtSrc { const float* W; int ldsrc, s0, k0; bf16_t* WT; int Kdst, dst_row0; };
__device__ __forceinline__ void cvt_load(const CvtSrc& c, int lane, float (&wv)[32]) {
#pragma unroll
    for (int i = 0; i < 32; ++i) { const int kk = 2 * i + (lane >> 5); wv[i] = c.W[(size_t)(c.k0 + kk) * c.ldsrc + c.s0 + (lane & 31)]; }
}
__device__ __forceinline__ void cvt_finish(const CvtSrc& cs, int lane, const float (&wv)[32], LAS float* scr) {
#pragma unroll
    for (int i = 0; i < 32; ++i) { const int kk = 2 * i + (lane >> 5); scr[kk * 33 + (lane & 31)] = wv[i]; }
    LDS_WAIT(); asm volatile("" ::: "memory");
    const int c = lane & 7;
#pragma unroll
    for (int j = 0; j < 4; ++j) { const int n = (lane >> 3) + 8 * j; const LAS float* s = scr + (8 * c) * 33 + n;
        u32x4 o; o.x = cvt_pk_bf16(s[0 * 33], s[1 * 33]); o.y = cvt_pk_bf16(s[2 * 33], s[3 * 33]); o.z = cvt_pk_bf16(s[4 * 33], s[5 * 33]); o.w = cvt_pk_bf16(s[6 * 33], s[7 * 33]);
        *(u32x4*)(cs.WT + (size_t)(cs.dst_row0 + n) * cs.Kdst + cs.k0 + 8 * c) = o; }
    LDS_WAIT(); asm volatile("" ::: "memory");
}
__device__ __forceinline__ CvtSrc expert_item(const Args& A, int it) {
    constexpr int I_GU = 256, I_D = 128, I_E = I_GU + I_D;
    const int e = it / I_E, r = it % I_E; CvtSrc c;
    if (r < I_GU) { const int kb = r >> 4, rb = r & 15; const int p = rb >> 3, bj = (rb >> 2) & 1, q = rb & 3;
        c.W = (bj ? A.in[17] : A.in[16]) + (size_t)e * DM * ED; c.ldsrc = 256; c.s0 = 128 * p + 32 * q; c.k0 = 64 * kb; c.WT = WSP(bf16_t, WS_WGU) + (size_t)e * 512 * DM; c.Kdst = 1024; c.dst_row0 = 32 * rb; }
    else { const int q = r - I_GU; c.W = A.in[18] + (size_t)e * ED * DM; c.ldsrc = DM; c.s0 = 32 * (q & 31); c.k0 = 64 * (q >> 5); c.WT = WSP(bf16_t, WS_WD) + (size_t)e * DM * ED; c.Kdst = ED; c.dst_row0 = 32 * (q & 31); }
    return c;
}
__device__ __forceinline__ void p0_phase(Frame& F, const Args& A) {
    const float* c = A.in[1]; const float* w_ada = A.in[2]; const float* b_ada = A.in[3];
    float* mod = WSP(float, WS_MOD);
    if (blockIdx.x < 192) {
        LAS float* sc = (LAS float*)F.lds;
        LAS float* part = (LAS float*)(F.lds + 32768);
        for (int i = F.tid; i < NB * DM; i += NTHR) { const float v = c[i]; sc[i] = v / (1.f + expf(-v)); }
        __syncthreads();
        const int j0 = blockIdx.x * 32, col = F.lane & 31, kpar = F.lane >> 5;
        float acc[NB];
#pragma unroll
        for (int b = 0; b < NB; ++b) acc[b] = 0.f;
        const float* wp = w_ada + (size_t)(F.wave * 128 + kpar) * (6 * DM) + j0 + col;
#pragma unroll 1
        for (int i0 = 0; i0 < 64; i0 += 16) {
            float w[16];
#pragma unroll
            for (int i = 0; i < 16; ++i) w[i] = wp[(size_t)(2 * (i0 + i)) * (6 * DM)];
#pragma unroll
            for (int i = 0; i < 16; ++i) { const int k = F.wave * 128 + 2 * (i0 + i) + kpar;
#pragma unroll
                for (int b = 0; b < NB; ++b) acc[b] += sc[b * DM + k] * w[i]; }
        }
#pragma unroll
        for (int b = 0; b < NB; ++b) { acc[b] += __shfl_xor(acc[b], 32); if (F.lane < 32) part[(F.wave * NB + b) * 32 + col] = acc[b]; }
        __syncthreads();
        if (F.tid < 256) { const int b = F.tid >> 5, cc = F.tid & 31; float s = b_ada[j0 + cc];
#pragma unroll
            for (int w = 0; w < 8; ++w) s += part[(w * NB + b) * 32 + cc];
            mod[b * 6 * DM + j0 + cc] = s; }
        __syncthreads();
    }
    { const int gt = blockIdx.x * NTHR + F.tid;
      if (gt < SEQ * 32) { const int pos = gt >> 5, f = gt & 31; const float inv = powf(10000.f, -(float)f / 32.f); float sn, cs; sincosf((float)pos * inv, &sn, &cs);
          WSP(float, WS_ROPE)[gt] = cs; WSP(float, WS_ROPE)[SEQ * 32 + gt] = sn; } }
    LAS float* scr = (LAS float*)(F.lds + F.wave * 16384);
    const int gw = F.vcu * NWAVES + F.wave, NGW = F.G * NWAVES;
    constexpr int I_IN = 16 * 176, I_PA = 8 * 32, I_PB = 16 * 32, I_OUT = 16 * 32, I_RS = 16 * 24, I_SD = 4 * 32;
    constexpr int NIT = I_IN + I_PA + I_PB + I_OUT + I_RS + I_SD;
    for (int it = gw; it < NIT; it += NGW) {
        int r = it;
        if (r < I_IN) { const int kb = r / 176, rb = r % 176; const int pn = rb >> 3, blk = rb & 7; int s0;
            if (pn < 4) { const int base = (pn < 2) ? 0 : AW; s0 = base + (4 * (pn & 1) + (blk & 3)) * 64 + 32 * (blk >> 2); } else s0 = 32 * rb;
            cvt_item(A.in[4], INW, s0, 64 * kb, WSP(bf16_t, WS_WIN), DM, 32 * rb, scr, F.lane); continue; } r -= I_IN;
        if (r < I_PA) { cvt_item(A.in[9], DM, 32 * (r & 31), 64 * (r >> 5), WSP(bf16_t, WS_WPA), AW, 32 * (r & 31), scr, F.lane); continue; } r -= I_PA;
        if (r < I_PB) { cvt_item(A.in[10], DM, 32 * (r & 31), 64 * (r >> 5), WSP(bf16_t, WS_WPB), GW, 32 * (r & 31), scr, F.lane); continue; } r -= I_PB;
        if (r < I_OUT) { cvt_item(A.in[11], DM, 32 * (r & 31), 64 * (r >> 5), WSP(bf16_t, WS_WOUT), DM, 32 * (r & 31), scr, F.lane); continue; } r -= I_OUT;
        if (r < I_RS) { const int kb = r / 24, rb = r % 24;
            if (rb < 8) cvt_item(A.in[14], NE, 32 * rb, 64 * kb, WSP(bf16_t, WS_WRS), DM, 32 * rb, scr, F.lane);
            else cvt_gu_item(A.in[19], A.in[20], WSP(bf16_t, WS_WRS) + (size_t)256 * DM, kb * 16 + (rb - 8), scr, F.lane);
            continue; } r -= I_RS;
        cvt_item(A.in[21], DM, 32 * (r & 31), 64 * (r >> 5), WSP(bf16_t, WS_WSD), SD, 32 * (r & 31), scr, F.lane);
    }
}
__device__ __forceinline__ void p1_phase(Frame& F, const Args& A) {
    const int gw = F.vcu * NWAVES + F.wave, NGW = F.G * NWAVES;
    const float* x = A.in[0]; const float* mod = WSP(float, WS_MOD); bf16_t* h = WSP(bf16_t, WS_H);
    for (int m = gw; m < T; m += NGW) {
        const float* md = mod + (m / SEQ) * 6 * DM; const f32x4* xr = (const f32x4*)(x + (size_t)m * DM) + F.lane; u32x2* o8 = (u32x2*)(h + (size_t)m * DM) + F.lane;
#pragma unroll
        for (int j = 0; j < 4; ++j) { const f32x4 v = xr[64 * j]; const f32x4 sh = *((const f32x4*)md + F.lane + 64 * j), sc = *((const f32x4*)(md + DM) + F.lane + 64 * j);
            const f32x4 r = v * (sc + 1.f) + sh; u32x2 w; w.x = cvt_pk_bf16(r[0], r[1]); w.y = cvt_pk_bf16(r[2], r[3]); o8[64 * j] = w; }
    }
    LAS float* scr = (LAS float*)(F.lds + F.wave * 16384);
    constexpr int I_GU = 256, I_D = 128, I_E = I_GU + I_D;
    for (int it = gw; it < NE * I_E; it += NGW) {
        const int e = it / I_E, r = it % I_E;
        if (r < I_GU) cvt_gu_item(A.in[16] + (size_t)e * DM * ED, A.in[17] + (size_t)e * DM * ED, WSP(bf16_t, WS_WGU) + (size_t)e * 512 * DM, r, scr, F.lane);
        else { const int q = r - I_GU; cvt_item(A.in[18] + (size_t)e * ED * DM, DM, 32 * (q & 31), 64 * (q >> 5), WSP(bf16_t, WS_WD) + (size_t)e * DM * ED, ED, 32 * (q & 31), scr, F.lane); }
    }
}

__device__ __forceinline__ s16x4 tr_read(const LAS unsigned char* p) { return __builtin_bit_cast(s16x4, __builtin_amdgcn_ds_read_tr16_b64_v4i16((LAS s16x4*)p)); }
struct AttnPre { u32x4 k[4], v[4], q[2]; };
__device__ __forceinline__ void attn_decode(int u, int& p, int& b, int& h, int& d, int& r, int& n) {
    p = u >> 10; const int bh = (u & 1023) >> 4, cls = u & 15; b = bh >> 3; h = bh & 7;
    if (p == 0) { d = 1; r = 0; n = cls; } else if (p == 1) { d = 4; r = cls & 3; n = cls >> 2; } else { d = 16; r = cls; n = 0; }
}
__device__ __forceinline__ void attn_load(Frame& F, const Args& A, int u, AttnPre& P) {
    int p, b, h, d, r, n; attn_decode(u, p, b, h, d, r, n);
    const bf16_t* Q = WSP(bf16_t, WS_Q); const bf16_t* K = WSP(bf16_t, WS_K); const bf16_t* V = WSP(bf16_t, WS_V);
    const size_t tb = (size_t)b * SEQ;
#pragma unroll
    for (int i = 0; i < 4; ++i) { const int idx = F.tid + NTHR * i, row = idx >> 3, c = idx & 7; const int ci = (n - 1) * 128 + row;
        P.k[i] = (u32x4){0u, 0u, 0u, 0u}; P.v[i] = P.k[i];
        if (ci >= 0) { const size_t off = (tb + (size_t)ci * d + r) * AW + h * HD + c * 8; P.k[i] = *(const u32x4*)(K + off); P.v[i] = *(const u32x4*)(V + off); } }
#pragma unroll
    for (int i = 0; i < 2; ++i) { const int idx = F.tid + NTHR * i, row = idx >> 3, c = idx & 7;
        const size_t off = (tb + (size_t)(n * 128 + row) * d + r) * AW + h * HD + c * 8; P.q[i] = *(const u32x4*)(Q + off); }
}
__device__ __forceinline__ void attn_store_lds(Frame& F, const AttnPre& P) {
    LAS unsigned char* Qs = F.lds; LAS unsigned char* Ks = F.lds + 16384; LAS unsigned char* Vs = F.lds + 49152;
#pragma unroll
    for (int i = 0; i < 4; ++i) { const int idx = F.tid + NTHR * i, row = idx >> 3, c = idx & 7; const int lo = row * 128 + ((c ^ (row & 7)) << 4);
        *(LAS u32x4*)(Ks + lo) = P.k[i]; *(LAS u32x4*)(Vs + lo) = P.v[i]; }
#pragma unroll
    for (int i = 0; i < 2; ++i) { const int idx = F.tid + NTHR * i, row = idx >> 3, c = idx & 7; *(LAS u32x4*)(Qs + row * 128 + ((c ^ (row & 7)) << 4)) = P.q[i]; }
}
__device__ __forceinline__ void attn_compute(Frame& F, const Args& A, int u) {
    LAS unsigned char* Qs = F.lds; LAS unsigned char* Ks = F.lds + 16384; LAS unsigned char* Vs = F.lds + 49152;
    int p, b, h, d, r, n; attn_decode(u, p, b, h, d, r, n);
    const int lane = F.lane, w = F.wave, g = lane >> 4, li = lane & 15;
    const size_t tb = (size_t)b * SEQ;
    bf16x8 qf[2];
    { const int row = 16 * w + li;
#pragma unroll
      for (int ks = 0; ks < 2; ++ks) qf[ks] = *(const LAS bf16x8*)(Qs + row * 128 + (((4 * ks + g) ^ (row & 7)) << 4)); }
    f32x4 s[9];
#pragma unroll
    for (int kt = 0; kt < 9; ++kt) { const int krow = 16 * (w + kt) + li; f32x4 a = (f32x4){0.f, 0.f, 0.f, 0.f};
#pragma unroll
        for (int ks = 0; ks < 2; ++ks) { const bf16x8 kf = *(const LAS bf16x8*)(Ks + krow * 128 + (((4 * ks + g) ^ (krow & 7)) << 4)); a = __builtin_amdgcn_mfma_f32_16x16x32_bf16(kf, qf[ks], a, 0, 0, 0); }
        s[kt] = a; }
    float mx = -INFINITY;
#pragma unroll
    for (int kt = 0; kt < 9; ++kt)
#pragma unroll
        for (int rr = 0; rr < 4; ++rr) { const int kk = 16 * kt + 4 * g + rr; const int kj = 16 * w + kk;
            const bool ok = (kk >= li) && (kk <= li + 128) && (n > 0 || kj >= 128);
            const float v = ok ? s[kt][rr] : -INFINITY; s[kt][rr] = v; mx = fmaxf(mx, v); }
    mx = fmaxf(mx, __shfl_xor(mx, 16)); mx = fmaxf(mx, __shfl_xor(mx, 32));
    const float C = 0.125f * 1.4426950408889634f; float ls = 0.f;
#pragma unroll
    for (int kt = 0; kt < 9; ++kt)
#pragma unroll
        for (int rr = 0; rr < 4; ++rr) { const float e = __builtin_amdgcn_exp2f((s[kt][rr] - mx) * C); s[kt][rr] = e; ls += e; }
    ls += __shfl_xor(ls, 16); ls += __shfl_xor(ls, 32);
    f32x4 o[4];
#pragma unroll
    for (int nt = 0; nt < 4; ++nt) o[nt] = (f32x4){0.f, 0.f, 0.f, 0.f};
    const int q4 = li >> 2, p4 = li & 3;
#pragma unroll
    for (int k2 = 0; k2 < 5; ++k2) {
        const int t0 = 2 * k2, t1 = 2 * k2 + 1;
        u32x4 pw; pw.x = cvt_pk_bf16(s[t0][0], s[t0][1]); pw.y = cvt_pk_bf16(s[t0][2], s[t0][3]);
        if (t1 < 9) { pw.z = cvt_pk_bf16(s[t1 < 9 ? t1 : 8][0], s[t1 < 9 ? t1 : 8][1]); pw.w = cvt_pk_bf16(s[t1 < 9 ? t1 : 8][2], s[t1 < 9 ? t1 : 8][3]); } else { pw.z = 0u; pw.w = 0u; }
        const bf16x8 pa = __builtin_bit_cast(bf16x8, pw);
        int KT1 = w + t1; if (KT1 > 15) KT1 = 15;
        const int r0 = 16 * (w + t0) + 4 * g + q4, r1 = 16 * KT1 + 4 * g + q4;
#pragma unroll
        for (int nt = 0; nt < 4; ++nt) { const int ch = 2 * nt + (p4 >> 1);
            const s16x4 lo = tr_read(Vs + r0 * 128 + ((ch ^ (r0 & 7)) << 4) + (p4 & 1) * 8), hi = tr_read(Vs + r1 * 128 + ((ch ^ (r1 & 7)) << 4) + (p4 & 1) * 8);
            const bf16x8 vb = (bf16x8){lo[0], lo[1], lo[2], lo[3], hi[0], hi[1], hi[2], hi[3]};
            o[nt] = __builtin_amdgcn_mfma_f32_16x16x32_bf16(pa, vb, o[nt], 0, 0, 0); }
    }
    const float linv = 1.f / ls;
    LAS bf16_t* st = (LAS bf16_t*)(Qs + 16 * w * 128);
#pragma unroll
    for (int rr = 0; rr < 4; ++rr) { const float sc = __shfl(linv, 4 * g + rr);
#pragma unroll
        for (int nt = 0; nt < 4; ++nt) st[(4 * g + rr) * 64 + 16 * nt + li] = (bf16_t)(cvt_pk_bf16(o[nt][rr] * sc, 0.f) & 0xffffu); }
    LDS_WAIT(); asm volatile("" ::: "memory");
    bf16_t* OP = WSP(bf16_t, WS_OP) + (size_t)p * T * AW; float* LSE = WSP(float, WS_LSE) + (size_t)p * T * NH;
#pragma unroll
    for (int i = 0; i < 2; ++i) { const int cidx = lane + 64 * i, row = cidx >> 3, c = cidx & 7;
        const size_t tok = tb + (size_t)(n * 128 + 16 * w + row) * d + r;
        *(u32x4*)(OP + tok * AW + h * HD + c * 8) = *(const LAS u32x4*)((const LAS unsigned char*)st + row * 128 + c * 16); }
    if (lane < 16) { const size_t tok = tb + (size_t)(n * 128 + 16 * w + li) * d + r; LSE[tok * NH + h] = mx * 0.125f + logf(ls); }
}
__device__ __forceinline__ void attn_phase(Frame& F, const Args& A) {
    int u = F.vcu; AttnPre P;
    if (u < 3072) attn_load(F, A, u, P);
    while (u < 3072) {
        attn_store_lds(F, P);
        __syncthreads();
        const int un = u + F.G;
        if (un < 3072) attn_load(F, A, un, P);
        attn_compute(F, A, u);
        __syncthreads();
        u = un;
    }
}
__device__ __forceinline__ void sgu_unit(Frame& F, const Args& A, int bc, int g, bool do_stats) {
    LAS unsigned char* Ws = F.lds; LAS unsigned char* Vn = F.lds + 32768; LAS f32x2* stats = (LAS f32x2*)(F.lds + 65536);
    const size_t t0 = (size_t)bc * 128;
    const bf16_t* VG = WSP(bf16_t, WS_VG); const bf16_t* U = WSP(bf16_t, WS_U); bf16_t* SG = WSP(bf16_t, WS_SG);
    const float* lng = A.in[5]; const float* lnb = A.in[6]; const float* wsp = A.in[7] + (size_t)g * 128 * 128; const float* bsp = A.in[8] + g * 128;
    const int tid = F.tid, lane = F.lane, w = F.wave, g4 = lane >> 4, li = lane & 15;
    if (do_stats) { const int row = tid >> 2, qd = tid & 3; const u32x4* pr = (const u32x4*)(VG + (t0 + row) * GW + qd * 256); float s1 = 0.f, s2 = 0.f;
#pragma unroll 8
      for (int i = 0; i < 32; ++i) { const u32x4 v = pr[i];
#pragma unroll
          for (int j = 0; j < 4; ++j) { const float a = bf_lo(v[j]), c = bf_hi(v[j]); s1 += a + c; s2 += a * a + c * c; } }
      s1 += __shfl_xor(s1, 1); s2 += __shfl_xor(s2, 1); s1 += __shfl_xor(s1, 2); s2 += __shfl_xor(s2, 2);
      const float mean = s1 * (1.f / 1024.f); const float var = fmaxf(s2 * (1.f / 1024.f) - mean * mean, 0.f);
      if (qd == 0) stats[row] = (f32x2){mean, 1.f / sqrtf(var + LN_EPS)}; }
#pragma unroll
    for (int i = 0; i < 8; ++i) { const int idx = tid + NTHR * i, trow = idx >> 5, c4 = idx & 31; f32x4 v = *(const f32x4*)(wsp + trow * 128 + c4 * 4);
#pragma unroll
        for (int j = 0; j < 4; ++j) if (4 * c4 + j > trow) v[j] = 0.f;
        u32x2 o; o.x = cvt_pk_bf16(v[0], v[1]); o.y = cvt_pk_bf16(v[2], v[3]);
        *(LAS u32x2*)(Ws + trow * 256 + (((c4 >> 1) ^ (trow & 15)) << 4) + (c4 & 1) * 8) = o; }
    __syncthreads();
#pragma unroll
    for (int i = 0; i < 4; ++i) { const int idx = tid + NTHR * i, srow = idx >> 4, c16 = idx & 15; const int ch0 = g * 128 + c16 * 8;
        const u32x4 v = *(const u32x4*)(VG + (t0 + srow) * GW + ch0); const f32x2 st = stats[srow];
        const f32x4 ga = *(const f32x4*)(lng + ch0), gb = *(const f32x4*)(lng + ch0 + 4), ba = *(const f32x4*)(lnb + ch0), bb = *(const f32x4*)(lnb + ch0 + 4);
        f32x4 x0, x1; pg8::unpack8(v, x0, x1);
        x0 = (x0 - st.x) * st.y * ga + ba; x1 = (x1 - st.x) * st.y * gb + bb;
        *(LAS u32x4*)(Vn + srow * 256 + ((c16 ^ (srow & 15)) << 4)) = pg8::pack8(x0, x1); }
    __syncthreads();
    f32x4 acc[8];
#pragma unroll
    for (int nt = 0; nt < 8; ++nt) acc[nt] = (f32x4){0.f, 0.f, 0.f, 0.f};
    const int nks = (w >> 1) + 1; const int arow = 16 * w + li; const int q4 = li >> 2, p4 = li & 3;
    for (int ks = 0; ks < nks; ++ks) {
        const bf16x8 af = *(const LAS bf16x8*)(Ws + arow * 256 + (((4 * ks + g4) ^ (arow & 15)) << 4));
        const int r0 = 32 * ks + 8 * g4 + q4, r1 = r0 + 4;
#pragma unroll
        for (int nt = 0; nt < 8; ++nt) { const int ch = 2 * nt + (p4 >> 1);
            const s16x4 lo = tr_read(Vn + r0 * 256 + ((ch ^ (r0 & 15)) << 4) + (p4 & 1) * 8), hi = tr_read(Vn + r1 * 256 + ((ch ^ (r1 & 15)) << 4) + (p4 & 1) * 8);
            const bf16x8 vb = (bf16x8){lo[0], lo[1], lo[2], lo[3], hi[0], hi[1], hi[2], hi[3]};
            acc[nt] = __builtin_amdgcn_mfma_f32_16x16x32_bf16(af, vb, acc[nt], 0, 0, 0); }
    }
    LAS bf16_t* st = (LAS bf16_t*)(Ws + 16 * w * 256);
#pragma unroll
    for (int rr = 0; rr < 4; ++rr) { const float bias = bsp[16 * w + 4 * g4 + rr];
#pragma unroll
        for (int nt = 0; nt < 8; ++nt) st[(4 * g4 + rr) * 128 + 16 * nt + li] = (bf16_t)(cvt_pk_bf16(acc[nt][rr] + bias, 0.f) & 0xffffu); }
    LDS_WAIT(); asm volatile("" ::: "memory");
#pragma unroll
    for (int i = 0; i < 4; ++i) { const int cidx = lane + 64 * i, row = cidx >> 4, c16 = cidx & 15; const size_t off = (t0 + 16 * w + row) * GW + g * 128 + c16 * 8;
        f32x4 a0, a1, u0, u1; pg8::unpack8(*(const LAS u32x4*)((const LAS unsigned char*)st + row * 256 + c16 * 16), a0, a1); pg8::unpack8(*(const u32x4*)(U + off), u0, u1);
        *(u32x4*)(SG + off) = pg8::pack8(a0 * u0, a1 * u1); }
    __syncthreads();
}
__device__ __forceinline__ void sgu_phase(Frame& F, const Args& A) {
    for (int uu = F.vcu; uu < 256; uu += F.G) {
        const int bc = uu >> 1, g0 = 4 * (uu & 1);
        for (int gi = 0; gi < 4; ++gi) sgu_unit(F, A, bc, g0 + gi, gi == 0);
    }
}
__device__ __forceinline__ void p4_phase(Frame& F, const Args& A) {
    const bf16_t* OP = WSP(bf16_t, WS_OP); const float* LSE = WSP(float, WS_LSE); bf16_t* OA = WSP(bf16_t, WS_OA);
    for (int idx = F.vcu * NTHR + F.tid; idx < T * 64; idx += F.G * NTHR) {
        const int t = idx >> 6, h = (idx >> 3) & 7, c = idx & 7;
        const float l0 = LSE[(size_t)t * NH + h], l1 = LSE[(size_t)(T + t) * NH + h], l2 = LSE[(size_t)(2 * T + t) * NH + h];
        const float m = fmaxf(l0, fmaxf(l1, l2)); float w0 = expf(l0 - m), w1 = expf(l1 - m), w2 = expf(l2 - m); const float inv = 1.f / (w0 + w1 + w2); w0 *= inv; w1 *= inv; w2 *= inv;
        const size_t off = (size_t)t * AW + h * HD + c * 8;
        f32x4 a0, a1, b0, b1, c0, c1; pg8::unpack8(*(const u32x4*)(OP + off), a0, a1); pg8::unpack8(*(const u32x4*)(OP + (size_t)T * AW + off), b0, b1); pg8::unpack8(*(const u32x4*)(OP + (size_t)2 * T * AW + off), c0, c1);
        *(u32x4*)(OA + off) = pg8::pack8(a0 * w0 + b0 * w1 + c0 * w2, a1 * w0 + b1 * w1 + c1 * w2);
    }
}
__device__ __forceinline__ void p7_phase(Frame& F, const Args& A) {
    const int gw = F.vcu * NWAVES + F.wave, NGW = F.G * NWAVES;
    const float* x = A.in[0]; const float* mod = WSP(float, WS_MOD); const bf16_t* mix = WSP(bf16_t, WS_MIX); float* x1 = WSP(float, WS_X1); bf16_t* h2 = WSP(bf16_t, WS_H);
    const float* g1 = A.in[12]; const float* b1 = A.in[13];
    for (int m = gw; m < T; m += NGW) {
        const float* md = mod + (m / SEQ) * 6 * DM; const f32x4* xr = (const f32x4*)(x + (size_t)m * DM) + F.lane; const u32x2* mr = (const u32x2*)(mix + (size_t)m * DM) + F.lane;
        f32x4 v[4]; float s = 0.f;
#pragma unroll
        for (int j = 0; j < 4; ++j) { const f32x4 xv = xr[64 * j]; const u32x2 mw = mr[64 * j]; const f32x4 gv = *((const f32x4*)(md + 2 * DM) + F.lane + 64 * j);
            const f32x4 mv = (f32x4){bf_lo(mw.x), bf_hi(mw.x), bf_lo(mw.y), bf_hi(mw.y)};
            v[j] = xv * ALPHA + gv * mv; s += (v[j][0] + v[j][1]) + (v[j][2] + v[j][3]); }
        const float mean = wave_sum(s) * (1.f / DM); float s2 = 0.f;
#pragma unroll
        for (int j = 0; j < 4; ++j) { v[j] = v[j] - mean; s2 += (v[j][0] * v[j][0] + v[j][1] * v[j][1]) + (v[j][2] * v[j][2] + v[j][3] * v[j][3]); }
        const float rstd = 1.f / sqrtf(wave_sum(s2) * (1.f / DM) + LN_EPS);
        f32x4* xo = (f32x4*)(x1 + (size_t)m * DM) + F.lane; u32x2* ho = (u32x2*)(h2 + (size_t)m * DM) + F.lane;
#pragma unroll
        for (int j = 0; j < 4; ++j) { const f32x4 gg = *((const f32x4*)g1 + F.lane + 64 * j), bb = *((const f32x4*)b1 + F.lane + 64 * j);
            const f32x4 o = v[j] * rstd * gg + bb; xo[64 * j] = o;
            const f32x4 sh = *((const f32x4*)(md + 3 * DM) + F.lane + 64 * j), sc = *((const f32x4*)(md + 4 * DM) + F.lane + 64 * j);
            const f32x4 r = o * (sc + 1.f) + sh; u32x2 wv; wv.x = cvt_pk_bf16(r[0], r[1]); wv.y = cvt_pk_bf16(r[2], r[3]); ho[64 * j] = wv; }
    }
}
template <int CTRL> __device__ __forceinline__ unsigned dpp_u32(unsigned v) { return (unsigned)__builtin_amdgcn_update_dpp((int)v, (int)v, CTRL, 0xF, 0xF, false); }
__device__ __forceinline__ unsigned wave_max_u32(unsigned v) {
    unsigned t;
    t = dpp_u32<0xB1>(v); v = t > v ? t : v;
    t = dpp_u32<0x4E>(v); v = t > v ? t : v;
    t = dpp_u32<0x141>(v); v = t > v ? t : v;
    t = dpp_u32<0x140>(v); v = t > v ? t : v;
    const unsigned a = (unsigned)__builtin_amdgcn_readlane((int)v, 0), b = (unsigned)__builtin_amdgcn_readlane((int)v, 16), c = (unsigned)__builtin_amdgcn_readlane((int)v, 32), d = (unsigned)__builtin_amdgcn_readlane((int)v, 48);
    const unsigned ab = a > b ? a : b, cd = c > d ? c : d; return ab > cd ? ab : cd;
}
__device__ __forceinline__ void route_token(const float* logits, const f32x4 rb, int t, int lane, int& my_e, float& my_w) {
    const f32x4 lg = *((const f32x4*)(logits + (size_t)t * NE) + lane);
    f32x4 sc, bi;
#pragma unroll
    for (int i = 0; i < 4; ++i) { sc[i] = 1.f / (1.f + expf(-lg[i])); bi[i] = sc[i] + rb[i]; }
    float m1 = fmaxf(bi[0], bi[1]), m2 = fminf(bi[0], bi[1]);
#pragma unroll
    for (int i = 2; i < 4; ++i) { const float v = bi[i]; m2 = fmaxf(m2, fminf(m1, v)); m1 = fmaxf(m1, v); }
#pragma unroll
    for (int o = 1; o < 8; o <<= 1) { const float o1 = __shfl_xor(m1, o), o2 = __shfl_xor(m2, o); const float n1 = fmaxf(m1, o1), n2 = fmaxf(fminf(m1, o1), fmaxf(m2, o2)); m1 = n1; m2 = n2; }
    const float gs = m1 + m2; const int grp = lane >> 3; int rank = 0;
#pragma unroll
    for (int gg = 0; gg < 8; ++gg) { const float v = __builtin_bit_cast(float, __builtin_amdgcn_readlane(__builtin_bit_cast(int, gs), 8 * gg)); rank += (v > gs || (v == gs && gg < grp)) ? 1 : 0; }
    const bool sel = rank < 4;
    unsigned key[4];
#pragma unroll
    for (int i = 0; i < 4; ++i) { float f = (bi[i] + 0.0625f) * 8388608.f; f = fminf(fmaxf(f, 1.f), 16777215.f); key[i] = sel ? (((unsigned)f << 8) | (unsigned)(255 - (4 * lane + i))) : 0u; }
    my_e = 0; float my_s = 0.f, wsum = 0.f;
#pragma unroll
    for (int r = 0; r < TOPK; ++r) {
        unsigned k = key[0] > key[1] ? key[0] : key[1]; { const unsigned k2 = key[2] > key[3] ? key[2] : key[3]; k = k > k2 ? k : k2; }
        k = wave_max_u32(k);
        const int e = 255 - (int)(k & 0xffu); const int sub = e & 3;
        const float sv = (sub == 0) ? sc[0] : (sub == 1) ? sc[1] : (sub == 2) ? sc[2] : sc[3];
        const float ssel = __builtin_bit_cast(float, __builtin_amdgcn_readlane(__builtin_bit_cast(int, sv), e >> 2));
#pragma unroll
        for (int i = 0; i < 4; ++i) if (key[i] == k) key[i] = 0u;
        wsum += ssel; if (lane == r) { my_e = e; my_s = ssel; }
    }
    my_w = 2.5f * my_s / wsum;
}
__device__ __forceinline__ void p9_phase(Frame& F, const Args& A) {
    const int gw = F.vcu * NWAVES + F.wave, NGW = F.G * NWAVES, lane = F.lane;
    const float* logits = WSP(float, WS_LOGITS); const float* rbias = A.in[15];
    unsigned* cnt = (unsigned*)(F.ctl + CW_CNT); int* tok_e = WSP(int, WS_TOKE); int* tok_r = WSP(int, WS_TOKR); int* btok = WSP(int, WS_BTOK); float* bw = WSP(float, WS_BW);
    const f32x4 rb = *((const f32x4*)rbias + lane);
    for (int base = gw; base < T; base += 8 * NGW) {
        int es[8]; float ws[8]; unsigned rk[8];
#pragma unroll
        for (int i = 0; i < 8; ++i) { const int t = base + i * NGW; es[i] = 0; ws[i] = 0.f; if (t < T) route_token(logits, rb, t, lane, es[i], ws[i]); }
#pragma unroll
        for (int i = 0; i < 8; ++i) { const int t = base + i * NGW; rk[i] = 0u; if (t < T && lane < TOPK) rk[i] = atomicAdd(&cnt[es[i] * CNT_STRIDE], 1u); }
#pragma unroll
        for (int i = 0; i < 8; ++i) { const int t = base + i * NGW;
            if (t < T && lane < TOPK) { tok_e[t * TOPK + lane] = es[i]; tok_r[t * TOPK + lane] = (int)rk[i];
                if (rk[i] < (unsigned)BUCKET) { btok[(size_t)es[i] * BUCKET + rk[i]] = t; bw[(size_t)es[i] * BUCKET + rk[i]] = ws[i]; } } }
    }
}
__device__ __forceinline__ void build_tile_table(Frame& F, const Args& A) {
    LAS unsigned short* tile_e = (LAS unsigned short*)(F.lds + L_TILE_E); LAS unsigned short* tstart = (LAS unsigned short*)(F.lds + L_TSTART);
    const unsigned* cnt = (const unsigned*)(F.ctl + CW_CNT);
    __syncthreads();
    int val = 0, incl = 0;
    if (F.tid < NE) { unsigned c = __hip_atomic_load(cnt + F.tid * CNT_STRIDE, RLX_AGENT); if (c > (unsigned)BUCKET) c = BUCKET; ((LAS unsigned short*)(F.lds + L_CNT))[F.tid] = (unsigned short)c; val = (int)((c + 255u) >> 8); incl = val;
#pragma unroll
        for (int o = 1; o < 64; o <<= 1) { const int v = __shfl_up(incl, o); if (F.lane >= o) incl += v; }
        if (F.lane == 63) F.MISC[F.wave] = (unsigned)incl; }
    __syncthreads();
    if (F.tid < NE) { int off = 0;
#pragma unroll
        for (int w = 0; w < 4; ++w) if (w < F.wave) off += (int)F.MISC[w];
        const int st = off + incl - val; tstart[F.tid] = (unsigned short)st;
        for (int k = 0; k < val; ++k) tile_e[st + k] = (unsigned short)F.tid;
        if (F.tid == NE - 1) F.MISC[4] = (unsigned)(off + incl); }
    __syncthreads();
    int hv = 0, hincl = 0;
    if (F.tid < NE) { hv = (int)((((LAS unsigned short*)(F.lds + L_CNT))[F.tid] + 127u) >> 7); hincl = hv;
#pragma unroll
        for (int o = 1; o < 64; o <<= 1) { const int v = __shfl_up(hincl, o); if (F.lane >= o) hincl += v; }
        if (F.lane == 63) F.MISC[F.wave] = (unsigned)hincl; }
    __syncthreads();
    if (F.tid < NE) { int off = 0;
#pragma unroll
        for (int w = 0; w < 4; ++w) if (w < F.wave) off += (int)F.MISC[w];
        ((LAS unsigned short*)(F.lds + L_HPRE))[F.tid] = (unsigned short)(off + hincl - hv);
        if (F.tid == NE - 1) F.MISC[5] = (unsigned)(off + hincl); }
    __syncthreads();
}
__device__ __forceinline__ void p12_phase(Frame& F, const Args& A) {
    const int gw = F.vcu * NWAVES + F.wave, NGW = F.G * NWAVES;
    const LAS unsigned short* tstart = (const LAS unsigned short*)(F.lds + L_TSTART);
    const float* mod = WSP(float, WS_MOD); const float* x1 = WSP(float, WS_X1); const unsigned char* ysh = WSP(unsigned char, WS_YSH); const unsigned char* yrow = WSP(unsigned char, WS_YROW);
    const int* tok_e = WSP(int, WS_TOKE); const int* tok_r = WSP(int, WS_TOKR); const float* g2 = A.in[22]; const float* b2 = A.in[23]; float* out = A.out;
    const int c0 = 16 * F.lane;
    for (int m = gw; m < T; m += NGW) {
        const float* md = mod + (m / SEQ) * 6 * DM;
        f32x4 f[4];
#pragma unroll
        for (int j = 0; j < 4; ++j) f[j] = (f32x4){0.f, 0.f, 0.f, 0.f};
#pragma unroll
        for (int k = 0; k < TOPK; ++k) { const int e = tok_e[m * TOPK + k], rk = tok_r[m * TOPK + k]; const size_t pos = (size_t)tstart[e] * 256 + rk;
            const u32x4 w = *(const u32x4*)(yrow + pos * DM + c0);
#pragma unroll
            for (int j = 0; j < 4; ++j) { const f32x2 lo = __builtin_amdgcn_cvt_pk_f32_fp8((int)w[j], false), hi = __builtin_amdgcn_cvt_pk_f32_fp8((int)w[j], true); f[j] += (f32x4){lo.x, lo.y, hi.x, hi.y}; } }
        { const u32x4 w = *(const u32x4*)(ysh + (size_t)m * DM + c0);
#pragma unroll
          for (int j = 0; j < 4; ++j) { const f32x2 lo = __builtin_amdgcn_cvt_pk_f32_fp8((int)w[j], false), hi = __builtin_amdgcn_cvt_pk_f32_fp8((int)w[j], true); f[j] += (f32x4){lo.x, lo.y, hi.x, hi.y}; }
          const float is = 1.f / pg8::YROW_SCALE; f[0] = f[0] * is; f[1] = f[1] * is; f[2] = f[2] * is; f[3] = f[3] * is; }
        const f32x4* xr = (const f32x4*)(x1 + (size_t)m * DM + c0); f32x4 v[4]; float s = 0.f;
#pragma unroll
        for (int j = 0; j < 4; ++j) { const f32x4 gv = *((const f32x4*)(md + 5 * DM + c0) + j); v[j] = xr[j] * ALPHA + gv * f[j]; s += (v[j][0] + v[j][1]) + (v[j][2] + v[j][3]); }
        const float mean = wave_sum(s) * (1.f / DM); float s2 = 0.f;
#pragma unroll
        for (int j = 0; j < 4; ++j) { v[j] = v[j] - mean; s2 += (v[j][0] * v[j][0] + v[j][1] * v[j][1]) + (v[j][2] * v[j][2] + v[j][3] * v[j][3]); }
        const float rstd = 1.f / sqrtf(wave_sum(s2) * (1.f / DM) + LN_EPS);
        f32x4* oo = (f32x4*)(out + (size_t)m * DM + c0);
#pragma unroll
        for (int j = 0; j < 4; ++j) { const f32x4 gg = *((const f32x4*)(g2 + c0) + j), bb = *((const f32x4*)(b2 + c0) + j); oo[j] = v[j] * rstd * gg + bb; }
    }
}
constexpr int NPHASE = 13;

__global__ void __launch_bounds__(NTHR, 2) mk_fwd(Args args) {
    extern __shared__ __attribute__((aligned(16))) unsigned char lds_raw[];
    Frame F;
    F.lds = (LAS unsigned char*)lds_raw; F.MISC = (volatile LAS unsigned*)(F.lds + L_MISC);
    F.tid = threadIdx.x; F.lane = F.tid & 63; F.wave = __builtin_amdgcn_readfirstlane(F.tid >> 6);
    F.G = gridDim.x; { const int bx = blockIdx.x; F.vcu = (F.G % 8 == 0) ? (bx % 8) * (F.G / 8) + bx / 8 : bx; }
    const Args& A = args;
    F.ctl = (gu32*)(args.ws + WS_CTL);
    if (F.tid < 64) F.MISC[F.tid] = 0u;
    __syncthreads();
    const int lo = args.ph_lo, hi = args.ph_hi;
    XcdBarrier bar; bar.bar = (unsigned*)(F.ctl + CW_BAR); bar.x = 0; bar.st = nullptr;
    if (hi - lo > 1) bar = xcd_barrier_post((unsigned*)(F.ctl + CW_BAR), F.MISC + 8);
#ifndef REPEAT_MASK
#define REPEAT_MASK 0
#endif
#define IN(k) (lo <= (k) && (k) < hi)
#define REP(k) _Pragma("nounroll") for (int rep_ = 0; rep_ < (((REPEAT_MASK >> (k)) & 1) ? 2 : 1); ++rep_)
#define STAMP(k) do { if (TIME_PHASE >= 0 && blockIdx.x == 0 && F.tid == 0) { const unsigned long long t_ = __builtin_amdgcn_s_memrealtime(); F.MISC[16 + 2 * (k)] = (unsigned)t_; F.MISC[17 + 2 * (k)] = (unsigned)(t_ >> 32); } } while (0)
#define SEAM(k) do { if (IN(k) && IN((k) + 1)) xcd_barrier(bar); STAMP((k) + 1); } while (0)
    LAS unsigned char* ring = F.lds;
    STAMP(0);

    if (IN(0)) REP(0) { p0_phase(F, A); } SEAM(0);
    if (IN(1)) REP(1) { p1_phase(F, A); } SEAM(1);
    if (IN(2)) REP(2) {
        pg8::StaticOrder S; S.init(WSP(bf16_t, WS_H), WSP(bf16_t, WS_WIN), T, INW, DM * 2, DM * 2, F.G, (int)blockIdx.x);
        pg8::EpiInProj E{A.ws, WSP(float, WS_ROPE)};
        pg8::gemm_phase<pg8::EpiInProj, pg8::StaticOrder, false, true>(ring, DM, DM * 2, DM * 2, S, E);
    } SEAM(2);
    if (IN(3)) REP(3) { REP(13) attn_phase(F, A); REP(14) sgu_phase(F, A); } SEAM(3);
    if (IN(4)) REP(4) { p4_phase(F, A); } SEAM(4);
    if (IN(5)) REP(5) {
        { pg8::StaticOrder S; S.init(WSP(bf16_t, WS_OA), WSP(bf16_t, WS_WPA), T, DM, AW * 2, AW * 2, F.G, (int)blockIdx.x);
          pg8::EpiGate<false> E{WSP(bf16_t, WS_MERGED), WSP(bf16_t, WS_GA)};
          pg8::gemm_phase<pg8::EpiGate<false>, pg8::StaticOrder, false, false>(ring, AW, AW * 2, AW * 2, S, E); }
        { pg8::StaticOrder S; S.init(WSP(bf16_t, WS_SG), WSP(bf16_t, WS_WPB), T, DM, GW * 2, GW * 2, F.G, (int)blockIdx.x);
          pg8::EpiGate<true> E{WSP(bf16_t, WS_MERGED), WSP(bf16_t, WS_GB)};
          pg8::gemm_phase<pg8::EpiGate<true>, pg8::StaticOrder, false, false>(ring, GW, GW * 2, GW * 2, S, E); }
    } SEAM(5);
    if (IN(6)) REP(6) {
        pg8::StaticOrder S; S.init(WSP(bf16_t, WS_MERGED), WSP(bf16_t, WS_WOUT), T, DM, DM * 2, DM * 2, F.G, (int)blockIdx.x);
        pg8::EpiBf16<false> E{WSP(bf16_t, WS_MIX), DM, nullptr};
        pg8::gemm_phase<pg8::EpiBf16<false>, pg8::StaticOrder, false, false>(ring, DM, DM * 2, DM * 2, S, E);
    } SEAM(6);
    if (IN(7)) REP(7) { p7_phase(F, A); } SEAM(7);
    if (IN(8)) REP(8) {
        pg8::StaticOrder S; S.init(WSP(bf16_t, WS_H), WSP(bf16_t, WS_WRS), T, 768, DM * 2, DM * 2, F.G, (int)blockIdx.x);
        pg8::EpiRouterShared E{WSP(float, WS_LOGITS), WSP(bf16_t, WS_SHID)};
        pg8::gemm_phase<pg8::EpiRouterShared, pg8::StaticOrder, false, true>(ring, DM, DM * 2, DM * 2, S, E);
    } SEAM(8);
    if (IN(9)) REP(9) { p9_phase(F, A); } SEAM(9);
    if (IN(10)) REP(10) {
        build_tile_table(F, A);
        pg8::GroupedOrder S; S.G = F.G; S.c = F.vcu; S.NPN = 2; S.ntiles = (int)F.MISC[4]; S.tile_e = (const LAS unsigned short*)(F.lds + L_TILE_E); S.tstart = (const LAS unsigned short*)(F.lds + L_TSTART);
        S.cnt = (const LAS unsigned short*)(F.lds + L_CNT); S.Abase = (const char*)WSP(bf16_t, WS_H); S.a_tile_stride = 0; S.Bbase = (const char*)WSP(bf16_t, WS_WGU); S.b_exp_stride = (size_t)512 * DM * 2; S.b_tile_stride = (size_t)256 * DM * 2;
        S.idxbase = WSP(int, WS_BTOK); S.gather = true;
        pg8::EpiGateUp E{WSP(bf16_t, WS_HID)};
        pg8::gemm_phase<pg8::EpiGateUp, pg8::GroupedOrder, true, true>(ring, DM, DM * 2, DM * 2, S, E);
    } SEAM(10);
    if (IN(11)) REP(11) {
        build_tile_table(F, A);
        { pg8::GroupedOrder S; S.G = F.G; S.c = F.vcu; S.NPN = 4; S.ntiles = (int)F.MISC[4]; S.tile_e = (const LAS unsigned short*)(F.lds + L_TILE_E); S.tstart = (const LAS unsigned short*)(F.lds + L_TSTART);
          S.cnt = (const LAS unsigned short*)(F.lds + L_CNT); S.Abase = (const char*)WSP(bf16_t, WS_HID); S.a_tile_stride = (size_t)256 * ED * 2; S.Bbase = (const char*)WSP(bf16_t, WS_WD); S.b_exp_stride = (size_t)DM * ED * 2; S.b_tile_stride = (size_t)256 * ED * 2;
          S.idxbase = WSP(int, WS_BW); S.gather = false;
          pg8::EpiDown E{WSP(unsigned char, WS_YROW)};
          pg8::gemm_phase<pg8::EpiDown, pg8::GroupedOrder, false, true>(ring, ED, ED * 2, ED * 2, S, E); }
        { pg8::StaticOrder S; S.init(WSP(bf16_t, WS_SHID), WSP(bf16_t, WS_WSD), T, DM, SD * 2, SD * 2, F.G, (int)blockIdx.x);
          pg8::EpiDown E{WSP(unsigned char, WS_YSH)};
          pg8::gemm_phase<pg8::EpiDown, pg8::StaticOrder, false, false>(ring, SD, SD * 2, SD * 2, S, E); }
    } SEAM(11);
    if (IN(12)) REP(12) { build_tile_table(F, A); p12_phase(F, A); }
    if (TIME_PHASE >= 0 && blockIdx.x == 0 && F.tid == 0) {
        STAMP(13);
        const unsigned long long t0 = ((unsigned long long)F.MISC[17 + 2 * TIME_PHASE] << 32) | F.MISC[16 + 2 * TIME_PHASE], t1 = ((unsigned long long)F.MISC[19 + 2 * TIME_PHASE] << 32) | F.MISC[18 + 2 * TIME_PHASE];
        const unsigned long long dt = (t1 - t0) * 8ull, s0 = __builtin_amdgcn_s_memrealtime();
        while (__builtin_amdgcn_s_memrealtime() - s0 < dt) __builtin_amdgcn_s_sleep(8);
    }
#undef IN
#undef REP
#undef SEAM
}

#ifndef MK_SPLIT
#define MK_SPLIT 0
#endif
static int mk_grid(size_t ws_size) {
    static int grid = 0;
    if (grid == 0) {
        int dev = 0, cus = 0, per_cu = 0;
        if (ws_size < WS_END) { fprintf(stderr, "kernel_launch: workspace too small (%zu < %zu)\n", ws_size, (size_t)WS_END); grid = -1; return -1; }
        if (hipGetDevice(&dev) != hipSuccess || hipDeviceGetAttribute(&cus, hipDeviceAttributeMultiprocessorCount, dev) != hipSuccess) { grid = -1; return -1; }
        if (hipFuncSetAttribute((const void*)mk_fwd, hipFuncAttributeMaxDynamicSharedMemorySize, LDS_BYTES) != hipSuccess) { fprintf(stderr, "kernel_launch: hipFuncSetAttribute failed\n"); grid = -1; return -1; }
        if (hipOccupancyMaxActiveBlocksPerMultiprocessor(&per_cu, (const void*)mk_fwd, NTHR, LDS_BYTES) != hipSuccess || per_cu < 1) { fprintf(stderr, "kernel_launch: occupancy query says %d blocks/CU\n", per_cu); (void)hipGetLastError(); grid = -1; return -1; }
        grid = cus;
    }
    return grid;
}
static void mk_run(void* const* d_in, float* out, void* d_ws, int grid, int lo, int hi, hipStream_t stream) {
    Args a{};
    for (int i = 0; i < 24; ++i) a.in[i] = (const float*)d_in[i];
    a.out = out; a.ws = (unsigned char*)d_ws; a.ph_lo = lo; a.ph_hi = hi;
#ifndef MK_COOP
#define MK_COOP 1
#endif
    if (MK_COOP && hi - lo > 1) {
        void* kargs[] = {&a};
        hipError_t e = hipLaunchCooperativeKernel((const void*)mk_fwd, dim3(grid), dim3(NTHR), kargs, LDS_BYTES, stream);
        if (e != hipSuccess) fprintf(stderr, "kernel_launch: cooperative launch failed: %s (grid %d)\n", hipGetErrorString(e), grid);
    } else {
        hipLaunchKernelGGL(mk_fwd, dim3(grid), dim3(NTHR), LDS_BYTES, stream, a);
    }
}
static int mk_launch(void* const* d_in, float* out, void* d_ws, size_t ws_size, hipStream_t stream) {
    const int grid = mk_grid(ws_size);
    if (grid < 0) return -1;
    (void)hipMemsetAsync((char*)d_ws + WS_CTL, 0, CTL_ZERO_BYTES, stream);
#if MK_SPLIT
#ifndef EXTRA_PHASE
#define EXTRA_PHASE -1
#endif
    for (int p = 0; p < NPHASE; ++p) { mk_run(d_in, out, d_ws, grid, p, p + 1, stream); if (p == EXTRA_PHASE) mk_run(d_in, out, d_ws, grid, p, p + 1, stream); }
#else
    mk_run(d_in, out, d_ws, grid, 0, NPHASE, stream);
#endif
    return 0;
}
extern "C" void kernel_launch(void* const* d_in, const int* in_sizes, int n_in, void* d_out, int out_size, void* d_ws, size_t ws_size, hipStream_t stream) {
    (void)in_sizes; (void)n_in; (void)out_size;
#if PROBE
    probe::run(d_in, d_out, d_ws, ws_size, stream);
#else
    mk_launch(d_in, (float*)d_out, d_ws, ws_size, stream);
#endif
}
```

```cpp
#define PROBE 0
#define PROBE_STAGE -1
#define MK_SPLIT 0
#define REPEAT_MASK 0
#define EXTRA_PHASE -1
#define MK_COOP 1
#define TIME_PHASE -1
#include <hip/hip_runtime.h>
#include <math.h>
#include <stdint.h>
#include <cstdio>

#define LAS __attribute__((address_space(3)))
#define GAS __attribute__((address_space(1)))
typedef unsigned short bf16_t;
typedef short bf16x8 __attribute__((ext_vector_type(8)));
typedef short s16x4 __attribute__((ext_vector_type(4)));
typedef float f32x4 __attribute__((ext_vector_type(4)));
typedef float f32x2 __attribute__((ext_vector_type(2)));
typedef unsigned u32x4 __attribute__((ext_vector_type(4)));
typedef unsigned u32x2 __attribute__((ext_vector_type(2)));
typedef GAS unsigned gu32;

constexpr int NB = 8, SEQ = 2048, DM = 1024, T = NB * SEQ;
constexpr int NH = 8, HD = 64, AW = 512, GW = 1024, INW = 5632;
constexpr int NE = 256, TOPK = 8, ED = 256, SD = 256;
constexpr float ALPHA = 1.189207115002721f;
constexpr float LN_EPS = 1e-5f;
constexpr int NWAVES = 8, NTHR = 512;
constexpr int BUCKET = 16384;
constexpr int MAXTILES = 768;

constexpr size_t MiB = 1u << 20;
constexpr size_t WS_CTL = 0, CTL_ZERO_BYTES = 128 * 1024;
constexpr size_t WS_MOD = 1 * MiB;
constexpr size_t WS_ROPE = 1 * MiB + 256 * 1024;
constexpr size_t WS_WPA = 2 * MiB, WS_WPB = 3 * MiB, WS_WOUT = 5 * MiB, WS_WRS = 7 * MiB, WS_WSD = 8 * MiB + 512 * 1024;
constexpr size_t WS_WD = 10 * MiB;
constexpr size_t WS_X1 = 138 * MiB;
constexpr size_t WS_HID = 202 * MiB;
constexpr size_t WS_SHID = 298 * MiB;
constexpr size_t WS_YSH = 306 * MiB;
constexpr size_t WS_TOKE = 338 * MiB, WS_TOKR = WS_TOKE + 512 * 1024, WS_TOKW = WS_TOKR + 512 * 1024;
constexpr size_t WS_BTOK = 340 * MiB, WS_BW = 356 * MiB;
constexpr size_t WS_D = 372 * MiB;
constexpr size_t WS_YROW = WS_D;
constexpr size_t WS_WGU = 372 * MiB;
constexpr size_t WS_WIN = 628 * MiB;
constexpr size_t WS_H = 640 * MiB;
constexpr size_t WS_OP = 628 * MiB, WS_LSE = 676 * MiB;
constexpr size_t WS_Q = 678 * MiB, WS_K = 694 * MiB, WS_V = 710 * MiB;
constexpr size_t WS_H8 = 710 * MiB;
constexpr size_t WS_MERGED = 678 * MiB;
constexpr size_t WS_U = 726 * MiB, WS_VG = 758 * MiB;
constexpr size_t WS_MIX = 726 * MiB;
constexpr size_t WS_LOGITS = 758 * MiB;
constexpr size_t WS_GA = 790 * MiB, WS_GB = 822 * MiB;
constexpr size_t WS_OA = 854 * MiB, WS_SG = 870 * MiB;
constexpr size_t WS_END = 902 * MiB;
constexpr size_t WS_GOLD = 960 * MiB;
constexpr int CW_BAR = 1024;
constexpr int CW_CNT = 8192, CNT_STRIDE = 64;
static_assert((CW_CNT + 256 * CNT_STRIDE) * 4 <= (int)CTL_ZERO_BYTES, "CTL map");

#define RLX_AGENT __ATOMIC_RELAXED, __HIP_MEMORY_SCOPE_AGENT
#define LDS_WAIT() asm volatile("s_waitcnt lgkmcnt(0)" ::: "memory")
#define VM_WAIT() asm volatile("s_waitcnt vmcnt(0)" ::: "memory")
__device__ __forceinline__ unsigned cvt_pk_bf16(float lo, float hi) { unsigned r; asm volatile("v_cvt_pk_bf16_f32 %0, %1, %2" : "=v"(r) : "v"(lo), "v"(hi)); return r; }
__device__ __forceinline__ float bf_lo(unsigned u) { return __uint_as_float(u << 16); }
__device__ __forceinline__ float bf_hi(unsigned u) { return __uint_as_float(u & 0xffff0000u); }
__device__ __forceinline__ float wave_sum(float v) {
#pragma unroll
    for (int o = 1; o < 64; o <<= 1) v += __shfl_xor(v, o);
    return v;
}
__device__ __forceinline__ float fast_sigmoid(float x) { return __builtin_amdgcn_rcpf(1.f + __builtin_amdgcn_exp2f(-1.4426950408889634f * x)); }
__device__ __forceinline__ f32x2 gelu_pk(f32x2 v) {
    const f32x2 av = __builtin_elementwise_abs(v), d = av * 0.2316418882f + 1.0f;
    f32x2 t; t.x = __builtin_amdgcn_rcpf(d.x); t.y = __builtin_amdgcn_rcpf(d.y);
    f32x2 q = t * 0.5307027145f + (-0.7265760135f); q = q * t + 0.7107068705f; q = q * t + (-0.142248368f); q = q * t + 0.127414796f; q = q * t;
    const f32x2 s = (v * v) * (-0.72134752044f);
    f32x2 e; e.x = __builtin_amdgcn_exp2f(s.x); e.y = __builtin_amdgcn_exp2f(s.y);
    const f32x2 m = v * (q * e), r = v - m;
    f32x2 o; o.x = v.x < 0.f ? m.x : r.x; o.y = v.y < 0.f ? m.y : r.y; return o;
}

#define XB_TMO      128
#define XB_XCNT(j)  (256  + 64 * (j))
#define XB_XSUB(j)  (1280 + 64 * (j))
#define XB_XGEN(j)  (2304 + 64 * (j))
#define XB_TOP      3328
#define XB_TOPGEN   3392
#define XCD_BAR_WORDS 3456
#define XB_SPIN_CAP (1u << 18)
__device__ __forceinline__ unsigned xb_ld(unsigned* p)              { return __hip_atomic_load(p, __ATOMIC_RELAXED, __HIP_MEMORY_SCOPE_AGENT); }
__device__ __forceinline__ unsigned xb_add(unsigned* p, unsigned v) { return __hip_atomic_fetch_add(p, v, __ATOMIC_RELAXED, __HIP_MEMORY_SCOPE_AGENT); }
__device__ __forceinline__ unsigned xb_xcc_id() { return (unsigned)__builtin_amdgcn_s_getreg((3 << 11) | 20) & 0xFu; }
#define XB_SPIN(cond, bar) do { unsigned _sp = 0; while (cond) { __builtin_amdgcn_s_sleep(1); \
    if ((++_sp & 255u) == 0u) { if (xb_ld(&(bar)[XB_TMO])) break; if (_sp > XB_SPIN_CAP) { atomicAdd(&(bar)[XB_TMO], 1u); break; } } } } while (0)
struct XcdBarrier { unsigned* bar; unsigned x; volatile LAS unsigned* st; };
__device__ __forceinline__ XcdBarrier xcd_barrier_post(unsigned* bar, volatile LAS unsigned* st) {
    XcdBarrier b; b.bar = bar; b.x = xb_xcc_id(); b.st = st;
    if (threadIdx.x == 0) (void)xb_add(&bar[XB_XCNT(b.x)], 1u);
    return b;
}
__device__ __forceinline__ void xcd_barrier_complete(unsigned* bar, unsigned x, unsigned& nloc, unsigned& nx) {
    const unsigned G = gridDim.x * gridDim.y * gridDim.z;
    unsigned sum, cnt, mine, sp = 0u;
    for (;;) {
        sum = 0u; cnt = 0u; mine = 0u;
#pragma unroll
        for (unsigned j = 0; j < 16; ++j) { const unsigned c = xb_ld(&bar[XB_XCNT(j)]); sum += c; cnt += (c > 0u) ? 1u : 0u; mine = (j == x) ? c : mine; }
        if (sum == G) break;
        __builtin_amdgcn_s_sleep(1);
        if ((++sp & 255u) == 0u) { if (xb_ld(&bar[XB_TMO])) break; if (sp > XB_SPIN_CAP) { atomicAdd(&bar[XB_TMO], 1u); break; } }
    }
    nloc = mine > 0u ? mine : 1u; nx = cnt > 0u ? cnt : 1u;
}
__device__ __forceinline__ void xcd_barrier(const XcdBarrier& b) {
    asm volatile("s_waitcnt vmcnt(0)" ::: "memory");
    __syncthreads();
    if (threadIdx.x == 0) {
        unsigned* bar = b.bar;
        __builtin_amdgcn_s_waitcnt(0);
        unsigned nloc = b.st[0], nx = b.st[1];
        if (nloc == 0u) { xcd_barrier_complete(bar, b.x, nloc, nx); b.st[0] = nloc; b.st[1] = nx; }
        const unsigned old = xb_add(&bar[XB_XSUB(b.x)], 1u);
        const unsigned gen = old / nloc;
        if (old + 1u == (gen + 1u) * nloc) {
            __builtin_amdgcn_fence(__ATOMIC_RELEASE, "agent");
            asm volatile("s_waitcnt vmcnt(0)" ::: "memory");
            const unsigned og = xb_add(&bar[XB_TOP], 1u);
            const unsigned tg = og / nx;
            if (og + 1u == (tg + 1u) * nx) xb_add(&bar[XB_TOPGEN], 1u);
            else XB_SPIN(xb_ld(&bar[XB_TOPGEN]) == tg, bar);
            __builtin_amdgcn_fence(__ATOMIC_ACQUIRE, "agent");
            xb_add(&bar[XB_XGEN(b.x)], 1u);
            asm volatile("s_waitcnt vmcnt(0)" ::: "memory");
        } else {
            XB_SPIN(xb_ld(&bar[XB_XGEN(b.x)]) == gen, bar);
            __builtin_amdgcn_fence(__ATOMIC_ACQUIRE, "agent");
            asm volatile("s_waitcnt vmcnt(0)" ::: "memory");
        }
    }
    __syncthreads();
}

namespace pg8 {
constexpr int BM = 256, BK = 64, HALF = 128, HTB = HALF * BK * 2, STAGE_BYTES = 8 * HTB, NXCD = 8, WGM = 8;
__host__ __device__ __forceinline__ int lds_byte(int r, int c) { const int st = (r >> 4) * 2 + (c >> 5), rr = r & 15, cc = c & 31, ob = rr * 64 + cc * 2; return st * 1024 + (ob ^ (((ob >> 9) & 1) << 5)); }
__host__ __device__ __forceinline__ void stage_rc(int b, int& R, int& C) { const int st = b / 1024, sb = b % 1024, swz = sb ^ (((sb >> 9) & 1) << 5); R = (st >> 1) * 16 + swz / 64; C = (st & 1) * 32 + (swz % 64) / 2; }
__host__ __device__ __forceinline__ int perm32(int rho) { const int n = rho >> 4, i = rho & 15; return 8 * (i >> 2) + 4 * n + (i & 3); }

struct GU { const char* A; const char* B; const int* gidx; int gcnt; int pm, pn, e; };

struct StaticOrder {
    int nM, nN, nwg, G, c; const char* A; const char* B; size_t tstepA, tstepB;
    __device__ void init(const void* A_, const void* B_, int M, int N, unsigned lda, unsigned ldb, int G_, int c_) { nM = M / BM; nN = N / BM; nwg = nM * nN; G = G_; c = c_; A = (const char*)A_; B = (const char*)B_; tstepA = (size_t)BM * lda; tstepB = (size_t)BM * ldb; }
    __device__ bool next(int i, GU& u) const {
        const long L = (long)i * G + c; if (L >= nwg) return false;
        int wgid = (int)L; { const int q = nwg / NXCD, r = nwg % NXCD, xcd = wgid % NXCD, off = wgid / NXCD; wgid = (xcd < r ? xcd * (q + 1) : r * (q + 1) + (xcd - r) * q) + off; }
        const int nig = WGM * nN, gid = wgid / nig, fm = gid * WGM, gsz = (nM - fm) < WGM ? (nM - fm) : WGM;
        u.pm = fm + ((wgid % nig) % gsz); u.pn = (wgid % nig) / gsz; u.e = 0; u.gidx = nullptr; u.gcnt = BM;
        u.A = A + (size_t)u.pm * tstepA; u.B = B + (size_t)u.pn * tstepB; return true;
    }
};

typedef int v8i32 __attribute__((ext_vector_type(8)));
template <class Epi, class Sched, bool GATHER, bool ALIGN_EPI, bool SKIP = false, bool FP8 = false>
__device__ __forceinline__ void gemm_phase(LAS unsigned char* lds, const int K, const unsigned lda, const unsigned ldb, const Sched& S, const Epi& E) {
    const int tid = threadIdx.x, wid = __builtin_amdgcn_readfirstlane(tid >> 6), lane = tid & 63, wr = wid >> 2, wc = wid & 3, fr = lane & 15, fq = lane >> 4;
    int nt = K / BK; asm volatile("" : "+s"(nt));
    int R0, C0, R1, C1; stage_rc(tid * 16, R0, C0); stage_rc(tid * 16 + 8192, R1, C1);
    const int Rb0 = (R0 & ~31) + perm32(R0 & 31), Rb1 = (R1 & ~31) + perm32(R1 & 31);
    const unsigned vB0 = (unsigned)Rb0 * ldb + (unsigned)C0 * 2u, vB1 = (unsigned)Rb1 * ldb + (unsigned)C1 * 2u;
    const size_t kstep = (size_t)(BK * 2);
    const size_t hstepB = (size_t)HALF * ldb;
    const unsigned ldsw = (unsigned)wid * 1024u;
    const int aoff = FP8 ? lds_byte(wr * 64 + fr, fq * 16) : lds_byte(wr * 64 + fr, fq * 8), boff = FP8 ? lds_byte(wc * 32 + fr, fq * 16) : lds_byte(wc * 32 + fr, fq * 8);
#define PG8_SA(b, h) (((b) * 2 + (h)) * HTB)
#define PG8_SB(b, h) ((4 + (b) * 2 + (h)) * HTB)
#define PG8_STAGE(bufoff, gbase, v0, v1) do { \
        __builtin_amdgcn_global_load_lds((const unsigned*)((const char*)(gbase) + (v0)), (LAS unsigned*)(lds + (bufoff) + ldsw), 16, 0, 0); \
        __builtin_amdgcn_global_load_lds((const unsigned*)((const char*)(gbase) + (v1)), (LAS unsigned*)(lds + (bufoff) + ldsw + 8192), 16, 0, 0); } while (0)
#define PG8_LDA(dst, b, h) do { _Pragma("unroll") for (int m = 0; m < 4; ++m) _Pragma("unroll") for (int k = 0; k < 2; ++k) dst[m][k] = *(const LAS bf16x8*)(lds + PG8_SA(b, h) + aoff + m * 2048 + k * (FP8 ? 16 : 1024)); } while (0)
#define PG8_LDB(dst, b, h) do { _Pragma("unroll") for (int n = 0; n < 2; ++n) _Pragma("unroll") for (int k = 0; k < 2; ++k) dst[n][k] = *(const LAS bf16x8*)(lds + PG8_SB(b, h) + boff + n * 2048 + k * (FP8 ? 16 : 1024)); } while (0)
#define PG8_CAT8(x) __builtin_shufflevector(__builtin_bit_cast(u32x4, (x)[0]), __builtin_bit_cast(u32x4, (x)[1]), 0, 1, 2, 3, 4, 5, 6, 7)
#define PG8_MMA(ai, bj, At, Bt) do { if (SKIP && !((ai) ? do1 : do0)) break; __builtin_amdgcn_s_setprio(1); \
        if constexpr (FP8) { _Pragma("unroll") for (int m = 0; m < 4; ++m) _Pragma("unroll") for (int n = 0; n < 2; ++n) \
            asm volatile("v_mfma_scale_f32_16x16x128_f8f6f4 %0, %1, %2, %0, %3, %3 op_sel_hi:[0,0,0]" : "+v"(acc[ai][bj][m][n]) : "v"(__builtin_bit_cast(v8i32, PG8_CAT8(Bt[n]))), "v"(__builtin_bit_cast(v8i32, PG8_CAT8(At[m]))), "v"(one8)); } \
        else { _Pragma("unroll") for (int m = 0; m < 4; ++m) _Pragma("unroll") for (int n = 0; n < 2; ++n) _Pragma("unroll") for (int k = 0; k < 2; ++k) \
            acc[ai][bj][m][n] = __builtin_amdgcn_mfma_f32_16x16x32_bf16(Bt[n][k], At[m][k], acc[ai][bj][m][n], 0, 0, 0); } \
        __builtin_amdgcn_s_setprio(0); } while (0)
#define PG8_WAIT_V(n) asm volatile("s_waitcnt vmcnt(" #n ")" ::: "memory")
#define PG8_WAIT_L(n) asm volatile("s_waitcnt lgkmcnt(" #n ")" ::: "memory")
#define PG8_BAR __builtin_amdgcn_s_barrier()
#define PG8_SCHED __builtin_amdgcn_sched_barrier(0)
#define PG8_AOFFS(u, o00, o01, o10, o11) do { \
        if constexpr (GATHER) { \
            const int i00 = R0 < (u).gcnt ? (u).gidx[R0] : 0, i01 = R1 < (u).gcnt ? (u).gidx[R1] : 0; \
            const int i10 = (HALF + R0) < (u).gcnt ? (u).gidx[HALF + R0] : 0, i11 = (HALF + R1) < (u).gcnt ? (u).gidx[HALF + R1] : 0; \
            o00 = (unsigned)i00 * lda + (unsigned)C0 * 2u; o01 = (unsigned)i01 * lda + (unsigned)C1 * 2u; \
            o10 = (unsigned)i10 * lda + (unsigned)C0 * 2u; o11 = (unsigned)i11 * lda + (unsigned)C1 * 2u; \
            asm volatile("s_waitcnt vmcnt(0)" : "+v"(o00), "+v"(o01), "+v"(o10), "+v"(o11) :: "memory"); \
        } else { \
            o00 = (unsigned)R0 * lda + (unsigned)C0 * 2u; o01 = (unsigned)R1 * lda + (unsigned)C1 * 2u; \
            o10 = (unsigned)(HALF + R0) * lda + (unsigned)C0 * 2u; o11 = (unsigned)(HALF + R1) * lda + (unsigned)C1 * 2u; \
        } } while (0)
    GU cur, nxt; int ui = 0;
    if (!S.next(0, cur)) return;
    int one8 = 0x7f7f7f7f; asm volatile("" : "+v"(one8));
    f32x4 acc[2][2][4][2];
#pragma unroll
    for (int a = 0; a < 2; ++a)
#pragma unroll
        for (int b = 0; b < 2; ++b)
#pragma unroll
            for (int m = 0; m < 4; ++m)
#pragma unroll
                for (int n = 0; n < 2; ++n) acc[a][b][m][n] = (f32x4){0.f, 0.f, 0.f, 0.f};
    bf16x8 At[4][2], B0[2][2], B1[2][2];
    const char* cA = cur.A; const char* cB = cur.B;
    unsigned c00, c01, c10, c11, n00, n01, n10, n11;
    PG8_AOFFS(cur, c00, c01, c10, c11);
    PG8_STAGE(PG8_SB(0, 0), cB, vB0, vB1); PG8_STAGE(PG8_SB(0, 1), cB + hstepB, vB0, vB1); PG8_STAGE(PG8_SA(0, 0), cA, c00, c01); PG8_STAGE(PG8_SA(0, 1), cA, c10, c11);
    if (wr == 1) PG8_BAR;
    PG8_WAIT_V(2); PG8_BAR;
    PG8_STAGE(PG8_SB(1, 0), cB + kstep, vB0, vB1); PG8_STAGE(PG8_SA(1, 0), cA + kstep, c00, c01); PG8_STAGE(PG8_SB(1, 1), cB + hstepB + kstep, vB0, vB1);
    PG8_WAIT_V(6); PG8_BAR;
    for (;;) {
        const bool has_next = S.next(ui + 1, nxt);
        const bool do0 = !SKIP || (wr * 64 < cur.gcnt), do1 = !SKIP || (HALF + wr * 64 < cur.gcnt);
        const char* nA = has_next ? nxt.A : cA; const char* nB = has_next ? nxt.B : cB;
        if (has_next) { PG8_AOFFS(nxt, n00, n01, n10, n11); } else { n00 = c00; n01 = c01; n10 = c10; n11 = c11; }
#pragma nounroll
        for (int t = 0; t < nt; t += 2) {
            const bool last = (t == nt - 2);
            const char* a1 = cA + (size_t)(t + 1) * kstep;
            const char* a2 = last ? nA : cA + (size_t)(t + 2) * kstep; const char* b2 = last ? nB : cB + (size_t)(t + 2) * kstep;
            const char* a3 = a2 + kstep; const char* b3 = b2 + kstep;
            const unsigned x00 = last ? n00 : c00, x01 = last ? n01 : c01, x10 = last ? n10 : c10, x11 = last ? n11 : c11;
            PG8_LDB(B0, 0, 0); PG8_LDB(B1, 0, 1); PG8_SCHED; PG8_LDA(At, 0, 0); PG8_STAGE(PG8_SA(1, 1), a1, c10, c11);
            PG8_WAIT_V(8); PG8_WAIT_L(0); PG8_BAR; PG8_MMA(0, 0, At, B0); PG8_MMA(0, 1, At, B1); PG8_BAR; PG8_SCHED;
            PG8_LDA(At, 0, 1); PG8_STAGE(PG8_SB(0, 0), b2, vB0, vB1); PG8_STAGE(PG8_SB(0, 1), b2 + hstepB, vB0, vB1); PG8_STAGE(PG8_SA(0, 0), a2, x00, x01);
            PG8_WAIT_V(8); PG8_WAIT_L(0); PG8_BAR; PG8_MMA(1, 0, At, B0); PG8_MMA(1, 1, At, B1); PG8_BAR; PG8_SCHED;
            PG8_LDB(B0, 1, 0); PG8_LDB(B1, 1, 1); PG8_SCHED; PG8_LDA(At, 1, 0); PG8_STAGE(PG8_SA(0, 1), a2, x10, x11);
            PG8_WAIT_V(8); PG8_WAIT_L(0); PG8_BAR; PG8_MMA(0, 0, At, B0); PG8_MMA(0, 1, At, B1); PG8_BAR; PG8_SCHED;
            PG8_LDA(At, 1, 1); PG8_STAGE(PG8_SB(1, 0), b3, vB0, vB1); PG8_STAGE(PG8_SB(1, 1), b3 + hstepB, vB0, vB1); PG8_STAGE(PG8_SA(1, 0), a3, x00, x01);
            PG8_WAIT_V(8); PG8_WAIT_L(0); PG8_BAR; PG8_MMA(1, 0, At, B0); PG8_MMA(1, 1, At, B1); PG8_BAR; PG8_SCHED;
        }
        if constexpr (ALIGN_EPI) { if (wr == 0) PG8_BAR; }
        if constexpr (FP8) asm volatile("s_nop 15\n\ts_nop 15" ::: "memory");
        E(acc, cur, wr, wc, fr, fq);
        if (!has_next) break;
#pragma unroll
        for (int a = 0; a < 2; ++a)
#pragma unroll
            for (int b = 0; b < 2; ++b)
#pragma unroll
                for (int m = 0; m < 4; ++m)
#pragma unroll
                    for (int n = 0; n < 2; ++n) acc[a][b][m][n] = (f32x4){0.f, 0.f, 0.f, 0.f};
        cur = nxt; cA = nA; cB = nB; c00 = n00; c01 = n01; c10 = n10; c11 = n11; ++ui;
        if constexpr (ALIGN_EPI) { if (wr == 1) PG8_BAR; }
    }
    PG8_WAIT_V(0);
    if constexpr (!ALIGN_EPI) { if (wr == 0) PG8_BAR; }
    PG8_BAR;
#undef PG8_SA
#undef PG8_SB
#undef PG8_STAGE
#undef PG8_LDA
#undef PG8_LDB
#undef PG8_MMA
#undef PG8_WAIT_V
#undef PG8_WAIT_L
#undef PG8_BAR
#undef PG8_SCHED
#undef PG8_AOFFS
#undef PG8_CAT8
}
}
namespace pg8 {
typedef const f32x4 (&AccRef)[2][2][4][2];
__device__ __forceinline__ u32x4 pack8(f32x4 a, f32x4 b) { u32x4 w; w.x = cvt_pk_bf16(a[0], a[1]); w.y = cvt_pk_bf16(a[2], a[3]); w.z = cvt_pk_bf16(b[0], b[1]); w.w = cvt_pk_bf16(b[2], b[3]); return w; }
__device__ __forceinline__ void unpack8(u32x4 w, f32x4& a, f32x4& b) { a = (f32x4){bf_lo(w.x), bf_hi(w.x), bf_lo(w.y), bf_hi(w.y)}; b = (f32x4){bf_lo(w.z), bf_hi(w.z), bf_lo(w.w), bf_hi(w.w)}; }

struct EpiInProj {
    unsigned char* ws; const float* rcos;
    __device__ __forceinline__ void operator()(AccRef acc, const GU& un, int wr, int wc, int fr, int fq) const {
        const int pn = un.pn; const int row0 = un.pm * BM + wr * 64 + fr;
        if (pn < 4) {
            const float* rsin = rcos + SEQ * 32;
            bf16_t* dst = (bf16_t*)(ws + WS_Q + (size_t)(pn >> 1) * (16 * MiB)); const int dcol = (4 * (pn & 1) + wc) * 64 + 8 * fq;
#pragma unroll
            for (int ai = 0; ai < 2; ++ai)
#pragma unroll
                for (int m = 0; m < 4; ++m) {
                    const int row = row0 + ai * HALF + m * 16; const int pos = row & (SEQ - 1);
                    const f32x4 c0 = *(const f32x4*)(rcos + pos * 32 + 8 * fq), c1 = *(const f32x4*)(rcos + pos * 32 + 8 * fq + 4);
                    const f32x4 s0 = *(const f32x4*)(rsin + pos * 32 + 8 * fq), s1 = *(const f32x4*)(rsin + pos * 32 + 8 * fq + 4);
                    const f32x4 a0 = acc[ai][0][m][0], a1 = acc[ai][0][m][1], b0 = acc[ai][1][m][0], b1 = acc[ai][1][m][1];
                    const f32x4 o0 = a0 * c0 - b0 * s0, o1 = a1 * c1 - b1 * s1, p0 = b0 * c0 + a0 * s0, p1 = b1 * c1 + a1 * s1;
                    bf16_t* rp = dst + (size_t)row * AW + dcol;
                    *(u32x4*)rp = pack8(o0, o1); *(u32x4*)(rp + 32) = pack8(p0, p1);
                }
        } else {
            static_assert(WS_K == WS_Q + 16 * MiB && WS_VG == WS_U + 32 * MiB && WS_GA == WS_U + 64 * MiB && WS_GB == WS_U + 96 * MiB, "in-proj output map");
            const int grp = (pn - 6) >> 2;
            bf16_t* dst = (bf16_t*)(ws + (pn < 6 ? WS_V : WS_U + (size_t)grp * (32 * MiB)));
            const int ldc = pn < 6 ? AW : GW; const int ct = pn < 6 ? pn - 4 : (pn - 6) & 3; const int act = pn < 6 ? 0 : (pn < 14 ? 1 : 2);
            const int col0 = ct * BM + wc * 32 + 8 * fq;
#pragma unroll
            for (int ai = 0; ai < 2; ++ai)
#pragma unroll
                for (int m = 0; m < 4; ++m) {
                    bf16_t* rp = dst + (size_t)(row0 + ai * HALF + m * 16) * ldc + col0;
#pragma unroll
                    for (int bj = 0; bj < 2; ++bj) {
                        f32x4 v0 = acc[ai][bj][m][0], v1 = acc[ai][bj][m][1];
                        if (act == 1) { f32x2 a = gelu_pk((f32x2){v0[0], v0[1]}), b = gelu_pk((f32x2){v0[2], v0[3]}), c = gelu_pk((f32x2){v1[0], v1[1]}), d = gelu_pk((f32x2){v1[2], v1[3]});
                            v0 = (f32x4){a.x, a.y, b.x, b.y}; v1 = (f32x4){c.x, c.y, d.x, d.y}; }
                        else if (act == 2) {
#pragma unroll
                            for (int j = 0; j < 4; ++j) { v0[j] = fast_sigmoid(v0[j]); v1[j] = fast_sigmoid(v1[j]); } }
                        *(u32x4*)(rp + bj * HALF) = pack8(v0, v1);
                    }
                }
        }
    }
};
template <bool ROWSCALE> struct EpiBf16 {
    bf16_t* O; int ldc; const float* roww;
    __device__ __forceinline__ void operator()(AccRef acc, const GU& un, int wr, int wc, int fr, int fq) const {
        const int row0 = un.pm * BM + wr * 64 + fr; const int col0 = un.pn * BM + wc * 32 + 8 * fq;
#pragma unroll
        for (int ai = 0; ai < 2; ++ai)
#pragma unroll
            for (int m = 0; m < 4; ++m) {
                const int row = row0 + ai * HALF + m * 16; bf16_t* rp = O + (size_t)row * ldc + col0;
                float s = 1.f; if constexpr (ROWSCALE) s = roww[row];
#pragma unroll
                for (int bj = 0; bj < 2; ++bj) *(u32x4*)(rp + bj * HALF) = pack8(acc[ai][bj][m][0] * s, acc[ai][bj][m][1] * s);
            }
    }
};
constexpr float YROW_SCALE = 32.f;
struct EpiDown {
    unsigned char* O; float osc;
    __device__ __forceinline__ void operator()(AccRef acc, const GU& un, int wr, int wc, int fr, int fq) const {
        const int r0 = wr * 64 + fr; const int col0 = un.pn * BM + wc * 32 + 8 * fq; const float* wts = (const float*)un.gidx;
#pragma unroll
        for (int ai = 0; ai < 2; ++ai)
#pragma unroll
            for (int m = 0; m < 4; ++m) {
                const int r = r0 + ai * HALF + m * 16; unsigned char* rp = O + (size_t)(un.pm * BM + r) * DM + col0;
                if (r < un.gcnt) { const float s = (wts ? wts[r] : 1.f) * osc;
#pragma unroll
                for (int bj = 0; bj < 2; ++bj) { const f32x4 a = acc[ai][bj][m][0] * s, b = acc[ai][bj][m][1] * s;
                    int w0 = __builtin_amdgcn_cvt_pk_fp8_f32(a[0], a[1], 0, false); w0 = __builtin_amdgcn_cvt_pk_fp8_f32(a[2], a[3], w0, true);
                    int w1 = __builtin_amdgcn_cvt_pk_fp8_f32(b[0], b[1], 0, false); w1 = __builtin_amdgcn_cvt_pk_fp8_f32(b[2], b[3], w1, true);
                    *(u32x2*)(rp + bj * HALF) = (u32x2){(unsigned)w0, (unsigned)w1}; } }
                if (m & 1) asm volatile("" ::: "memory");
            }
    }
};
template <bool ADD> struct EpiGate {
    bf16_t* O; const bf16_t* G;
    __device__ __forceinline__ void operator()(AccRef acc, const GU& un, int wr, int wc, int fr, int fq) const {
        const int row0 = un.pm * BM + wr * 64 + fr; const int col0 = un.pn * BM + wc * 32 + 8 * fq;
#pragma unroll
        for (int ai = 0; ai < 2; ++ai)
#pragma unroll
            for (int m = 0; m < 4; ++m) {
                const size_t off = (size_t)(row0 + ai * HALF + m * 16) * DM + col0;
#pragma unroll
                for (int bj = 0; bj < 2; ++bj) {
                    f32x4 g0, g1; unpack8(*(const u32x4*)(G + off + bj * HALF), g0, g1);
                    f32x4 v0 = acc[ai][bj][m][0] * g0, v1 = acc[ai][bj][m][1] * g1;
                    if constexpr (ADD) { f32x4 p0, p1; unpack8(*(const u32x4*)(O + off + bj * HALF), p0, p1); v0 += p0; v1 += p1; }
                    *(u32x4*)(O + off + bj * HALF) = pack8(v0, v1);
                }
            }
    }
};
struct EpiRouterShared {
    float* logits; bf16_t* shid;
    __device__ __forceinline__ void operator()(AccRef acc, const GU& un, int wr, int wc, int fr, int fq) const {
        const int row0 = un.pm * BM + wr * 64 + fr;
        if (un.pn == 0) {
#pragma unroll
            for (int ai = 0; ai < 2; ++ai)
#pragma unroll
                for (int m = 0; m < 4; ++m) { float* rp = logits + (size_t)(row0 + ai * HALF + m * 16) * NE + wc * 32 + 8 * fq;
#pragma unroll
                    for (int bj = 0; bj < 2; ++bj) { *(f32x4*)(rp + bj * HALF) = acc[ai][bj][m][0]; *(f32x4*)(rp + bj * HALF + 4) = acc[ai][bj][m][1]; } }
        } else {
            const int col0 = (un.pn - 1) * HALF + wc * 32 + 8 * fq;
#pragma unroll
            for (int ai = 0; ai < 2; ++ai)
#pragma unroll
                for (int m = 0; m < 4; ++m) {
                    f32x4 h0, h1;
#pragma unroll
                    for (int j = 0; j < 4; ++j) { const float g0 = acc[ai][0][m][0][j], g1 = acc[ai][0][m][1][j];
                        h0[j] = g0 * fast_sigmoid(g0) * acc[ai][1][m][0][j]; h1[j] = g1 * fast_sigmoid(g1) * acc[ai][1][m][1][j]; }
                    *(u32x4*)(shid + (size_t)(row0 + ai * HALF + m * 16) * SD + col0) = pack8(h0, h1);
                }
        }
    }
};
constexpr float HID_SCALE = 8.f;
struct EpiGateUp {
    unsigned char* hid; float sc;
    __device__ __forceinline__ void operator()(AccRef acc, const GU& un, int wr, int wc, int fr, int fq) const {
        const int row0 = un.pm * BM + wr * 64 + fr; const int col0 = un.pn * HALF + wc * 32 + 8 * fq;
#pragma unroll
        for (int ai = 0; ai < 2; ++ai)
#pragma unroll
            for (int m = 0; m < 4; ++m) {
                f32x4 h0, h1;
#pragma unroll
                for (int j = 0; j < 4; ++j) { const float g0 = acc[ai][0][m][0][j] * sc, g1 = acc[ai][0][m][1][j] * sc;
                    h0[j] = g0 * fast_sigmoid(g0) * (acc[ai][1][m][0][j] * (sc * HID_SCALE)); h1[j] = g1 * fast_sigmoid(g1) * (acc[ai][1][m][1][j] * (sc * HID_SCALE)); }
                int w0 = __builtin_amdgcn_cvt_pk_fp8_f32(h0[0], h0[1], 0, false); w0 = __builtin_amdgcn_cvt_pk_fp8_f32(h0[2], h0[3], w0, true);
                int w1 = __builtin_amdgcn_cvt_pk_fp8_f32(h1[0], h1[1], 0, false); w1 = __builtin_amdgcn_cvt_pk_fp8_f32(h1[2], h1[3], w1, true);
                *(u32x2*)(hid + (size_t)(row0 + ai * HALF + m * 16) * ED + col0) = (u32x2){(unsigned)w0, (unsigned)w1};
            }
    }
};

struct GroupedOrder {
    int G, c, NPN, ntiles; const LAS unsigned short* tile_e; const LAS unsigned short* tstart; const LAS unsigned short* cnt;
    const char* Abase; size_t a_tile_stride;
    const char* Bbase; size_t b_exp_stride, b_tile_stride;
    const int* idxbase;
    bool gather;
    __device__ bool next(int i, GU& u) const {
        const long L = (long)i * G + c; const int tile = (int)(L / NPN);
        if (tile >= ntiles) return false;
        const int pn = (int)(L % NPN); const int e = tile_e[tile]; const int mt = tile - tstart[e];
        u.pm = tile; u.pn = pn; u.e = e; u.gcnt = (int)cnt[e] - mt * BM; u.gidx = idxbase + (size_t)e * BUCKET + mt * BM;
        u.A = gather ? Abase : Abase + (size_t)tile * a_tile_stride;
        u.B = Bbase + (size_t)e * b_exp_stride + (size_t)pn * b_tile_stride;
        return true;
    }
};
}
constexpr int RING_BYTES = 131072;
constexpr int L_TILE_E = RING_BYTES;
constexpr int L_TSTART = L_TILE_E + 1536;
constexpr int L_CNT = L_TSTART + 512;
constexpr int L_HPRE = L_CNT + 512;
constexpr int L_MISC = L_HPRE + 512;
constexpr int LDS_BYTES = 147456;

struct Frame {
    LAS unsigned char* lds; volatile LAS unsigned* MISC; gu32* ctl;
    int tid, lane, wave, vcu, G;
};
struct Args { const float* in[24]; float* out; unsigned char* ws; int ph_lo, ph_hi; };
#define WSP(T_, off) ((T_*)(A.ws + (off)))

__device__ __forceinline__ void cvt_item(const float* W, int ldsrc, int s0, int k0, bf16_t* WT, int Kdst, int dst_row0, LAS float* scr, int lane) {
    float wv[32];
#pragma unroll
    for (int i = 0; i < 32; ++i) { const int kk = 2 * i + (lane >> 5); wv[i] = W[(size_t)(k0 + kk) * ldsrc + s0 + (lane & 31)]; }
#pragma unroll
    for (int i = 0; i < 32; ++i) { const int kk = 2 * i + (lane >> 5); scr[kk * 33 + (lane & 31)] = wv[i]; }
    LDS_WAIT(); asm volatile("" ::: "memory");
    const int c = lane & 7;
#pragma unroll
    for (int j = 0; j < 4; ++j) { const int n = (lane >> 3) + 8 * j; const LAS float* s = scr + (8 * c) * 33 + n;
        u32x4 o; o.x = cvt_pk_bf16(s[0 * 33], s[1 * 33]); o.y = cvt_pk_bf16(s[2 * 33], s[3 * 33]); o.z = cvt_pk_bf16(s[4 * 33], s[5 * 33]); o.w = cvt_pk_bf16(s[6 * 33], s[7 * 33]);
        *(u32x4*)(WT + (size_t)(dst_row0 + n) * Kdst + k0 + 8 * c) = o; }
    LDS_WAIT(); asm volatile("" ::: "memory");
}
constexpr float W8_SCALE = 32.f;
__device__ __forceinline__ void cvt_item_fp8(const float* W, int ldsrc, int s0, int k0, unsigned char* WT, int Kdst, int dst_row0, LAS float* scr, int lane) {
    float wv[32];
#pragma unroll
    for (int i = 0; i < 32; ++i) { const int kk = 2 * i + (lane >> 5); wv[i] = W[(size_t)(k0 + kk) * ldsrc + s0 + (lane & 31)]; }
#pragma unroll
    for (int i = 0; i < 32; ++i) { const int kk = 2 * i + (lane >> 5); scr[kk * 33 + (lane & 31)] = wv[i]; }
    LDS_WAIT(); asm volatile("" ::: "memory");
    const int c = lane & 7;
#pragma unroll
    for (int j = 0; j < 4; ++j) { const int n = (lane >> 3) + 8 * j; const LAS float* s = scr + (8 * c) * 33 + n;
        int w0 = __builtin_amdgcn_cvt_pk_fp8_f32(s[0 * 33] * W8_SCALE, s[1 * 33] * W8_SCALE, 0, false); w0 = __builtin_amdgcn_cvt_pk_fp8_f32(s[2 * 33] * W8_SCALE, s[3 * 33] * W8_SCALE, w0, true);
        int w1 = __builtin_amdgcn_cvt_pk_fp8_f32(s[4 * 33] * W8_SCALE, s[5 * 33] * W8_SCALE, 0, false); w1 = __builtin_amdgcn_cvt_pk_fp8_f32(s[6 * 33] * W8_SCALE, s[7 * 33] * W8_SCALE, w1, true);
        *(u32x2*)(WT + (size_t)(dst_row0 + n) * Kdst + k0 + 8 * c) = (u32x2){(unsigned)w0, (unsigned)w1}; }
    LDS_WAIT(); asm volatile("" ::: "memory");
}
__device__ __forceinline__ void cvt_gu_item(const float* Wg, const float* Wu, bf16_t* WT, int item, LAS float* scr, int lane) {
    const int kb = item >> 4, rb = item & 15; const int p = rb >> 3, bj = (rb >> 2) & 1, q = rb & 3;
    cvt_item(bj ? Wu : Wg, 256, 128 * p + 32 * q, 64 * kb, WT, 1024, 32 * rb, scr, lane);
}

struct CvtSrc { const float* W; int ldsrc, s0, k0; bf16_t* WT; int Kdst, dst_row0; };
__device__ __forceinline__ void cvt_load(const CvtSrc& c, int lane, float (&wv)[32]) {
#pragma unroll
    for (int i = 0; i < 32; ++i) { const int kk = 2 * i + (lane >> 5); wv[i] = c.W[(size_t)(c.k0 + kk) * c.ldsrc + c.s0 + (lane & 31)]; }
}
__device__ __forceinline__ void cvt_finish(const CvtSrc& cs, int lane, const float (&wv)[32], LAS float* scr) {
#pragma unroll
    for (int i = 0; i < 32; ++i) { const int kk = 2 * i + (lane >> 5); scr[kk * 33 + (lane & 31)] = wv[i]; }
    LDS_WAIT(); asm volatile("" ::: "memory");
    const int c = lane & 7;
#pragma unroll
    for (int j = 0; j < 4; ++j) { const int n = (lane >> 3) + 8 * j; const LAS float* s = scr + (8 * c) * 33 + n;
        u32x4 o; o.x = cvt_pk_bf16(s[0 * 33], s[1 * 33]); o.y = cvt_pk_bf16(s[2 * 33], s[3 * 33]); o.z = cvt_pk_bf16(s[4 * 33], s[5 * 33]); o.w = cvt_pk_bf16(s[6 * 33], s[7 * 33]);
        *(u32x4*)(cs.WT + (size_t)(cs.dst_row0 + n) * cs.Kdst + cs.k0 + 8 * c) = o; }
    LDS_WAIT(); asm volatile("" ::: "memory");
}
__device__ __forceinline__ CvtSrc expert_item(const Args& A, int it) {
    constexpr int I_GU = 256, I_D = 128, I_E = I_GU + I_D;
    const int e = it / I_E, r = it % I_E; CvtSrc c;
    if (r < I_GU) { const int kb = r >> 4, rb = r & 15; const int p = rb >> 3, bj = (rb >> 2) & 1, q = rb & 3;
        c.W = (bj ? A.in[17] : A.in[16]) + (size_t)e * DM * ED; c.ldsrc = 256; c.s0 = 128 * p + 32 * q; c.k0 = 64 * kb; c.WT = WSP(bf16_t, WS_WGU) + (size_t)e * 512 * DM; c.Kdst = 1024; c.dst_row0 = 32 * rb; }
    else { const int q = r - I_GU; c.W = A.in[18] + (size_t)e * ED * DM; c.ldsrc = DM; c.s0 = 32 * (q & 31); c.k0 = 64 * (q >> 5); c.WT = WSP(bf16_t, WS_WD) + (size_t)e * DM * ED; c.Kdst = ED; c.dst_row0 = 32 * (q & 31); }
    return c;
}
__device__ __forceinline__ void p0_phase(Frame& F, const Args& A) {
    const float* c = A.in[1]; const float* w_ada = A.in[2]; const float* b_ada = A.in[3];
    float* mod = WSP(float, WS_MOD);
    if (blockIdx.x < 192) {
        LAS float* sc = (LAS float*)F.lds;
        LAS float* part = (LAS float*)(F.lds + 32768);
        for (int i = F.tid; i < NB * DM; i += NTHR) { const float v = c[i]; sc[i] = v / (1.f + expf(-v)); }
        __syncthreads();
        const int j0 = blockIdx.x * 32, col = F.lane & 31, kpar = F.lane >> 5;
        float acc[NB];
#pragma unroll
        for (int b = 0; b < NB; ++b) acc[b] = 0.f;
        const float* wp = w_ada + (size_t)(F.wave * 128 + kpar) * (6 * DM) + j0 + col;
#pragma unroll 1
        for (int i0 = 0; i0 < 64; i0 += 16) {
            float w[16];
#pragma unroll
            for (int i = 0; i < 16; ++i) w[i] = wp[(size_t)(2 * (i0 + i)) * (6 * DM)];
#pragma unroll
            for (int i = 0; i < 16; ++i) { const int k = F.wave * 128 + 2 * (i0 + i) + kpar;
#pragma unroll
                for (int b = 0; b < NB; ++b) acc[b] += sc[b * DM + k] * w[i]; }
        }
#pragma unroll
        for (int b = 0; b < NB; ++b) { acc[b] += __shfl_xor(acc[b], 32); if (F.lane < 32) part[(F.wave * NB + b) * 32 + col] = acc[b]; }
        __syncthreads();
        if (F.tid < 256) { const int b = F.tid >> 5, cc = F.tid & 31; float s = b_ada[j0 + cc];
#pragma unroll
            for (int w = 0; w < 8; ++w) s += part[(w * NB + b) * 32 + cc];
            mod[b * 6 * DM + j0 + cc] = s; }
        __syncthreads();
    }
    { const int gt = blockIdx.x * NTHR + F.tid;
      if (gt < SEQ * 32) { const int pos = gt >> 5, f = gt & 31; const float inv = powf(10000.f, -(float)f / 32.f); float sn, cs; sincosf((float)pos * inv, &sn, &cs);
          WSP(float, WS_ROPE)[gt] = cs; WSP(float, WS_ROPE)[SEQ * 32 + gt] = sn; } }
    LAS float* scr = (LAS float*)(F.lds + F.wave * 16384);
    const int gw = F.vcu * NWAVES + F.wave, NGW = F.G * NWAVES;
    constexpr int I_IN = 16 * 176, I_PA = 8 * 32, I_PB = 16 * 32, I_OUT = 16 * 32, I_RS = 16 * 24, I_SD = 4 * 32;
    constexpr int NIT = I_IN + I_PA + I_PB + I_OUT + I_RS + I_SD;
    for (int it = gw; it < NIT; it += NGW) {
        int r = it;
        if (r < I_IN) { const int kb = r / 176, rb = r % 176; const int pn = rb >> 3, blk = rb & 7; int s0;
            if (pn < 4) { const int base = (pn < 2) ? 0 : AW; s0 = base + (4 * (pn & 1) + (blk & 3)) * 64 + 32 * (blk >> 2); } else s0 = 32 * rb;
            cvt_item(A.in[4], INW, s0, 64 * kb, WSP(bf16_t, WS_WIN), DM, 32 * rb, scr, F.lane); continue; } r -= I_IN;
        if (r < I_PA) { cvt_item(A.in[9], DM, 32 * (r & 31), 64 * (r >> 5), WSP(bf16_t, WS_WPA), AW, 32 * (r & 31), scr, F.lane); continue; } r -= I_PA;
        if (r < I_PB) { cvt_item(A.in[10], DM, 32 * (r & 31), 64 * (r >> 5), WSP(bf16_t, WS_WPB), GW, 32 * (r & 31), scr, F.lane); continue; } r -= I_PB;
        if (r < I_OUT) { cvt_item(A.in[11], DM, 32 * (r & 31), 64 * (r >> 5), WSP(bf16_t, WS_WOUT), DM, 32 * (r & 31), scr, F.lane); continue; } r -= I_OUT;
        if (r < I_RS) { const int kb = r / 24, rb = r % 24;
            if (rb < 8) cvt_item(A.in[14], NE, 32 * rb, 64 * kb, WSP(bf16_t, WS_WRS), DM, 32 * rb, scr, F.lane);
            else cvt_gu_item(A.in[19], A.in[20], WSP(bf16_t, WS_WRS) + (size_t)256 * DM, kb * 16 + (rb - 8), scr, F.lane);
            continue; } r -= I_RS;
        cvt_item(A.in[21], DM, 32 * (r & 31), 64 * (r >> 5), WSP(bf16_t, WS_WSD), SD, 32 * (r & 31), scr, F.lane);
    }
}
__device__ __forceinline__ void p1_phase(Frame& F, const Args& A) {
    const int gw = F.vcu * NWAVES + F.wave, NGW = F.G * NWAVES;
    const float* x = A.in[0]; const float* mod = WSP(float, WS_MOD); bf16_t* h = WSP(bf16_t, WS_H);
    for (int m = gw; m < T; m += NGW) {
        const float* md = mod + (m / SEQ) * 6 * DM; const f32x4* xr = (const f32x4*)(x + (size_t)m * DM) + F.lane; u32x2* o8 = (u32x2*)(h + (size_t)m * DM) + F.lane;
#pragma unroll
        for (int j = 0; j < 4; ++j) { const f32x4 v = xr[64 * j]; const f32x4 sh = *((const f32x4*)md + F.lane + 64 * j), sc = *((const f32x4*)(md + DM) + F.lane + 64 * j);
            const f32x4 r = v * (sc + 1.f) + sh; u32x2 w; w.x = cvt_pk_bf16(r[0], r[1]); w.y = cvt_pk_bf16(r[2], r[3]); o8[64 * j] = w; }
    }
    LAS float* scr = (LAS float*)(F.lds + F.wave * 16384);
    constexpr int I_GU = 256, I_D = 128, I_E = I_GU + I_D;
    for (int it = gw; it < NE * I_E; it += NGW) {
        const int e = it / I_E, r = it % I_E;
        if (r < I_GU) { const int kb = r >> 4, rb = r & 15; const int p = rb >> 3, bj = (rb >> 2) & 1, q = rb & 3;
            cvt_item_fp8((bj ? A.in[17] : A.in[16]) + (size_t)e * DM * ED, 256, 128 * p + 32 * q, 64 * kb, WSP(unsigned char, WS_WGU) + (size_t)e * 512 * DM, DM, 32 * rb, scr, F.lane); }
        else { const int q = r - I_GU; cvt_item_fp8(A.in[18] + (size_t)e * ED * DM, DM, 32 * (q & 31), 64 * (q >> 5), WSP(unsigned char, WS_WD) + (size_t)e * DM * ED, ED, 32 * (q & 31), scr, F.lane); }
    }
}

__device__ __forceinline__ s16x4 tr_read(const LAS unsigned char* p) { return __builtin_bit_cast(s16x4, __builtin_amdgcn_ds_read_tr16_b64_v4i16((LAS s16x4*)p)); }
struct AttnPre { u32x4 k[4], v[4], q[2]; };
__device__ __forceinline__ void attn_decode(int u, int& p, int& b, int& h, int& d, int& r, int& n) {
    p = u >> 10; const int bh = (u & 1023) >> 4, cls = u & 15; b = bh >> 3; h = bh & 7;
    if (p == 0) { d = 1; r = 0; n = cls; } else if (p == 1) { d = 4; r = cls & 3; n = cls >> 2; } else { d = 16; r = cls; n = 0; }
}
__device__ __forceinline__ void attn_load(Frame& F, const Args& A, int u, AttnPre& P) {
    int p, b, h, d, r, n; attn_decode(u, p, b, h, d, r, n);
    const bf16_t* Q = WSP(bf16_t, WS_Q); const bf16_t* K = WSP(bf16_t, WS_K); const bf16_t* V = WSP(bf16_t, WS_V);
    const size_t tb = (size_t)b * SEQ;
#pragma unroll
    for (int i = 0; i < 4; ++i) { const int idx = F.tid + NTHR * i, row = idx >> 3, c = idx & 7; const int ci = (n - 1) * 128 + row;
        P.k[i] = (u32x4){0u, 0u, 0u, 0u}; P.v[i] = P.k[i];
        if (ci >= 0) { const size_t off = (tb + (size_t)ci * d + r) * AW + h * HD + c * 8; P.k[i] = *(const u32x4*)(K + off); P.v[i] = *(const u32x4*)(V + off); } }
#pragma unroll
    for (int i = 0; i < 2; ++i) { const int idx = F.tid + NTHR * i, row = idx >> 3, c = idx & 7;
        const size_t off = (tb + (size_t)(n * 128 + row) * d + r) * AW + h * HD + c * 8; P.q[i] = *(const u32x4*)(Q + off); }
}
__device__ __forceinline__ void attn_store_lds(Frame& F, const AttnPre& P) {
    LAS unsigned char* Qs = F.lds; LAS unsigned char* Ks = F.lds + 16384; LAS unsigned char* Vs = F.lds + 49152;
#pragma unroll
    for (int i = 0; i < 4; ++i) { const int idx = F.tid + NTHR * i, row = idx >> 3, c = idx & 7; const int lo = row * 128 + ((c ^ (row & 7)) << 4);
        *(LAS u32x4*)(Ks + lo) = P.k[i]; *(LAS u32x4*)(Vs + lo) = P.v[i]; }
#pragma unroll
    for (int i = 0; i < 2; ++i) { const int idx = F.tid + NTHR * i, row = idx >> 3, c = idx & 7; *(LAS u32x4*)(Qs + row * 128 + ((c ^ (row & 7)) << 4)) = P.q[i]; }
}
__device__ __forceinline__ void attn_compute(Frame& F, const Args& A, int u) {
    LAS unsigned char* Qs = F.lds; LAS unsigned char* Ks = F.lds + 16384; LAS unsigned char* Vs = F.lds + 49152;
    int p, b, h, d, r, n; attn_decode(u, p, b, h, d, r, n);
    const int lane = F.lane, w = F.wave, g = lane >> 4, li = lane & 15;
    const size_t tb = (size_t)b * SEQ;
    bf16x8 qf[2];
    { const int row = 16 * w + li;
#pragma unroll
      for (int ks = 0; ks < 2; ++ks) qf[ks] = *(const LAS bf16x8*)(Qs + row * 128 + (((4 * ks + g) ^ (row & 7)) << 4)); }
    f32x4 s[9];
#pragma unroll
    for (int kt = 0; kt < 9; ++kt) { const int krow = 16 * (w + kt) + li; f32x4 a = (f32x4){0.f, 0.f, 0.f, 0.f};
#pragma unroll
        for (int ks = 0; ks < 2; ++ks) { const bf16x8 kf = *(const LAS bf16x8*)(Ks + krow * 128 + (((4 * ks + g) ^ (krow & 7)) << 4)); a = __builtin_amdgcn_mfma_f32_16x16x32_bf16(kf, qf[ks], a, 0, 0, 0); }
        s[kt] = a; }
    float mx = -INFINITY;
#pragma unroll
    for (int kt = 0; kt < 9; ++kt)
#pragma unroll
        for (int rr = 0; rr < 4; ++rr) { const int kk = 16 * kt + 4 * g + rr; const int kj = 16 * w + kk;
            const bool ok = (kk >= li) && (kk <= li + 128) && (n > 0 || kj >= 128);
            const float v = ok ? s[kt][rr] : -INFINITY; s[kt][rr] = v; mx = fmaxf(mx, v); }
    mx = fmaxf(mx, __shfl_xor(mx, 16)); mx = fmaxf(mx, __shfl_xor(mx, 32));
    const float C = 0.125f * 1.4426950408889634f; float ls = 0.f;
#pragma unroll
    for (int kt = 0; kt < 9; ++kt)
#pragma unroll
        for (int rr = 0; rr < 4; ++rr) { const float e = __builtin_amdgcn_exp2f((s[kt][rr] - mx) * C); s[kt][rr] = e; ls += e; }
    ls += __shfl_xor(ls, 16); ls += __shfl_xor(ls, 32);
    f32x4 o[4];
#pragma unroll
    for (int nt = 0; nt < 4; ++nt) o[nt] = (f32x4){0.f, 0.f, 0.f, 0.f};
    const int q4 = li >> 2, p4 = li & 3;
#pragma unroll
    for (int k2 = 0; k2 < 5; ++k2) {
        const int t0 = 2 * k2, t1 = 2 * k2 + 1;
        u32x4 pw; pw.x = cvt_pk_bf16(s[t0][0], s[t0][1]); pw.y = cvt_pk_bf16(s[t0][2], s[t0][3]);
        if (t1 < 9) { pw.z = cvt_pk_bf16(s[t1 < 9 ? t1 : 8][0], s[t1 < 9 ? t1 : 8][1]); pw.w = cvt_pk_bf16(s[t1 < 9 ? t1 : 8][2], s[t1 < 9 ? t1 : 8][3]); } else { pw.z = 0u; pw.w = 0u; }
        const bf16x8 pa = __builtin_bit_cast(bf16x8, pw);
        int KT1 = w + t1; if (KT1 > 15) KT1 = 15;
        const int r0 = 16 * (w + t0) + 4 * g + q4, r1 = 16 * KT1 + 4 * g + q4;
#pragma unroll
        for (int nt = 0; nt < 4; ++nt) { const int ch = 2 * nt + (p4 >> 1);
            const s16x4 lo = tr_read(Vs + r0 * 128 + ((ch ^ (r0 & 7)) << 4) + (p4 & 1) * 8), hi = tr_read(Vs + r1 * 128 + ((ch ^ (r1 & 7)) << 4) + (p4 & 1) * 8);
            const bf16x8 vb = (bf16x8){lo[0], lo[1], lo[2], lo[3], hi[0], hi[1], hi[2], hi[3]};
            o[nt] = __builtin_amdgcn_mfma_f32_16x16x32_bf16(pa, vb, o[nt], 0, 0, 0); }
    }
    const float linv = 1.f / ls;
    LAS bf16_t* st = (LAS bf16_t*)(Qs + 16 * w * 128);
#pragma unroll
    for (int rr = 0; rr < 4; ++rr) { const float sc = __shfl(linv, 4 * g + rr);
#pragma unroll
        for (int nt = 0; nt < 4; ++nt) st[(4 * g + rr) * 64 + 16 * nt + li] = (bf16_t)(cvt_pk_bf16(o[nt][rr] * sc, 0.f) & 0xffffu); }
    LDS_WAIT(); asm volatile("" ::: "memory");
    bf16_t* OP = WSP(bf16_t, WS_OP) + (size_t)p * T * AW; float* LSE = WSP(float, WS_LSE) + (size_t)p * T * NH;
#pragma unroll
    for (int i = 0; i < 2; ++i) { const int cidx = lane + 64 * i, row = cidx >> 3, c = cidx & 7;
        const size_t tok = tb + (size_t)(n * 128 + 16 * w + row) * d + r;
        *(u32x4*)(OP + tok * AW + h * HD + c * 8) = *(const LAS u32x4*)((const LAS unsigned char*)st + row * 128 + c * 16); }
    if (lane < 16) { const size_t tok = tb + (size_t)(n * 128 + 16 * w + li) * d + r; LSE[tok * NH + h] = mx * 0.125f + logf(ls); }
}
__device__ __forceinline__ void attn_phase(Frame& F, const Args& A) {
    int u = F.vcu; AttnPre P;
    if (u < 3072) attn_load(F, A, u, P);
    while (u < 3072) {
        attn_store_lds(F, P);
        __syncthreads();
        const int un = u + F.G;
        if (un < 3072) attn_load(F, A, un, P);
        attn_compute(F, A, u);
        __syncthreads();
        u = un;
    }
}
__device__ __forceinline__ void sgu_unit(Frame& F, const Args& A, int bc, int g, bool do_stats) {
    LAS unsigned char* Ws = F.lds; LAS unsigned char* Vn = F.lds + 32768; LAS f32x2* stats = (LAS f32x2*)(F.lds + 65536);
    const size_t t0 = (size_t)bc * 128;
    const bf16_t* VG = WSP(bf16_t, WS_VG); const bf16_t* U = WSP(bf16_t, WS_U); bf16_t* SG = WSP(bf16_t, WS_SG);
    const float* lng = A.in[5]; const float* lnb = A.in[6]; const float* wsp = A.in[7] + (size_t)g * 128 * 128; const float* bsp = A.in[8] + g * 128;
    const int tid = F.tid, lane = F.lane, w = F.wave, g4 = lane >> 4, li = lane & 15;
    if (do_stats) { const int row = tid >> 2, qd = tid & 3; const u32x4* pr = (const u32x4*)(VG + (t0 + row) * GW + qd * 256); float s1 = 0.f, s2 = 0.f;
#pragma unroll 8
      for (int i = 0; i < 32; ++i) { const u32x4 v = pr[i];
#pragma unroll
          for (int j = 0; j < 4; ++j) { const float a = bf_lo(v[j]), c = bf_hi(v[j]); s1 += a + c; s2 += a * a + c * c; } }
      s1 += __shfl_xor(s1, 1); s2 += __shfl_xor(s2, 1); s1 += __shfl_xor(s1, 2); s2 += __shfl_xor(s2, 2);
      const float mean = s1 * (1.f / 1024.f); const float var = fmaxf(s2 * (1.f / 1024.f) - mean * mean, 0.f);
      if (qd == 0) stats[row] = (f32x2){mean, 1.f / sqrtf(var + LN_EPS)}; }
#pragma unroll
    for (int i = 0; i < 8; ++i) { const int idx = tid + NTHR * i, trow = idx >> 5, c4 = idx & 31; f32x4 v = *(const f32x4*)(wsp + trow * 128 + c4 * 4);
#pragma unroll
        for (int j = 0; j < 4; ++j) if (4 * c4 + j > trow) v[j] = 0.f;
        u32x2 o; o.x = cvt_pk_bf16(v[0], v[1]); o.y = cvt_pk_bf16(v[2], v[3]);
        *(LAS u32x2*)(Ws + trow * 256 + (((c4 >> 1) ^ (trow & 15)) << 4) + (c4 & 1) * 8) = o; }
    __syncthreads();
#pragma unroll
    for (int i = 0; i < 4; ++i) { const int idx = tid + NTHR * i, srow = idx >> 4, c16 = idx & 15; const int ch0 = g * 128 + c16 * 8;
        const u32x4 v = *(const u32x4*)(VG + (t0 + srow) * GW + ch0); const f32x2 st = stats[srow];
        const f32x4 ga = *(const f32x4*)(lng + ch0), gb = *(const f32x4*)(lng + ch0 + 4), ba = *(const f32x4*)(lnb + ch0), bb = *(const f32x4*)(lnb + ch0 + 4);
        f32x4 x0, x1; pg8::unpack8(v, x0, x1);
        x0 = (x0 - st.x) * st.y * ga + ba; x1 = (x1 - st.x) * st.y * gb + bb;
        *(LAS u32x4*)(Vn + srow * 256 + ((c16 ^ (srow & 15)) << 4)) = pg8::pack8(x0, x1); }
    __syncthreads();
    f32x4 acc[8];
#pragma unroll
    for (int nt = 0; nt < 8; ++nt) acc[nt] = (f32x4){0.f, 0.f, 0.f, 0.f};
    const int nks = (w >> 1) + 1; const int arow = 16 * w + li; const int q4 = li >> 2, p4 = li & 3;
    for (int ks = 0; ks < nks; ++ks) {
        const bf16x8 af = *(const LAS bf16x8*)(Ws + arow * 256 + (((4 * ks + g4) ^ (arow & 15)) << 4));
        const int r0 = 32 * ks + 8 * g4 + q4, r1 = r0 + 4;
#pragma unroll
        for (int nt = 0; nt < 8; ++nt) { const int ch = 2 * nt + (p4 >> 1);
            const s16x4 lo = tr_read(Vn + r0 * 256 + ((ch ^ (r0 & 15)) << 4) + (p4 & 1) * 8), hi = tr_read(Vn + r1 * 256 + ((ch ^ (r1 & 15)) << 4) + (p4 & 1) * 8);
            const bf16x8 vb = (bf16x8){lo[0], lo[1], lo[2], lo[3], hi[0], hi[1], hi[2], hi[3]};
            acc[nt] = __builtin_amdgcn_mfma_f32_16x16x32_bf16(af, vb, acc[nt], 0, 0, 0); }
    }
    LAS bf16_t* st = (LAS bf16_t*)(Ws + 16 * w * 256);
#pragma unroll
    for (int rr = 0; rr < 4; ++rr) { const float bias = bsp[16 * w + 4 * g4 + rr];
#pragma unroll
        for (int nt = 0; nt < 8; ++nt) st[(4 * g4 + rr) * 128 + 16 * nt + li] = (bf16_t)(cvt_pk_bf16(acc[nt][rr] + bias, 0.f) & 0xffffu); }
    LDS_WAIT(); asm volatile("" ::: "memory");
#pragma unroll
    for (int i = 0; i < 4; ++i) { const int cidx = lane + 64 * i, row = cidx >> 4, c16 = cidx & 15; const size_t off = (t0 + 16 * w + row) * GW + g * 128 + c16 * 8;
        f32x4 a0, a1, u0, u1; pg8::unpack8(*(const LAS u32x4*)((const LAS unsigned char*)st + row * 256 + c16 * 16), a0, a1); pg8::unpack8(*(const u32x4*)(U + off), u0, u1);
        *(u32x4*)(SG + off) = pg8::pack8(a0 * u0, a1 * u1); }
    __syncthreads();
}
__device__ __forceinline__ void sgu_phase(Frame& F, const Args& A) {
    for (int uu = F.vcu; uu < 256; uu += F.G) {
        const int bc = uu >> 1, g0 = 4 * (uu & 1);
        for (int gi = 0; gi < 4; ++gi) sgu_unit(F, A, bc, g0 + gi, gi == 0);
    }
}
__device__ __forceinline__ void p4_phase(Frame& F, const Args& A) {
    const bf16_t* OP = WSP(bf16_t, WS_OP); const float* LSE = WSP(float, WS_LSE); bf16_t* OA = WSP(bf16_t, WS_OA);
    for (int idx = F.vcu * NTHR + F.tid; idx < T * 64; idx += F.G * NTHR) {
        const int t = idx >> 6, h = (idx >> 3) & 7, c = idx & 7;
        const float l0 = LSE[(size_t)t * NH + h], l1 = LSE[(size_t)(T + t) * NH + h], l2 = LSE[(size_t)(2 * T + t) * NH + h];
        const float m = fmaxf(l0, fmaxf(l1, l2)); float w0 = expf(l0 - m), w1 = expf(l1 - m), w2 = expf(l2 - m); const float inv = 1.f / (w0 + w1 + w2); w0 *= inv; w1 *= inv; w2 *= inv;
        const size_t off = (size_t)t * AW + h * HD + c * 8;
        f32x4 a0, a1, b0, b1, c0, c1; pg8::unpack8(*(const u32x4*)(OP + off), a0, a1); pg8::unpack8(*(const u32x4*)(OP + (size_t)T * AW + off), b0, b1); pg8::unpack8(*(const u32x4*)(OP + (size_t)2 * T * AW + off), c0, c1);
        *(u32x4*)(OA + off) = pg8::pack8(a0 * w0 + b0 * w1 + c0 * w2, a1 * w0 + b1 * w1 + c1 * w2);
    }
}
__device__ __forceinline__ void p7_phase(Frame& F, const Args& A) {
    const int gw = F.vcu * NWAVES + F.wave, NGW = F.G * NWAVES;
    const float* x = A.in[0]; const float* mod = WSP(float, WS_MOD); const bf16_t* mix = WSP(bf16_t, WS_MIX); float* x1 = WSP(float, WS_X1); bf16_t* h2 = WSP(bf16_t, WS_H);
    const float* g1 = A.in[12]; const float* b1 = A.in[13];
    for (int m = gw; m < T; m += NGW) {
        const float* md = mod + (m / SEQ) * 6 * DM; const f32x4* xr = (const f32x4*)(x + (size_t)m * DM) + F.lane; const u32x2* mr = (const u32x2*)(mix + (size_t)m * DM) + F.lane;
        f32x4 v[4]; float s = 0.f;
#pragma unroll
        for (int j = 0; j < 4; ++j) { const f32x4 xv = xr[64 * j]; const u32x2 mw = mr[64 * j]; const f32x4 gv = *((const f32x4*)(md + 2 * DM) + F.lane + 64 * j);
            const f32x4 mv = (f32x4){bf_lo(mw.x), bf_hi(mw.x), bf_lo(mw.y), bf_hi(mw.y)};
            v[j] = xv * ALPHA + gv * mv; s += (v[j][0] + v[j][1]) + (v[j][2] + v[j][3]); }
        const float mean = wave_sum(s) * (1.f / DM); float s2 = 0.f;
#pragma unroll
        for (int j = 0; j < 4; ++j) { v[j] = v[j] - mean; s2 += (v[j][0] * v[j][0] + v[j][1] * v[j][1]) + (v[j][2] * v[j][2] + v[j][3] * v[j][3]); }
        const float rstd = 1.f / sqrtf(wave_sum(s2) * (1.f / DM) + LN_EPS);
        f32x4* xo = (f32x4*)(x1 + (size_t)m * DM) + F.lane; u32x2* ho = (u32x2*)(h2 + (size_t)m * DM) + F.lane; unsigned* h8 = (unsigned*)(WSP(unsigned char, WS_H8) + (size_t)m * DM) + F.lane;
#pragma unroll
        for (int j = 0; j < 4; ++j) { const f32x4 gg = *((const f32x4*)g1 + F.lane + 64 * j), bb = *((const f32x4*)b1 + F.lane + 64 * j);
            const f32x4 o = v[j] * rstd * gg + bb; xo[64 * j] = o;
            const f32x4 sh = *((const f32x4*)(md + 3 * DM) + F.lane + 64 * j), sc = *((const f32x4*)(md + 4 * DM) + F.lane + 64 * j);
            const f32x4 r = o * (sc + 1.f) + sh; u32x2 wv; wv.x = cvt_pk_bf16(r[0], r[1]); wv.y = cvt_pk_bf16(r[2], r[3]); ho[64 * j] = wv;
            int w8 = __builtin_amdgcn_cvt_pk_fp8_f32(r[0], r[1], 0, false); w8 = __builtin_amdgcn_cvt_pk_fp8_f32(r[2], r[3], w8, true); h8[64 * j] = (unsigned)w8; }
    }
}
template <int CTRL> __device__ __forceinline__ unsigned dpp_u32(unsigned v) { return (unsigned)__builtin_amdgcn_update_dpp((int)v, (int)v, CTRL, 0xF, 0xF, false); }
__device__ __forceinline__ unsigned wave_max_u32(unsigned v) {
    unsigned t;
    t = dpp_u32<0xB1>(v); v = t > v ? t : v;
    t = dpp_u32<0x4E>(v); v = t > v ? t : v;
    t = dpp_u32<0x141>(v); v = t > v ? t : v;
    t = dpp_u32<0x140>(v); v = t > v ? t : v;
    const unsigned a = (unsigned)__builtin_amdgcn_readlane((int)v, 0), b = (unsigned)__builtin_amdgcn_readlane((int)v, 16), c = (unsigned)__builtin_amdgcn_readlane((int)v, 32), d = (unsigned)__builtin_amdgcn_readlane((int)v, 48);
    const unsigned ab = a > b ? a : b, cd = c > d ? c : d; return ab > cd ? ab : cd;
}
__device__ __forceinline__ void route_token(const float* logits, const f32x4 rb, int t, int lane, int& my_e, float& my_w) {
    const f32x4 lg = *((const f32x4*)(logits + (size_t)t * NE) + lane);
    f32x4 sc, bi;
#pragma unroll
    for (int i = 0; i < 4; ++i) { sc[i] = 1.f / (1.f + expf(-lg[i])); bi[i] = sc[i] + rb[i]; }
    float m1 = fmaxf(bi[0], bi[1]), m2 = fminf(bi[0], bi[1]);
#pragma unroll
    for (int i = 2; i < 4; ++i) { const float v = bi[i]; m2 = fmaxf(m2, fminf(m1, v)); m1 = fmaxf(m1, v); }
#pragma unroll
    for (int o = 1; o < 8; o <<= 1) { const float o1 = __shfl_xor(m1, o), o2 = __shfl_xor(m2, o); const float n1 = fmaxf(m1, o1), n2 = fmaxf(fminf(m1, o1), fmaxf(m2, o2)); m1 = n1; m2 = n2; }
    const float gs = m1 + m2; const int grp = lane >> 3; int rank = 0;
#pragma unroll
    for (int gg = 0; gg < 8; ++gg) { const float v = __builtin_bit_cast(float, __builtin_amdgcn_readlane(__builtin_bit_cast(int, gs), 8 * gg)); rank += (v > gs || (v == gs && gg < grp)) ? 1 : 0; }
    const bool sel = rank < 4;
    unsigned key[4];
#pragma unroll
    for (int i = 0; i < 4; ++i) { float f = (bi[i] + 0.0625f) * 8388608.f; f = fminf(fmaxf(f, 1.f), 16777215.f); key[i] = sel ? (((unsigned)f << 8) | (unsigned)(255 - (4 * lane + i))) : 0u; }
    my_e = 0; float my_s = 0.f, wsum = 0.f;
#pragma unroll
    for (int r = 0; r < TOPK; ++r) {
        unsigned k = key[0] > key[1] ? key[0] : key[1]; { const unsigned k2 = key[2] > key[3] ? key[2] : key[3]; k = k > k2 ? k : k2; }
        k = wave_max_u32(k);
        const int e = 255 - (int)(k & 0xffu); const int sub = e & 3;
        const float sv = (sub == 0) ? sc[0] : (sub == 1) ? sc[1] : (sub == 2) ? sc[2] : sc[3];
        const float ssel = __builtin_bit_cast(float, __builtin_amdgcn_readlane(__builtin_bit_cast(int, sv), e >> 2));
#pragma unroll
        for (int i = 0; i < 4; ++i) if (key[i] == k) key[i] = 0u;
        wsum += ssel; if (lane == r) { my_e = e; my_s = ssel; }
    }
    my_w = 2.5f * my_s / wsum;
}
__device__ __forceinline__ void p9_phase(Frame& F, const Args& A) {
    const int gw = F.vcu * NWAVES + F.wave, NGW = F.G * NWAVES, lane = F.lane;
    const float* logits = WSP(float, WS_LOGITS); const float* rbias = A.in[15];
    unsigned* cnt = (unsigned*)(F.ctl + CW_CNT); int* tok_e = WSP(int, WS_TOKE); int* tok_r = WSP(int, WS_TOKR); int* btok = WSP(int, WS_BTOK); float* bw = WSP(float, WS_BW);
    const f32x4 rb = *((const f32x4*)rbias + lane);
    for (int base = gw; base < T; base += 8 * NGW) {
        int es[8]; float ws[8]; unsigned rk[8];
#pragma unroll
        for (int i = 0; i < 8; ++i) { const int t = base + i * NGW; es[i] = 0; ws[i] = 0.f; if (t < T) route_token(logits, rb, t, lane, es[i], ws[i]); }
#pragma unroll
        for (int i = 0; i < 8; ++i) { const int t = base + i * NGW; rk[i] = 0u; if (t < T && lane < TOPK) rk[i] = atomicAdd(&cnt[es[i] * CNT_STRIDE], 1u); }
#pragma unroll
        for (int i = 0; i < 8; ++i) { const int t = base + i * NGW;
            if (t < T && lane < TOPK) { tok_e[t * TOPK + lane] = es[i]; tok_r[t * TOPK + lane] = (int)rk[i];
                if (rk[i] < (unsigned)BUCKET) { btok[(size_t)es[i] * BUCKET + rk[i]] = t; bw[(size_t)es[i] * BUCKET + rk[i]] = ws[i]; } } }
    }
}
__device__ __forceinline__ void build_tile_table(Frame& F, const Args& A) {
    LAS unsigned short* tile_e = (LAS unsigned short*)(F.lds + L_TILE_E); LAS unsigned short* tstart = (LAS unsigned short*)(F.lds + L_TSTART);
    const unsigned* cnt = (const unsigned*)(F.ctl + CW_CNT);
    __syncthreads();
    int val = 0, incl = 0;
    if (F.tid < NE) { unsigned c = __hip_atomic_load(cnt + F.tid * CNT_STRIDE, RLX_AGENT); if (c > (unsigned)BUCKET) c = BUCKET; ((LAS unsigned short*)(F.lds + L_CNT))[F.tid] = (unsigned short)c; val = (int)((c + 255u) >> 8); incl = val;
#pragma unroll
        for (int o = 1; o < 64; o <<= 1) { const int v = __shfl_up(incl, o); if (F.lane >= o) incl += v; }
        if (F.lane == 63) F.MISC[F.wave] = (unsigned)incl; }
    __syncthreads();
    if (F.tid < NE) { int off = 0;
#pragma unroll
        for (int w = 0; w < 4; ++w) if (w < F.wave) off += (int)F.MISC[w];
        const int st = off + incl - val; tstart[F.tid] = (unsigned short)st;
        for (int k = 0; k < val; ++k) tile_e[st + k] = (unsigned short)F.tid;
        if (F.tid == NE - 1) F.MISC[4] = (unsigned)(off + incl); }
    __syncthreads();
    int hv = 0, hincl = 0;
    if (F.tid < NE) { hv = (int)((((LAS unsigned short*)(F.lds + L_CNT))[F.tid] + 127u) >> 7); hincl = hv;
#pragma unroll
        for (int o = 1; o < 64; o <<= 1) { const int v = __shfl_up(hincl, o); if (F.lane >= o) hincl += v; }
        if (F.lane == 63) F.MISC[F.wave] = (unsigned)hincl; }
    __syncthreads();
    if (F.tid < NE) { int off = 0;
#pragma unroll
        for (int w = 0; w < 4; ++w) if (w < F.wave) off += (int)F.MISC[w];
        ((LAS unsigned short*)(F.lds + L_HPRE))[F.tid] = (unsigned short)(off + hincl - hv);
        if (F.tid == NE - 1) F.MISC[5] = (unsigned)(off + hincl); }
    __syncthreads();
}
__device__ __forceinline__ void p12_phase(Frame& F, const Args& A) {
    const int gw = F.vcu * NWAVES + F.wave, NGW = F.G * NWAVES;
    const LAS unsigned short* tstart = (const LAS unsigned short*)(F.lds + L_TSTART);
    const float* mod = WSP(float, WS_MOD); const float* x1 = WSP(float, WS_X1); const unsigned char* ysh = WSP(unsigned char, WS_YSH); const unsigned char* yrow = WSP(unsigned char, WS_YROW);
    const int* tok_e = WSP(int, WS_TOKE); const int* tok_r = WSP(int, WS_TOKR); const float* g2 = A.in[22]; const float* b2 = A.in[23]; float* out = A.out;
    const int c0 = 16 * F.lane;
    for (int m = gw; m < T; m += NGW) {
        const float* md = mod + (m / SEQ) * 6 * DM;
        f32x4 f[4];
#pragma unroll
        for (int j = 0; j < 4; ++j) f[j] = (f32x4){0.f, 0.f, 0.f, 0.f};
#pragma unroll
        for (int k = 0; k < TOPK; ++k) { const int e = tok_e[m * TOPK + k], rk = tok_r[m * TOPK + k]; const size_t pos = (size_t)tstart[e] * 256 + rk;
            const u32x4 w = *(const u32x4*)(yrow + pos * DM + c0);
#pragma unroll
            for (int j = 0; j < 4; ++j) { const f32x2 lo = __builtin_amdgcn_cvt_pk_f32_fp8((int)w[j], false), hi = __builtin_amdgcn_cvt_pk_f32_fp8((int)w[j], true); f[j] += (f32x4){lo.x, lo.y, hi.x, hi.y}; } }
        { const u32x4 w = *(const u32x4*)(ysh + (size_t)m * DM + c0);
#pragma unroll
          for (int j = 0; j < 4; ++j) { const f32x2 lo = __builtin_amdgcn_cvt_pk_f32_fp8((int)w[j], false), hi = __builtin_amdgcn_cvt_pk_f32_fp8((int)w[j], true); f[j] += (f32x4){lo.x, lo.y, hi.x, hi.y}; }
          const float is = 1.f / pg8::YROW_SCALE; f[0] = f[0] * is; f[1] = f[1] * is; f[2] = f[2] * is; f[3] = f[3] * is; }
        const f32x4* xr = (const f32x4*)(x1 + (size_t)m * DM + c0); f32x4 v[4]; float s = 0.f;
#pragma unroll
        for (int j = 0; j < 4; ++j) { const f32x4 gv = *((const f32x4*)(md + 5 * DM + c0) + j); v[j] = xr[j] * ALPHA + gv * f[j]; s += (v[j][0] + v[j][1]) + (v[j][2] + v[j][3]); }
        const float mean = wave_sum(s) * (1.f / DM); float s2 = 0.f;
#pragma unroll
        for (int j = 0; j < 4; ++j) { v[j] = v[j] - mean; s2 += (v[j][0] * v[j][0] + v[j][1] * v[j][1]) + (v[j][2] * v[j][2] + v[j][3] * v[j][3]); }
        const float rstd = 1.f / sqrtf(wave_sum(s2) * (1.f / DM) + LN_EPS);
        f32x4* oo = (f32x4*)(out + (size_t)m * DM + c0);
#pragma unroll
        for (int j = 0; j < 4; ++j) { const f32x4 gg = *((const f32x4*)(g2 + c0) + j), bb = *((const f32x4*)(b2 + c0) + j); oo[j] = v[j] * rstd * gg + bb; }
    }
}
constexpr int NPHASE = 13;

__global__ void __launch_bounds__(NTHR, 2) mk_fwd(Args args) {
    extern __shared__ __attribute__((aligned(16))) unsigned char lds_raw[];
    Frame F;
    F.lds = (LAS unsigned char*)lds_raw; F.MISC = (volatile LAS unsigned*)(F.lds + L_MISC);
    F.tid = threadIdx.x; F.lane = F.tid & 63; F.wave = __builtin_amdgcn_readfirstlane(F.tid >> 6);
    F.G = gridDim.x; { const int bx = blockIdx.x; F.vcu = (F.G % 8 == 0) ? (bx % 8) * (F.G / 8) + bx / 8 : bx; }
    const Args& A = args;
    F.ctl = (gu32*)(args.ws + WS_CTL);
    if (F.tid < 64) F.MISC[F.tid] = 0u;
    __syncthreads();
    const int lo = args.ph_lo, hi = args.ph_hi;
    XcdBarrier bar; bar.bar = (unsigned*)(F.ctl + CW_BAR); bar.x = 0; bar.st = nullptr;
    if (hi - lo > 1) bar = xcd_barrier_post((unsigned*)(F.ctl + CW_BAR), F.MISC + 8);
#ifndef REPEAT_MASK
#define REPEAT_MASK 0
#endif
#define IN(k) (lo <= (k) && (k) < hi)
#define REP(k) _Pragma("nounroll") for (int rep_ = 0; rep_ < (((REPEAT_MASK >> (k)) & 1) ? 2 : 1); ++rep_)
#define STAMP(k) do { if (TIME_PHASE >= 0 && blockIdx.x == 0 && F.tid == 0) { const unsigned long long t_ = __builtin_amdgcn_s_memrealtime(); F.MISC[16 + 2 * (k)] = (unsigned)t_; F.MISC[17 + 2 * (k)] = (unsigned)(t_ >> 32); } } while (0)
#define SEAM(k) do { if (IN(k) && IN((k) + 1)) xcd_barrier(bar); STAMP((k) + 1); } while (0)
    LAS unsigned char* ring = F.lds;
    STAMP(0);

    if (IN(0)) REP(0) { p0_phase(F, A); } SEAM(0);
    if (IN(1)) REP(1) { p1_phase(F, A); } SEAM(1);
    if (IN(2)) REP(2) {
        pg8::StaticOrder S; S.init(WSP(bf16_t, WS_H), WSP(bf16_t, WS_WIN), T, INW, DM * 2, DM * 2, F.G, (int)blockIdx.x);
        pg8::EpiInProj E{A.ws, WSP(float, WS_ROPE)};
        pg8::gemm_phase<pg8::EpiInProj, pg8::StaticOrder, false, true>(ring, DM, DM * 2, DM * 2, S, E);
    } SEAM(2);
    if (IN(3)) REP(3) { REP(13) attn_phase(F, A); REP(14) sgu_phase(F, A); } SEAM(3);
    if (IN(4)) REP(4) { p4_phase(F, A); } SEAM(4);
    if (IN(5)) REP(5) {
        { pg8::StaticOrder S; S.init(WSP(bf16_t, WS_OA), WSP(bf16_t, WS_WPA), T, DM, AW * 2, AW * 2, F.G, (int)blockIdx.x);
          pg8::EpiGate<false> E{WSP(bf16_t, WS_MERGED), WSP(bf16_t, WS_GA)};
          pg8::gemm_phase<pg8::EpiGate<false>, pg8::StaticOrder, false, false>(ring, AW, AW * 2, AW * 2, S, E); }
        { pg8::StaticOrder S; S.init(WSP(bf16_t, WS_SG), WSP(bf16_t, WS_WPB), T, DM, GW * 2, GW * 2, F.G, (int)blockIdx.x);
          pg8::EpiGate<true> E{WSP(bf16_t, WS_MERGED), WSP(bf16_t, WS_GB)};
          pg8::gemm_phase<pg8::EpiGate<true>, pg8::StaticOrder, false, false>(ring, GW, GW * 2, GW * 2, S, E); }
    } SEAM(5);
    if (IN(6)) REP(6) {
        pg8::StaticOrder S; S.init(WSP(bf16_t, WS_MERGED), WSP(bf16_t, WS_WOUT), T, DM, DM * 2, DM * 2, F.G, (int)blockIdx.x);
        pg8::EpiBf16<false> E{WSP(bf16_t, WS_MIX), DM, nullptr};
        pg8::gemm_phase<pg8::EpiBf16<false>, pg8::StaticOrder, false, false>(ring, DM, DM * 2, DM * 2, S, E);
    } SEAM(6);
    if (IN(7)) REP(7) { p7_phase(F, A); } SEAM(7);
    if (IN(8)) REP(8) {
        pg8::StaticOrder S; S.init(WSP(bf16_t, WS_H), WSP(bf16_t, WS_WRS), T, 768, DM * 2, DM * 2, F.G, (int)blockIdx.x);
        pg8::EpiRouterShared E{WSP(float, WS_LOGITS), WSP(bf16_t, WS_SHID)};
        pg8::gemm_phase<pg8::EpiRouterShared, pg8::StaticOrder, false, true>(ring, DM, DM * 2, DM * 2, S, E);
    } SEAM(8);
    if (IN(9)) REP(9) { p9_phase(F, A); } SEAM(9);
    if (IN(10)) REP(10) {
        build_tile_table(F, A);
        pg8::GroupedOrder S; S.G = F.G; S.c = F.vcu; S.NPN = 2; S.ntiles = (int)F.MISC[4]; S.tile_e = (const LAS unsigned short*)(F.lds + L_TILE_E); S.tstart = (const LAS unsigned short*)(F.lds + L_TSTART);
        S.cnt = (const LAS unsigned short*)(F.lds + L_CNT); S.Abase = (const char*)WSP(unsigned char, WS_H8); S.a_tile_stride = 0; S.Bbase = (const char*)WSP(unsigned char, WS_WGU); S.b_exp_stride = (size_t)512 * DM; S.b_tile_stride = (size_t)256 * DM;
        S.idxbase = WSP(int, WS_BTOK); S.gather = true;
        pg8::EpiGateUp E{WSP(unsigned char, WS_HID), 1.f / W8_SCALE};
        pg8::gemm_phase<pg8::EpiGateUp, pg8::GroupedOrder, true, true, false, true>(ring, DM / 2, DM, DM, S, E);
    } SEAM(10);
    if (IN(11)) REP(11) {
        build_tile_table(F, A);
        { pg8::GroupedOrder S; S.G = F.G; S.c = F.vcu; S.NPN = 4; S.ntiles = (int)F.MISC[4]; S.tile_e = (const LAS unsigned short*)(F.lds + L_TILE_E); S.tstart = (const LAS unsigned short*)(F.lds + L_TSTART);
          S.cnt = (const LAS unsigned short*)(F.lds + L_CNT); S.Abase = (const char*)WSP(unsigned char, WS_HID); S.a_tile_stride = (size_t)256 * ED; S.Bbase = (const char*)WSP(unsigned char, WS_WD); S.b_exp_stride = (size_t)DM * ED; S.b_tile_stride = (size_t)256 * ED;
          S.idxbase = WSP(int, WS_BW); S.gather = false;
          pg8::EpiDown E{WSP(unsigned char, WS_YROW), pg8::YROW_SCALE / (W8_SCALE * pg8::HID_SCALE)};
          pg8::gemm_phase<pg8::EpiDown, pg8::GroupedOrder, false, true, false, true>(ring, ED / 2, ED, ED, S, E); }
        { pg8::StaticOrder S; S.init(WSP(bf16_t, WS_SHID), WSP(bf16_t, WS_WSD), T, DM, SD * 2, SD * 2, F.G, (int)blockIdx.x);
          pg8::EpiDown E{WSP(unsigned char, WS_YSH), pg8::YROW_SCALE};
          pg8::gemm_phase<pg8::EpiDown, pg8::StaticOrder, false, false>(ring, SD, SD * 2, SD * 2, S, E); }
    } SEAM(11);
    if (IN(12)) REP(12) { build_tile_table(F, A); p12_phase(F, A); }
    if (TIME_PHASE >= 0 && blockIdx.x == 0 && F.tid == 0) {
        STAMP(13);
        const unsigned long long t0 = ((unsigned long long)F.MISC[17 + 2 * TIME_PHASE] << 32) | F.MISC[16 + 2 * TIME_PHASE], t1 = ((unsigned long long)F.MISC[19 + 2 * TIME_PHASE] << 32) | F.MISC[18 + 2 * TIME_PHASE];
        const unsigned long long dt = (t1 - t0) * 8ull, s0 = __builtin_amdgcn_s_memrealtime();
        while (__builtin_amdgcn_s_memrealtime() - s0 < dt) __builtin_amdgcn_s_sleep(8);
    }
#undef IN
#undef REP
#undef SEAM
}

#ifndef MK_SPLIT
#define MK_SPLIT 0
#endif
static int mk_grid(size_t ws_size) {
    static int grid = 0;
    if (grid == 0) {
        int dev = 0, cus = 0, per_cu = 0;
        if (ws_size < WS_END) { fprintf(stderr, "kernel_launch: workspace too small (%zu < %zu)\n", ws_size, (size_t)WS_END); grid = -1; return -1; }
        if (hipGetDevice(&dev) != hipSuccess || hipDeviceGetAttribute(&cus, hipDeviceAttributeMultiprocessorCount, dev) != hipSuccess) { grid = -1; return -1; }
        if (hipFuncSetAttribute((const void*)mk_fwd, hipFuncAttributeMaxDynamicSharedMemorySize, LDS_BYTES) != hipSuccess) { fprintf(stderr, "kernel_launch: hipFuncSetAttribute failed\n"); grid = -1; return -1; }
        if (hipOccupancyMaxActiveBlocksPerMultiprocessor(&per_cu, (const void*)mk_fwd, NTHR, LDS_BYTES) != hipSuccess || per_cu < 1) { fprintf(stderr, "kernel_launch: occupancy query says %d blocks/CU\n", per_cu); (void)hipGetLastError(); grid = -1; return -1; }
        grid = cus;
    }
    return grid;
}
static void mk_run(void* const* d_in, float* out, void* d_ws, int grid, int lo, int hi, hipStream_t stream) {
    Args a{};
    for (int i = 0; i < 24; ++i) a.in[i] = (const float*)d_in[i];
    a.out = out; a.ws = (unsigned char*)d_ws; a.ph_lo = lo; a.ph_hi = hi;
#ifndef MK_COOP
#define MK_COOP 1
#endif
    if (MK_COOP && hi - lo > 1) {
        void* kargs[] = {&a};
        hipError_t e = hipLaunchCooperativeKernel((const void*)mk_fwd, dim3(grid), dim3(NTHR), kargs, LDS_BYTES, stream);
        if (e != hipSuccess) fprintf(stderr, "kernel_launch: cooperative launch failed: %s (grid %d)\n", hipGetErrorString(e), grid);
    } else {
        hipLaunchKernelGGL(mk_fwd, dim3(grid), dim3(NTHR), LDS_BYTES, stream, a);
    }
}
static int mk_launch(void* const* d_in, float* out, void* d_ws, size_t ws_size, hipStream_t stream) {
    const int grid = mk_grid(ws_size);
    if (grid < 0) return -1;
    (void)hipMemsetAsync((char*)d_ws + WS_CTL, 0, CTL_ZERO_BYTES, stream);
#if MK_SPLIT
#ifndef EXTRA_PHASE
#define EXTRA_PHASE -1
#endif
    for (int p = 0; p < NPHASE; ++p) { mk_run(d_in, out, d_ws, grid, p, p + 1, stream); if (p == EXTRA_PHASE) mk_run(d_in, out, d_ws, grid, p, p + 1, stream); }
#else
    mk_run(d_in, out, d_ws, grid, 0, NPHASE, stream);
#endif
    return 0;
}
extern "C" void kernel_launch(void* const* d_in, const int* in_sizes, int n_in, void* d_out, int out_size, void* d_ws, size_t ws_size, hipStream_t stream) {
    (void)in_sizes; (void)n_in; (void)out_size;
#if PROBE
    probe::run(d_in, d_out, d_ws, ws_size, stream);
#else
    mk_launch(d_in, (float*)d_out, d_ws, ws_size, stream);
#endif
}
```
